# Optimizing an MI355X kernel written in HIP

```python
import math
import jax, jax.numpy as jnp
from jax import lax
import numpy as np

D_MODEL = 2048
BATCH = 4
SEQ = 2048
DEPTH = 1

N_DN_HEADS = 6
DN_HEAD_DIM = 128
DN_WIDTH = N_DN_HEADS * DN_HEAD_DIM
DN_QKV_WIDTH = 3 * DN_WIDTH
DN_CONV = 4
DN_CHUNK = 64
DT_MIN = 0.001
DT_MAX = 0.1
N_SWA_HEADS = 6
N_SWA_KV = 2
SWA_HEAD_DIM = 128
SWA_WIDTH = N_SWA_HEADS * SWA_HEAD_DIM
SWA_KV_WIDTH = N_SWA_KV * SWA_HEAD_DIM
WINDOW = 128
SWA_BLOCK = 128
MEM_LEN = 256
N_MEM_HEADS = 4
MEM_HEAD_DIM = 128
MEM_WIDTH = N_MEM_HEADS * MEM_HEAD_DIM
N_BUCKETS = 32
MAX_DISTANCE = 128
N_BRANCHES = 3
D_FF = 4 * D_MODEL
EPS = 1e-6

IN_SIZES = [DN_QKV_WIDTH, DN_WIDTH, N_DN_HEADS, N_DN_HEADS,
            SWA_WIDTH, SWA_KV_WIDTH, SWA_KV_WIDTH, MEM_WIDTH, N_BRANCHES * D_MODEL]
IN_WIDTH = sum(IN_SIZES)
IN_SPLITS = [int(v) for v in np.cumsum(IN_SIZES[:-1])]

kernel_name = "hybrid_gdn_swa_memxattn_layer"


def rms_norm(x, w, eps=EPS):
    xf = x.astype(jnp.float32)
    y = xf * lax.rsqrt(jnp.mean(xf * xf, axis=-1, keepdims=True) + eps)
    return (y * w.astype(jnp.float32)).astype(x.dtype)


def l2_norm(x, eps=EPS):
    xf = x.astype(jnp.float32)
    return xf * lax.rsqrt(jnp.sum(xf * xf, axis=-1, keepdims=True) + eps)


def causal_depthwise_conv(x, w):
    k = w.shape[0]
    return lax.conv_general_dilated(
        x, w[:, None, :].astype(x.dtype), window_strides=(1,), padding=[(k - 1, 0)],
        dimension_numbers=("NWC", "WIO", "NWC"), feature_group_count=x.shape[-1])


def t5_bucket(dist):
    n = jnp.maximum(dist, 0)
    max_exact = N_BUCKETS // 2
    nf = jnp.maximum(n, 1).astype(jnp.float32)
    large = max_exact + (jnp.log(nf / max_exact) / math.log(MAX_DISTANCE / max_exact)
                         * (N_BUCKETS - max_exact)).astype(jnp.int32)
    large = jnp.minimum(large, N_BUCKETS - 1)
    return jnp.where(n < max_exact, n, large)


def gated_delta_rule(q, k, v, beta, g):
    B, S, H, DK = q.shape
    DV = v.shape[-1]
    C = DN_CHUNK
    NC = S // C

    def chunks(t):
        return t.reshape(B, NC, C, H, -1).transpose(0, 3, 1, 2, 4)

    q, k, v = chunks(q), chunks(k), chunks(v)
    beta = beta.reshape(B, NC, C, H).transpose(0, 3, 1, 2)
    G = jnp.cumsum(g.reshape(B, NC, C, H).transpose(0, 3, 1, 2), axis=-1)
    idx = jnp.arange(C)
    strict = idx[:, None] > idx[None, :]
    incl = idx[:, None] >= idx[None, :]
    dG = G[..., :, None] - G[..., None, :]
    decay_strict = jnp.exp(jnp.where(strict, dG, -jnp.inf))
    decay_incl = jnp.exp(jnp.where(incl, dG, -jnp.inf))
    kk = jnp.einsum("bhnid,bhnjd->bhnij", k, k)
    a_mat = jnp.eye(C, dtype=jnp.float32) + beta[..., None] * kk * decay_strict
    rhs = jnp.concatenate([v * beta[..., None], k * (beta * jnp.exp(G))[..., None]], axis=-1)
    sol = lax.linalg.triangular_solve(a_mat, rhs, left_side=True, lower=True, unit_diagonal=True)
    u, w = sol[..., :DV], sol[..., DV:]
    p = jnp.einsum("bhnid,bhnjd->bhnij", q, k) * decay_incl
    qg = q * jnp.exp(G)[..., None]
    kd = k * jnp.exp(G[..., -1:] - G)[..., None]
    gc = jnp.exp(G[..., -1])
    xs = (jnp.moveaxis(u, 2, 0), jnp.moveaxis(w, 2, 0), jnp.moveaxis(p, 2, 0),
          jnp.moveaxis(qg, 2, 0), jnp.moveaxis(kd, 2, 0), jnp.moveaxis(gc, 2, 0))

    def step(state, inp):
        u_c, w_c, p_c, qg_c, kd_c, gc_c = inp
        delta = u_c - jnp.einsum("bhcd,bhdv->bhcv", w_c, state)
        o_c = jnp.einsum("bhcd,bhdv->bhcv", qg_c, state) + jnp.einsum("bhij,bhjv->bhiv", p_c, delta)
        state = gc_c[..., None, None] * state + jnp.einsum("bhcd,bhcv->bhdv", kd_c, delta)
        return state, o_c

    s0 = jnp.zeros((B, H, DK, DV), jnp.float32)
    _, o = lax.scan(step, s0, xs)
    return o.transpose(1, 0, 3, 2, 4).reshape(B, S, H, DV)


def sliding_window_attention(q, k, v, sinks, rel_bias):
    B, S, HQ, D = q.shape
    HKV = k.shape[2]
    G = HQ // HKV
    L = SWA_BLOCK
    NB = S // L
    qb = q.reshape(B, NB, L, HKV, G, D)

    def windows(t):
        tp = jnp.pad(t, ((0, 0), (L, 0), (0, 0), (0, 0))).reshape(B, NB + 1, L, HKV, D)
        return jnp.concatenate([tp[:, :-1], tp[:, 1:]], axis=2)

    kw, vw = windows(k), windows(v)
    logits = jnp.einsum("bnqhgd,bnkhd->bnhgqk", qb, kw).astype(jnp.float32) * (D ** -0.5)
    qi = jnp.arange(L)[:, None]
    kj = jnp.arange(2 * L)[None, :]
    dist = qi - kj + L
    bias = rel_bias[t5_bucket(dist)].astype(jnp.float32)
    bias = bias.transpose(2, 0, 1).reshape(HKV, G, L, 2 * L)
    key_pos = jnp.arange(NB)[:, None, None] * L + kj[None] - L
    valid = (dist >= 0) & (dist < WINDOW) & (key_pos >= 0)
    logits = jnp.where(valid[None, :, None, None], logits + bias, -jnp.inf)
    sink = jnp.broadcast_to(sinks.astype(jnp.float32).reshape(HKV, G, 1, 1), logits.shape[:-1] + (1,))
    probs = jax.nn.softmax(jnp.concatenate([logits, sink], axis=-1), axis=-1)[..., :-1]
    out = jnp.einsum("bnhgqk,bnkhd->bnqhgd", probs.astype(v.dtype), vw)
    return out.reshape(B, S, HQ * D)


def memory_cross_attention(q, k, v):
    B, S, H, D = q.shape
    logits = jnp.einsum("bshd,bmhd->bhsm", q, k).astype(jnp.float32) * (D ** -0.5)
    probs = jax.nn.softmax(logits, axis=-1)
    return jnp.einsum("bhsm,bmhd->bshd", probs.astype(v.dtype), v).reshape(B, S, H * D)


def setup_inputs(seed: int = 0) -> dict:
    key = jax.random.key(seed)
    ks = jax.random.split(key, 24)
    f32 = jnp.float32
    L = DEPTH

    def nrm(k, shape, scale):
        return jax.random.normal(k, shape, f32) * scale

    def gain(k, shape):
        return 1.0 + 0.02 * jax.random.normal(k, shape, f32)

    dt = jnp.exp(jax.random.uniform(ks[23], (L, N_DN_HEADS), f32, math.log(DT_MIN), math.log(DT_MAX)))
    return {
        "x": nrm(ks[0], (BATCH, SEQ, D_MODEL), 1.0),
        "mem": nrm(ks[1], (BATCH, MEM_LEN, D_MODEL), 1.0),
        "attn_norm_w": gain(ks[2], (L, D_MODEL)),
        "w_in": nrm(ks[3], (L, D_MODEL, IN_WIDTH), D_MODEL ** -0.5),
        "dn_conv_w": nrm(ks[4], (L, DN_CONV, DN_QKV_WIDTH), DN_CONV ** -0.5),
        "dn_A_log": jnp.log(jax.random.uniform(ks[5], (L, N_DN_HEADS), f32, 1.0, 16.0)),
        "dn_dt_bias": dt + jnp.log(-jnp.expm1(-dt)),
        "dn_out_norm_w": gain(ks[6], (L, DN_HEAD_DIM)),
        "swa_q_norm_w": gain(ks[7], (L, SWA_HEAD_DIM)),
        "swa_k_norm_w": gain(ks[8], (L, SWA_HEAD_DIM)),
        "swa_sinks": nrm(ks[9], (L, N_SWA_HEADS), 0.5),
        "rel_bias": nrm(ks[10], (N_BUCKETS, N_SWA_HEADS), 0.5),
        "mem_norm_w": gain(ks[11], (L, D_MODEL)),
        "w_mem_kv": nrm(ks[12], (L, D_MODEL, 2 * MEM_WIDTH), D_MODEL ** -0.5),
        "xq_norm_w": gain(ks[13], (L, MEM_HEAD_DIM)),
        "xk_norm_w": gain(ks[14], (L, MEM_HEAD_DIM)),
        "p_dn": nrm(ks[15], (L, DN_WIDTH, D_MODEL), DN_WIDTH ** -0.5),
        "p_swa": nrm(ks[16], (L, SWA_WIDTH, D_MODEL), SWA_WIDTH ** -0.5),
        "p_mem": nrm(ks[17], (L, MEM_WIDTH, D_MODEL), MEM_WIDTH ** -0.5),
        "w_out": nrm(ks[18], (L, D_MODEL, D_MODEL), D_MODEL ** -0.5),
        "mlp_norm_w": gain(ks[19], (L, D_MODEL)),
        "w_mlp_up": nrm(ks[20], (L, D_MODEL, D_FF), D_MODEL ** -0.5),
        "w_mlp_down": nrm(ks[21], (L, D_FF, D_MODEL), D_FF ** -0.5),
    }


def reference(x, mem, attn_norm_w, w_in, dn_conv_w, dn_A_log, dn_dt_bias, dn_out_norm_w,
              swa_q_norm_w, swa_k_norm_w, swa_sinks, rel_bias, mem_norm_w, w_mem_kv,
              xq_norm_w, xk_norm_w, p_dn, p_swa, p_mem, w_out, mlp_norm_w, w_mlp_up, w_mlp_down):
    B, S, _ = x.shape
    M = mem.shape[1]
    f32 = jnp.float32
    for l in range(DEPTH):
        h = rms_norm(x, attn_norm_w[l])
        proj = h @ w_in[l]
        dn_qkv, dn_z, dn_b, dn_a, sq, sk, sv, mq, gate_logits = jnp.split(proj, IN_SPLITS, axis=-1)

        qkv = jax.nn.silu(causal_depthwise_conv(dn_qkv, dn_conv_w[l]))
        q_dn, k_dn, v_dn = jnp.split(qkv, 3, axis=-1)
        q_dn = l2_norm(q_dn.reshape(B, S, N_DN_HEADS, DN_HEAD_DIM)) * (DN_HEAD_DIM ** -0.5)
        k_dn = l2_norm(k_dn.reshape(B, S, N_DN_HEADS, DN_HEAD_DIM))
        v_dn = v_dn.reshape(B, S, N_DN_HEADS, DN_HEAD_DIM).astype(f32)
        beta = jax.nn.sigmoid(dn_b.astype(f32))
        g = -jnp.exp(dn_A_log[l].astype(f32)) * jax.nn.softplus(dn_a.astype(f32) + dn_dt_bias[l].astype(f32))
        o_dn = gated_delta_rule(q_dn, k_dn, v_dn, beta, g)
        z = dn_z.reshape(B, S, N_DN_HEADS, DN_HEAD_DIM).astype(f32)
        o_dn = (rms_norm(o_dn, dn_out_norm_w[l]) * jax.nn.silu(z)).astype(x.dtype).reshape(B, S, DN_WIDTH)

        q_s = rms_norm(sq.reshape(B, S, N_SWA_HEADS, SWA_HEAD_DIM), swa_q_norm_w[l])
        k_s = rms_norm(sk.reshape(B, S, N_SWA_KV, SWA_HEAD_DIM), swa_k_norm_w[l])
        v_s = sv.reshape(B, S, N_SWA_KV, SWA_HEAD_DIM)
        o_swa = sliding_window_attention(q_s, k_s, v_s, swa_sinks[l], rel_bias)

        mkv = rms_norm(mem, mem_norm_w[l]) @ w_mem_kv[l]
        mk, mv = jnp.split(mkv, 2, axis=-1)
        q_m = rms_norm(mq.reshape(B, S, N_MEM_HEADS, MEM_HEAD_DIM), xq_norm_w[l])
        k_m = rms_norm(mk.reshape(B, M, N_MEM_HEADS, MEM_HEAD_DIM), xk_norm_w[l])
        v_m = mv.reshape(B, M, N_MEM_HEADS, MEM_HEAD_DIM)
        o_mem = memory_cross_attention(q_m, k_m, v_m)

        gates = jax.nn.sigmoid(gate_logits.astype(f32)).astype(x.dtype).reshape(B, S, N_BRANCHES, D_MODEL)
        merged = (gates[:, :, 0] * (o_dn @ p_dn[l])
                  + gates[:, :, 1] * (o_swa @ p_swa[l])
                  + gates[:, :, 2] * (o_mem @ p_mem[l]))
        x = x + merged @ w_out[l]

        h2 = rms_norm(x, mlp_norm_w[l])
        x = x + jnp.square(jax.nn.relu(h2 @ w_mlp_up[l])) @ w_mlp_down[l]
    return x
```

```cpp
#include <hip/hip_runtime.h>
#include <cstdio>
#include <cstdint>
namespace pg8 {
#define PG8_LAS __attribute__((address_space(3)))
typedef unsigned short bf16_t;
typedef short bf16x8 __attribute__((ext_vector_type(8)));
typedef float f32x4 __attribute__((ext_vector_type(4)));
typedef unsigned u32x4 __attribute__((ext_vector_type(4)));
constexpr int BM = 256, BK = 64, HALF = 128, HTB = HALF * BK * 2  , STAGE_BYTES = 8 * HTB, NXCD = 8, WGM = 8;

__host__ __device__ __forceinline__ int lds_byte(int r, int c) { const int st = (r >> 4) * 2 + (c >> 5), rr = r & 15, cc = c & 31, ob = rr * 64 + cc * 2; return st * 1024 + (ob ^ (((ob >> 9) & 1) << 5)); }
__host__ __device__ __forceinline__ void stage_rc(int b, int& R, int& C) { const int st = b / 1024, sb = b % 1024, swz = sb ^ (((sb >> 9) & 1) << 5); R = (st >> 1) * 16 + swz / 64; C = (st & 1) * 32 + (swz % 64) / 2; }
__host__ __device__ __forceinline__ int perm32(int rho) { const int n = rho >> 4, i = rho & 15; return 8 * (i >> 2) + 4 * n + (i & 3); }

struct Unit { int pm, pn; };
struct Gemm { const bf16_t* A; const bf16_t* Bt; int M, N, K; };

struct StaticOrder {
    int nM, nN, nwg, G, c;
    __host__ __device__ void init(int M, int N, int G_, int c_) { nM = M / BM; nN = N / BM; nwg = nM * nN; G = G_; c = c_; }
    __host__ __device__ bool next(int i, Unit& u) const {
        const long L = (long)i * G + c; if (L >= nwg) return false;
        int wgid = (int)L; { const int q = nwg / NXCD, r = nwg % NXCD, xcd = wgid % NXCD, off = wgid / NXCD; wgid = (xcd < r ? xcd * (q + 1) : r * (q + 1) + (xcd - r) * q) + off; }
        const int nig = WGM * nN, gid = wgid / nig, fm = gid * WGM, gsz = (nM - fm) < WGM ? (nM - fm) : WGM;
        u.pm = fm + ((wgid % nig) % gsz); u.pn = (wgid % nig) / gsz; return true;
    }
    __device__ __forceinline__ void a_ready(const Unit&) const {}
    __device__ __forceinline__ void done(const Unit&) const {}
};

__device__ __forceinline__ unsigned cvt_pk_bf16(float lo, float hi) { unsigned r; asm volatile("v_cvt_pk_bf16_f32 %0, %1, %2" : "=v"(r) : "v"(lo), "v"(hi)); return r; }
typedef float f32x2 __attribute__((ext_vector_type(2)));
__device__ __forceinline__ f32x2 gelu_pk(f32x2 v) {
    const f32x2 av = __builtin_elementwise_abs(v), d = av * 0.2316418882f + 1.0f;
    f32x2 t; t.x = __builtin_amdgcn_rcpf(d.x); t.y = __builtin_amdgcn_rcpf(d.y);
    f32x2 q = t * 0.5307027145f + (-0.7265760135f); q = q * t + 0.7107068705f; q = q * t + (-0.142248368f); q = q * t + 0.127414796f; q = q * t;
    const f32x2 s = (v * v) * (-0.72134752044f);
    f32x2 e; e.x = __builtin_amdgcn_exp2f(s.x); e.y = __builtin_amdgcn_exp2f(s.y);
    const f32x2 m = v * (q * e), r = v - m;
    f32x2 o; o.x = v.x < 0.f ? m.x : r.x; o.y = v.y < 0.f ? m.y : r.y; return o;
}

template <int ACT  > struct EpiBf16 {
    static constexpr bool PERM = true, AFTER_DRAIN = false; static_assert(ACT == 0 || ACT == 1, "EpiBf16: ACT is 0 (none) or 1 (gelu_pk)");
    bf16_t* O; int ldc; const float* bias; int split_cols; size_t split_stride; float scale0;
    __device__ __forceinline__ void operator()(const f32x4 (&acc)[2][2][4][2], const Unit& u, int wr, int wc, int fr, int fq) const {
        const int row0 = u.pm * BM + wr * 64 + fr; int colt = u.pn * BM; bf16_t* base = O;
        float sc = 1.f; if (split_cols) { const int t = colt / split_cols; base += (size_t)t * split_stride; colt -= t * split_cols; if (t == 0) sc = scale0; }
        const int col0 = colt + wc * 32 + 8 * fq, bcol0 = u.pn * BM + wc * 32 + 8 * fq;
        f32x4 bv[2][2];
#pragma unroll
        for (int bj = 0; bj < 2; ++bj)
#pragma unroll
            for (int n = 0; n < 2; ++n) bv[bj][n] = bias ? *(const f32x4*)(bias + bcol0 + bj * HALF + 4 * n) : (f32x4){0.f, 0.f, 0.f, 0.f};
#pragma unroll
        for (int ai = 0; ai < 2; ++ai)
#pragma unroll
            for (int m = 0; m < 4; ++m) { bf16_t* rowp = base + (size_t)(row0 + ai * HALF + m * 16) * ldc + col0;
#pragma unroll
                for (int bj = 0; bj < 2; ++bj) { f32x4 v0 = acc[ai][bj][m][0] + bv[bj][0], v1 = acc[ai][bj][m][1] + bv[bj][1];
                    if (ACT == 1) { f32x2 a = gelu_pk((f32x2){v0[0], v0[1]}), b = gelu_pk((f32x2){v0[2], v0[3]}), c = gelu_pk((f32x2){v1[0], v1[1]}), d = gelu_pk((f32x2){v1[2], v1[3]});
                        v0 = (f32x4){a.x, a.y, b.x, b.y}; v1 = (f32x4){c.x, c.y, d.x, d.y}; }
                    v0 = v0 * sc; v1 = v1 * sc; u32x4 w; w.x = cvt_pk_bf16(v0[0], v0[1]); w.y = cvt_pk_bf16(v0[2], v0[3]); w.z = cvt_pk_bf16(v1[0], v1[1]); w.w = cvt_pk_bf16(v1[2], v1[3]);
                    *(u32x4*)(rowp + bj * HALF) = w; } }
    }
};
template <class Epi, class Sched, bool ALIGN_EPI = false, bool SP2 = false>
__device__ __forceinline__ void gemm_phase(PG8_LAS unsigned char* lds, const Gemm g, const Sched& S, const Epi& E) {
    const int tid = threadIdx.x, wid = __builtin_amdgcn_readfirstlane(tid >> 6), lane = tid & 63, wr = wid >> 2, wc = wid & 3, fr = lane & 15, fq = lane >> 4;
    const int K = g.K, nt = K / BK;
    unsigned voffA[2], voffB[2];
#pragma unroll
    for (int i = 0; i < 2; ++i) { int R, C; stage_rc(tid * 16 + i * 8192, R, C); const int Rb = Epi::PERM ? ((R & ~31) + perm32(R & 31)) : R;
        voffA[i] = (unsigned)(R * K + C) * 2u; voffB[i] = (unsigned)(Rb * K + C) * 2u; }
    const size_t kstep = (size_t)(BK * 2);
    const size_t hstep = (size_t)HALF * K * 2;
    const size_t tstep = 2 * hstep;
    const unsigned ldsw = (unsigned)wid * 1024u;
    const int aoff = lds_byte(wr * 64 + fr, fq * 8), boff = lds_byte(wc * 32 + fr, fq * 8);
#define PG8_SA(b, h) (((b) * 2 + (h)) * HTB)
#define PG8_SB(b, h) ((4 + (b) * 2 + (h)) * HTB)
#define PG8_STAGE(bufoff, gbase, voff) do { _Pragma("unroll") for (int _i = 0; _i < 2; ++_i) \
        __builtin_amdgcn_global_load_lds((const unsigned*)((const char*)(gbase) + (voff)[_i]), (PG8_LAS unsigned*)(lds + (bufoff) + ldsw + _i * 8192), 16, 0, 0); } while (0)
#define PG8_LDA(dst, b, h) do { _Pragma("unroll") for (int m = 0; m < 4; ++m) _Pragma("unroll") for (int k = 0; k < 2; ++k) dst[m][k] = *(const PG8_LAS bf16x8*)(lds + PG8_SA(b, h) + aoff + m * 2048 + k * 1024); } while (0)
#define PG8_LDB(dst, b, h) do { _Pragma("unroll") for (int n = 0; n < 2; ++n) _Pragma("unroll") for (int k = 0; k < 2; ++k) dst[n][k] = *(const PG8_LAS bf16x8*)(lds + PG8_SB(b, h) + boff + n * 2048 + k * 1024); } while (0)
#define PG8_MMA(ai, bj, At, Bt) do { __builtin_amdgcn_s_setprio(1); _Pragma("unroll") for (int m = 0; m < 4; ++m) _Pragma("unroll") for (int n = 0; n < 2; ++n) _Pragma("unroll") for (int k = 0; k < 2; ++k) \
        acc[ai][bj][m][n] = __builtin_amdgcn_mfma_f32_16x16x32_bf16(Bt[n][k], At[m][k], acc[ai][bj][m][n], 0, 0, 0); __builtin_amdgcn_s_setprio(0); } while (0)
#define PG8_WAIT_V(n) asm volatile("s_waitcnt vmcnt(" #n ")" ::: "memory")
#define PG8_WAIT_L(n) asm volatile("s_waitcnt lgkmcnt(" #n ")" ::: "memory")
#define PG8_BAR __builtin_amdgcn_s_barrier()
#define PG8_SCHED __builtin_amdgcn_sched_barrier(0)
    Unit cur, nxt; int ui = 0;
    if (!S.next(0, cur)) return;
    f32x4 acc[2][2][4][2];
#pragma unroll
    for (int a = 0; a < 2; ++a)
#pragma unroll
        for (int b = 0; b < 2; ++b)
#pragma unroll
            for (int m = 0; m < 4; ++m)
#pragma unroll
                for (int n = 0; n < 2; ++n) acc[a][b][m][n] = (f32x4){0.f, 0.f, 0.f, 0.f};
    bf16x8 At[4][2], B0[2][2], B1[2][2];
    const char* cA = (const char*)g.A + (size_t)cur.pm * tstep; const char* cB = (const char*)g.Bt + (size_t)cur.pn * tstep;
    S.a_ready(cur);
    if constexpr (SP2) {
        PG8_STAGE(PG8_SB(0, 0), cB, voffB); PG8_STAGE(PG8_SB(0, 1), cB + hstep, voffB); PG8_STAGE(PG8_SA(0, 0), cA, voffA); PG8_STAGE(PG8_SA(0, 1), cA + hstep, voffA);
        if (wr == 1) PG8_BAR;
        PG8_WAIT_V(2); PG8_BAR;
        PG8_STAGE(PG8_SB(1, 0), cB + kstep, voffB); PG8_STAGE(PG8_SA(1, 0), cA + kstep, voffA); PG8_STAGE(PG8_SB(1, 1), cB + hstep + kstep, voffB);
        PG8_WAIT_V(6); PG8_BAR;
    } else {
        PG8_STAGE(PG8_SB(0, 0), cB, voffB); PG8_STAGE(PG8_SA(0, 0), cA, voffA); PG8_STAGE(PG8_SB(0, 1), cB + hstep, voffB); PG8_STAGE(PG8_SA(0, 1), cA + hstep, voffA);
        if (wr == 1) PG8_BAR;
        PG8_WAIT_V(4); PG8_BAR;
        PG8_STAGE(PG8_SB(1, 0), cB + kstep, voffB); PG8_STAGE(PG8_SA(1, 0), cA + kstep, voffA); PG8_STAGE(PG8_SB(1, 1), cB + hstep + kstep, voffB);
        PG8_WAIT_V(6); PG8_BAR;
    }
    for (;;) {
        const bool has_next = S.next(ui + 1, nxt);
        const char* nA = has_next ? (const char*)g.A + (size_t)nxt.pm * tstep : cA; const char* nB = has_next ? (const char*)g.Bt + (size_t)nxt.pn * tstep : cB;
        for (int t = 0; t < nt; t += 2) {
            const bool last = (t == nt - 2);
            const char* a1 = cA + (size_t)(t + 1) * kstep;
            const char* a2 = last ? nA : cA + (size_t)(t + 2) * kstep; const char* b2 = last ? nB : cB + (size_t)(t + 2) * kstep;
            const char* a3 = a2 + kstep; const char* b3 = b2 + kstep;
            if (last && has_next) S.a_ready(nxt);
            if constexpr (SP2) {
            PG8_LDB(B0, 0, 0); PG8_LDB(B1, 0, 1); PG8_SCHED; PG8_LDA(At, 0, 0); PG8_STAGE(PG8_SA(1, 1), a1 + hstep, voffA);
            PG8_WAIT_V(8); PG8_WAIT_L(0); PG8_BAR; PG8_MMA(0, 0, At, B0); PG8_MMA(0, 1, At, B1); PG8_BAR; PG8_SCHED;
            PG8_LDA(At, 0, 1); PG8_STAGE(PG8_SB(0, 0), b2, voffB); PG8_STAGE(PG8_SB(0, 1), b2 + hstep, voffB); PG8_STAGE(PG8_SA(0, 0), a2, voffA);
            PG8_WAIT_V(8); PG8_WAIT_L(0); PG8_BAR; PG8_MMA(1, 0, At, B0); PG8_MMA(1, 1, At, B1); PG8_BAR; PG8_SCHED;
            PG8_LDB(B0, 1, 0); PG8_LDB(B1, 1, 1); PG8_SCHED; PG8_LDA(At, 1, 0); PG8_STAGE(PG8_SA(0, 1), a2 + hstep, voffA);
            PG8_WAIT_V(8); PG8_WAIT_L(0); PG8_BAR; PG8_MMA(0, 0, At, B0); PG8_MMA(0, 1, At, B1); PG8_BAR; PG8_SCHED;
            PG8_LDA(At, 1, 1); PG8_STAGE(PG8_SB(1, 0), b3, voffB); PG8_STAGE(PG8_SB(1, 1), b3 + hstep, voffB); PG8_STAGE(PG8_SA(1, 0), a3, voffA);
            PG8_WAIT_V(8); PG8_WAIT_L(0); PG8_BAR; PG8_MMA(1, 0, At, B0); PG8_MMA(1, 1, At, B1); PG8_BAR; PG8_SCHED;
            } else {
            PG8_LDB(B0, 0, 0); PG8_SCHED; PG8_LDA(At, 0, 0); PG8_STAGE(PG8_SA(1, 1), a1 + hstep, voffA);
            PG8_WAIT_L(8); PG8_BAR; PG8_WAIT_L(0); PG8_MMA(0, 0, At, B0); PG8_BAR; PG8_SCHED;
            PG8_LDB(B1, 0, 1); PG8_STAGE(PG8_SB(0, 0), b2, voffB);
            PG8_BAR; PG8_WAIT_L(0); PG8_MMA(0, 1, At, B1); PG8_BAR;
            PG8_LDA(At, 0, 1); PG8_STAGE(PG8_SA(0, 0), a2, voffA);
            PG8_BAR; PG8_WAIT_L(0); PG8_MMA(1, 0, At, B0); PG8_BAR; PG8_SCHED;
            PG8_STAGE(PG8_SB(0, 1), b2 + hstep, voffB);
            PG8_WAIT_V(6); PG8_BAR; PG8_MMA(1, 1, At, B1); PG8_BAR;
            PG8_LDB(B0, 1, 0); PG8_SCHED; PG8_LDA(At, 1, 0); PG8_STAGE(PG8_SA(0, 1), a2 + hstep, voffA);
            PG8_WAIT_L(8); PG8_BAR; PG8_WAIT_L(0); PG8_MMA(0, 0, At, B0); PG8_BAR; PG8_SCHED;
            PG8_LDB(B1, 1, 1); PG8_STAGE(PG8_SB(1, 0), b3, voffB);
            PG8_BAR; PG8_WAIT_L(0); PG8_MMA(0, 1, At, B1); PG8_BAR;
            PG8_LDA(At, 1, 1); PG8_STAGE(PG8_SA(1, 0), a3, voffA);
            PG8_BAR; PG8_WAIT_L(0); PG8_MMA(1, 0, At, B0); PG8_BAR; PG8_SCHED;
            PG8_STAGE(PG8_SB(1, 1), b3 + hstep, voffB);
            PG8_WAIT_V(6); PG8_BAR; PG8_MMA(1, 1, At, B1); PG8_BAR;
            }
        }
        if constexpr (ALIGN_EPI) { if (wr == 0) PG8_BAR; }
        if constexpr (!Epi::AFTER_DRAIN) { E(acc, cur, wr, wc, fr, fq); S.done(cur); }
        if (!has_next) break;
#pragma unroll
        for (int a = 0; a < 2; ++a)
#pragma unroll
            for (int b = 0; b < 2; ++b)
#pragma unroll
                for (int m = 0; m < 4; ++m)
#pragma unroll
                    for (int n = 0; n < 2; ++n) acc[a][b][m][n] = (f32x4){0.f, 0.f, 0.f, 0.f};
        cur = nxt; cA = nA; cB = nB; ++ui;
        if constexpr (ALIGN_EPI) { if (wr == 1) PG8_BAR; }
    }
    PG8_WAIT_V(0);
    if constexpr (!ALIGN_EPI) { if (wr == 0) PG8_BAR; }
    PG8_BAR;
    if constexpr (Epi::AFTER_DRAIN) { E.fused(acc, cur, wr, wc, fr, fq, lds, wid, lane); S.done(cur); }
#undef PG8_SA
#undef PG8_SB
#undef PG8_STAGE
#undef PG8_LDA
#undef PG8_LDB
#undef PG8_MMA
#undef PG8_WAIT_V
#undef PG8_WAIT_L
#undef PG8_BAR
#undef PG8_SCHED
}
}

namespace pg8 {
typedef float f32x2e __attribute__((ext_vector_type(2))); typedef __bf16 bf16x2e __attribute__((ext_vector_type(2)));
__device__ __forceinline__ unsigned cvtpk(float lo, float hi) { f32x2e v = {lo, hi}; bf16x2e b = __builtin_convertvector(v, bf16x2e); return __builtin_bit_cast(unsigned, b); }
__device__ __forceinline__ float bflo(unsigned u) { return __builtin_bit_cast(float, u << 16); }
__device__ __forceinline__ float bfhi(unsigned u) { return __builtin_bit_cast(float, u & 0xffff0000u); }
__device__ __forceinline__ float sigm(float v) { return 1.0f / (1.0f + __expf(-v)); }

struct EpiProj {
    static constexpr bool PERM = true, AFTER_DRAIN = false;
    bf16_t* proj; bf16_t* gates; int ldp, ldg;
    __device__ __forceinline__ void operator()(const f32x4 (&acc)[2][2][4][2], const Unit& u, int wr, int wc, int fr, int fq) const {
        const int row0 = u.pm * BM + wr * 64 + fr; const int pn = u.pn; const bool isg = (pn >= 18 && pn < 42);
        bf16_t* base = isg ? gates : proj; const int ld = isg ? ldg : ldp; const int colt = isg ? (pn - 18) * BM : (pn == 42 ? 18 : pn) * BM;
        const int col0 = colt + wc * 32 + 8 * fq;
#pragma unroll
        for (int ai = 0; ai < 2; ++ai)
#pragma unroll
            for (int m = 0; m < 4; ++m) { bf16_t* rowp = base + (size_t)(row0 + ai * HALF + m * 16) * ld + col0;
#pragma unroll
                for (int bj = 0; bj < 2; ++bj) { f32x4 v0 = acc[ai][bj][m][0], v1 = acc[ai][bj][m][1];
                    if (isg) { v0 = (f32x4){sigm(v0[0]), sigm(v0[1]), sigm(v0[2]), sigm(v0[3])}; v1 = (f32x4){sigm(v1[0]), sigm(v1[1]), sigm(v1[2]), sigm(v1[3])}; }
                    u32x4 w; w.x = cvtpk(v0[0], v0[1]); w.y = cvtpk(v0[2], v0[3]); w.z = cvtpk(v1[0], v1[1]); w.w = cvtpk(v1[2], v1[3]);
                    *(u32x4*)(rowp + bj * HALF) = w; } }
    }
};
struct EpiPlain {
    static constexpr bool PERM = true, AFTER_DRAIN = false;
    bf16_t* O; int ldc;
    __device__ __forceinline__ void operator()(const f32x4 (&acc)[2][2][4][2], const Unit& u, int wr, int wc, int fr, int fq) const {
        const int row0 = u.pm * BM + wr * 64 + fr; const int col0 = u.pn * BM + wc * 32 + 8 * fq;
#pragma unroll
        for (int ai = 0; ai < 2; ++ai)
#pragma unroll
            for (int m = 0; m < 4; ++m) { bf16_t* rowp = O + (size_t)(row0 + ai * HALF + m * 16) * ldc + col0;
#pragma unroll
                for (int bj = 0; bj < 2; ++bj) { const f32x4 v0 = acc[ai][bj][m][0], v1 = acc[ai][bj][m][1];
                    u32x4 w; w.x = cvtpk(v0[0], v0[1]); w.y = cvtpk(v0[2], v0[3]); w.z = cvtpk(v1[0], v1[1]); w.w = cvtpk(v1[2], v1[3]);
                    *(u32x4*)(rowp + bj * HALF) = w; } }
    }
};
template <int NH, int SEQL> struct EpiVt {
    static constexpr bool PERM = true, AFTER_DRAIN = false;
    unsigned char* vt;
    __device__ __forceinline__ void operator()(const f32x4 (&acc)[2][2][4][2], const Unit& u, int wr, int wc, int fr, int fq) const {
        constexpr int NKT = SEQL / 32;
        const int row0 = u.pm * BM + wr * 64 + fr; const int col0 = u.pn * BM + wc * 32 + 8 * fq;
#pragma unroll
        for (int ai = 0; ai < 2; ++ai)
#pragma unroll
            for (int m = 0; m < 4; ++m) { const int drow = row0 + ai * HALF + m * 16; const int hh = drow >> 7, d = drow & 127, dt = d >> 5, dl = d & 31;
#pragma unroll
                for (int bj = 0; bj < 2; ++bj) { const int t0 = col0 + bj * HALF; const int b = t0 / SEQL, tt = t0 % SEQL, kt = tt >> 5, s = (tt >> 4) & 1, o8 = (tt >> 3) & 1;
                    const size_t blk = ((((size_t)(b * NH + hh) * NKT + kt) * 2 + s) * 4 + dt);
                    unsigned char* p = vt + blk * 1024 + dl * 16 + o8 * 8;
                    const f32x4 v0 = acc[ai][bj][m][0], v1 = acc[ai][bj][m][1];
                    unsigned long long w0 = (unsigned long long)cvtpk(v0[0], v0[1]) | ((unsigned long long)cvtpk(v0[2], v0[3]) << 32);
                    unsigned long long w1 = (unsigned long long)cvtpk(v1[0], v1[1]) | ((unsigned long long)cvtpk(v1[2], v1[3]) << 32);
                    *(unsigned long long*)p = w0; *(unsigned long long*)(p + 512) = w1; } }
    }
};
template <int PASS> struct EpiMerge {
    static constexpr bool PERM = true, AFTER_DRAIN = false;
    const bf16_t* gates; float* scr; bf16_t* merged; int ldg, ldc;
    __device__ __forceinline__ void operator()(const f32x4 (&acc)[2][2][4][2], const Unit& u, int wr, int wc, int fr, int fq) const {
        const int row0 = u.pm * BM + wr * 64 + fr; const int col0 = u.pn * BM + wc * 32 + 8 * fq;
#pragma unroll
        for (int ai = 0; ai < 2; ++ai)
#pragma unroll
            for (int m = 0; m < 4; ++m) { const size_t r = (size_t)(row0 + ai * HALF + m * 16);
#pragma unroll
                for (int bj = 0; bj < 2; ++bj) { const int c = col0 + bj * HALF;
                    const u32x4 g = *(const u32x4*)(gates + r * ldg + c);
                    f32x4 v0 = acc[ai][bj][m][0], v1 = acc[ai][bj][m][1];
                    v0 = v0 * (f32x4){bflo(g.x), bfhi(g.x), bflo(g.y), bfhi(g.y)}; v1 = v1 * (f32x4){bflo(g.z), bfhi(g.z), bflo(g.w), bfhi(g.w)};
                    float* sp = scr + r * ldc + c;
                    if (PASS >= 1) { v0 = v0 + *(const f32x4*)sp; v1 = v1 + *(const f32x4*)(sp + 4); }
                    if (PASS <= 1) { *(f32x4*)sp = v0; *(f32x4*)(sp + 4) = v1; }
                    else { u32x4 w; w.x = cvtpk(v0[0], v0[1]); w.y = cvtpk(v0[2], v0[3]); w.z = cvtpk(v1[0], v1[1]); w.w = cvtpk(v1[2], v1[3]); *(u32x4*)(merged + r * ldc + c) = w; } } }
    }
};
struct EpiOut {
    static constexpr bool PERM = true, AFTER_DRAIN = false;
    const float* x; float* out; bf16_t* xn2; float* ssq; int ldc;
    __device__ __forceinline__ void operator()(const f32x4 (&acc)[2][2][4][2], const Unit& u, int wr, int wc, int fr, int fq) const {
        const int row0 = u.pm * BM + wr * 64 + fr; const int col0 = u.pn * BM + wc * 32 + 8 * fq;
#pragma unroll
        for (int ai = 0; ai < 2; ++ai)
#pragma unroll
            for (int m = 0; m < 4; ++m) { const size_t r = (size_t)(row0 + ai * HALF + m * 16); float rs = 0.f;
#pragma unroll
                for (int bj = 0; bj < 2; ++bj) { const int c = col0 + bj * HALF; const size_t off = r * ldc + c;
                    const f32x4 v0 = acc[ai][bj][m][0] + *(const f32x4*)(x + off), v1 = acc[ai][bj][m][1] + *(const f32x4*)(x + off + 4);
                    *(f32x4*)(out + off) = v0; *(f32x4*)(out + off + 4) = v1;
                    rs += (v0[0] * v0[0] + v0[1] * v0[1]) + (v0[2] * v0[2] + v0[3] * v0[3]) + (v1[0] * v1[0] + v1[1] * v1[1]) + (v1[2] * v1[2] + v1[3] * v1[3]);
                    u32x4 w; w.x = cvtpk(v0[0], v0[1]); w.y = cvtpk(v0[2], v0[3]); w.z = cvtpk(v1[0], v1[1]); w.w = cvtpk(v1[2], v1[3]); *(u32x4*)(xn2 + off) = w; }
                rs += __shfl_xor(rs, 16); rs += __shfl_xor(rs, 32);
                if (fq == 0) atomicAdd(ssq + r, rs); }
    }
};
struct EpiUp {
    static constexpr bool PERM = true, AFTER_DRAIN = false;
    const float* ssq; bf16_t* H; int ldc; float inv_d, eps;
    __device__ __forceinline__ void operator()(const f32x4 (&acc)[2][2][4][2], const Unit& u, int wr, int wc, int fr, int fq) const {
        const int row0 = u.pm * BM + wr * 64 + fr; const int col0 = u.pn * BM + wc * 32 + 8 * fq;
#pragma unroll
        for (int ai = 0; ai < 2; ++ai)
#pragma unroll
            for (int m = 0; m < 4; ++m) { const size_t r = (size_t)(row0 + ai * HALF + m * 16); const float rstd = 1.0f / sqrtf(ssq[r] * inv_d + eps);
#pragma unroll
                for (int bj = 0; bj < 2; ++bj) { const int c = col0 + bj * HALF;
                    f32x4 v0 = acc[ai][bj][m][0] * rstd, v1 = acc[ai][bj][m][1] * rstd;
                    v0 = __builtin_elementwise_max(v0, (f32x4){0.f, 0.f, 0.f, 0.f}); v1 = __builtin_elementwise_max(v1, (f32x4){0.f, 0.f, 0.f, 0.f});
                    v0 = v0 * v0; v1 = v1 * v1;
                    u32x4 w; w.x = cvtpk(v0[0], v0[1]); w.y = cvtpk(v0[2], v0[3]); w.z = cvtpk(v1[0], v1[1]); w.w = cvtpk(v1[2], v1[3]); *(u32x4*)(H + r * ldc + c) = w; } }
    }
};
struct EpiDown {
    static constexpr bool PERM = false, AFTER_DRAIN = false;
    float* out; int ldc;
    __device__ __forceinline__ void operator()(const f32x4 (&acc)[2][2][4][2], const Unit& u, int wr, int wc, int fr, int fq) const {
        const int row0 = u.pm * BM + wr * 64 + fr; const int col0 = u.pn * BM + wc * 32 + 4 * fq;
#pragma unroll
        for (int ai = 0; ai < 2; ++ai)
#pragma unroll
            for (int m = 0; m < 4; ++m) { const size_t r = (size_t)(row0 + ai * HALF + m * 16);
#pragma unroll
                for (int bj = 0; bj < 2; ++bj)
#pragma unroll
                    for (int n = 0; n < 2; ++n) { float* p = out + r * ldc + col0 + bj * HALF + n * 16; *(f32x4*)p = *(const f32x4*)p + acc[ai][bj][m][n]; } }
    }
};
}

constexpr int NWAVES = 8;
constexpr int DM = 2048, NBATCH = 4, SEQ = 2048, MT = NBATCH * SEQ;
constexpr int MEML = 256, MMEM = NBATCH * MEML;
constexpr int NIN = 11020;
constexpr int NMAIN = 11008;
constexpr int NWIN = 11264;
constexpr int LDP = 4864, LDG = 6144, DFF = 8192;
constexpr float EPS = 1e-6f;
constexpr float LOG2E = 1.4426950408889634f;
constexpr float QSCALE = 0.08838834764831845f * 1.4426950408889634f;
constexpr int PC_DNZ = 2304, PC_SQ = 3072, PC_SK = 3840, PC_MQ = 4096, PC_BA = 4608;
constexpr int NCHUNK = NBATCH * 6 * 32;
constexpr int CH_W = 0, CH_QG = 16384, CH_KD = 32768, CH_P = 49152, CH_U = 57344, CH_ZG = 73728, CH_BYTES = 90112;

constexpr size_t MiB = 1u << 20;
constexpr size_t WS_CTL = 0, CTL_ZERO_BYTES = 1 * MiB;
constexpr size_t WS_SSQ = 512 * 1024;
constexpr size_t WS_WOUT = 1 * MiB, WS_PDN = 9 * MiB, WS_PSWA = 12 * MiB, WS_PMEM = 15 * MiB;
constexpr size_t WS_WIN = 17 * MiB, WS_WMKV = 61 * MiB, WS_MEMN = 65 * MiB;
constexpr size_t WS_DNF = 17 * MiB;
constexpr size_t WS_WUP = 17 * MiB, WS_WDN = 49 * MiB;
constexpr size_t WS_XN = 85 * MiB;
constexpr size_t WS_PROJ = 117 * MiB;
constexpr size_t WS_ODN = 117 * MiB, WS_OSWA = 129 * MiB, WS_OMEM = 141 * MiB, WS_MERGED = 149 * MiB;
constexpr size_t WS_GATES = 193 * MiB;
constexpr size_t WS_VT = 289 * MiB, WS_MVT = 293 * MiB, WS_MEMK = 294 * MiB;
constexpr size_t WS_QF = 295 * MiB, WS_KF = 307 * MiB, WS_MQF = 311 * MiB, WS_MKF = 319 * MiB, WS_GC = 320 * MiB;
constexpr size_t WS_H = 117 * MiB;
constexpr size_t WS_END = 321 * MiB;
static_assert(WS_DNF + (size_t)NCHUNK * CH_BYTES <= WS_XN && WS_PROJ + (size_t)MT * LDP * 2 <= WS_GATES && WS_GATES + (size_t)MT * LDG * 2 <= WS_VT, "ws map");
static_assert(WS_H + (size_t)MT * DFF * 2 <= WS_VT && WS_WIN + (size_t)NWIN * DM * 2 <= WS_WMKV, "ws map 2");
constexpr int CW_BAR = 4096;

constexpr int RING_OFF = 0, RING_BYTES = 131072;
constexpr int LDSCTL_OFF = RING_BYTES, MISC_OFF = LDSCTL_OFF + 320;
constexpr int LDS_BYTES = 147456;
#define GAS __attribute__((address_space(1)))
#define LAS __attribute__((address_space(3)))
typedef unsigned short bf16;
typedef unsigned v4u __attribute__((ext_vector_type(4)));
typedef float f32x4 __attribute__((ext_vector_type(4)));
typedef short bf16x8 __attribute__((ext_vector_type(8)));
typedef GAS unsigned gu32;
typedef GAS unsigned long long gu64;
#define RLX_AGENT __ATOMIC_RELAXED, __HIP_MEMORY_SCOPE_AGENT
#define LDS_WAIT() asm volatile("s_waitcnt lgkmcnt(0)" ::: "memory")
#define VM_WAIT() asm volatile("s_waitcnt vmcnt(0)" ::: "memory")
__device__ __forceinline__ unsigned long long rt() { return __builtin_amdgcn_s_memrealtime(); }
__device__ __forceinline__ unsigned f2bf(float f) { unsigned u = __builtin_bit_cast(unsigned, f); return (u + 0x7fffu + ((u >> 16) & 1u)) >> 16; }
__device__ __forceinline__ unsigned pk2(float lo, float hi) { return f2bf(lo) | (f2bf(hi) << 16); }

#define XB_TMO      128
#define XB_XCNT(j)  (256  + 64 * (j))
#define XB_XSUB(j)  (1280 + 64 * (j))
#define XB_XGEN(j)  (2304 + 64 * (j))
#define XB_TOP      3328
#define XB_TOPGEN   3392
#define XCD_BAR_WORDS 3456
#define XB_SPIN_CAP (1u << 18)

__device__ __forceinline__ unsigned xb_ld(unsigned* p)              { return __hip_atomic_load(p, __ATOMIC_RELAXED, __HIP_MEMORY_SCOPE_AGENT); }
__device__ __forceinline__ unsigned xb_add(unsigned* p, unsigned v) { return __hip_atomic_fetch_add(p, v, __ATOMIC_RELAXED, __HIP_MEMORY_SCOPE_AGENT); }
__device__ __forceinline__ unsigned xb_xcc_id() { return (unsigned)__builtin_amdgcn_s_getreg((3 << 11) | 20) & 0xFu; }
#define XB_SPIN(cond, bar) do { unsigned _sp = 0; while (cond) { __builtin_amdgcn_s_sleep(1); \
    if ((++_sp & 255u) == 0u) { if (xb_ld(&(bar)[XB_TMO])) break; if (_sp > XB_SPIN_CAP) { atomicAdd(&(bar)[XB_TMO], 1u); break; } } } } while (0)

struct XcdBarrier {
    unsigned* bar; unsigned x;
    volatile LAS unsigned* st;
};

__device__ __forceinline__ XcdBarrier xcd_barrier_post(unsigned* bar, volatile LAS unsigned* st) {
    XcdBarrier b; b.bar = bar; b.x = xb_xcc_id(); b.st = st;
    if (threadIdx.x == 0) (void)xb_add(&bar[XB_XCNT(b.x)], 1u);
    return b;
}
__device__ __forceinline__ void xcd_barrier_complete(unsigned* bar, unsigned x, unsigned& nloc, unsigned& nx) {
    const unsigned G = gridDim.x * gridDim.y * gridDim.z;
    unsigned sum, cnt, mine, sp = 0u;
    for (;;) {
        sum = 0u; cnt = 0u; mine = 0u;
#pragma unroll
        for (unsigned j = 0; j < 16; ++j) { const unsigned c = xb_ld(&bar[XB_XCNT(j)]); sum += c; cnt += (c > 0u) ? 1u : 0u; mine = (j == x) ? c : mine; }
        if (sum == G) break;
        __builtin_amdgcn_s_sleep(1);
        if ((++sp & 255u) == 0u) { if (xb_ld(&bar[XB_TMO])) break; if (sp > XB_SPIN_CAP) { atomicAdd(&bar[XB_TMO], 1u); break; } }
    }
    nloc = mine > 0u ? mine : 1u; nx = cnt > 0u ? cnt : 1u;
}

__device__ __forceinline__ void xcd_barrier(const XcdBarrier& b) {
    asm volatile("s_waitcnt vmcnt(0)" ::: "memory");
    __syncthreads();
    if (threadIdx.x == 0) {
        unsigned* bar = b.bar;
        __builtin_amdgcn_s_waitcnt(0);
        unsigned nloc = b.st[0], nx = b.st[1];
        if (nloc == 0u) { xcd_barrier_complete(bar, b.x, nloc, nx); b.st[0] = nloc; b.st[1] = nx; }
        const unsigned old = xb_add(&bar[XB_XSUB(b.x)], 1u);
        const unsigned gen = old / nloc;
        if (old + 1u == (gen + 1u) * nloc) {
            __builtin_amdgcn_fence(__ATOMIC_RELEASE, "agent");
            asm volatile("s_waitcnt vmcnt(0)" ::: "memory");
            const unsigned og = xb_add(&bar[XB_TOP], 1u);
            const unsigned tg = og / nx;
            if (og + 1u == (tg + 1u) * nx) xb_add(&bar[XB_TOPGEN], 1u);
            else XB_SPIN(xb_ld(&bar[XB_TOPGEN]) == tg, bar);
            __builtin_amdgcn_fence(__ATOMIC_ACQUIRE, "agent");
            xb_add(&bar[XB_XGEN(b.x)], 1u);
            asm volatile("s_waitcnt vmcnt(0)" ::: "memory");
        } else {
            XB_SPIN(xb_ld(&bar[XB_XGEN(b.x)]) == gen, bar);
            __builtin_amdgcn_fence(__ATOMIC_ACQUIRE, "agent");
            asm volatile("s_waitcnt vmcnt(0)" ::: "memory");
        }
    }
    __syncthreads();
}

typedef unsigned v2u __attribute__((ext_vector_type(2)));
typedef float f32x16 __attribute__((ext_vector_type(16)));
using pg8::cvtpk; using pg8::bflo; using pg8::bfhi;
__device__ __forceinline__ float bf2f(unsigned short b) { return __builtin_bit_cast(float, (unsigned)b << 16); }
__device__ __forceinline__ float wave_sum(float v) {
#pragma unroll
    for (int o = 1; o < 64; o <<= 1) v += __shfl_xor(v, o);
    return v;
}
__device__ __forceinline__ bf16x8 pack8(f32x4 a, f32x4 b) {
    v4u w; w.x = cvtpk(a[0], a[1]); w.y = cvtpk(a[2], a[3]); w.z = cvtpk(b[0], b[1]); w.w = cvtpk(b[2], b[3]);
    return __builtin_bit_cast(bf16x8, w);
}
__device__ __forceinline__ float siluf(float y) { return y / (1.0f + __expf(-y)); }

template <int MODE> __device__ __forceinline__ int colmap(int nr) {
    if (MODE == 0) return nr;
    if (nr < 3072) return nr;
    if (nr < 4096) return nr + 12;
    if (nr < 10752) return nr + 268;
    if (nr < 10764) return nr - 10752 + 3072;
    if (nr < 11008) return -1;
    return nr - 11008 + 4108;
}
template <int MODE> __device__ __forceinline__ void p0_transpose_item(const float* W, int K, int N, const float* kscale, bf16* WT, LAS float* scr, int item, int nblk, int lane) {
    const int kb = item / nblk, nb = item % nblk, k0 = 64 * kb, n0 = 32 * nb;
    const int src = colmap<MODE>(n0 + (lane & 31));
#pragma unroll 8
    for (int i = 0; i < 32; ++i) { const int kk = 2 * i + (lane >> 5); float v = 0.f; if (src >= 0) v = W[(size_t)(k0 + kk) * N + src]; if (kscale) v *= kscale[k0 + kk]; scr[kk * 33 + (lane & 31)] = v; }
    LDS_WAIT(); asm volatile("" ::: "memory");
    const int c = lane & 7;
#pragma unroll
    for (int j = 0; j < 4; ++j) { const int n = (lane >> 3) + 8 * j; const LAS float* s = scr + (8 * c) * 33 + n;
        v4u o; o.x = cvtpk(s[0 * 33], s[1 * 33]); o.y = cvtpk(s[2 * 33], s[3 * 33]); o.z = cvtpk(s[4 * 33], s[5 * 33]); o.w = cvtpk(s[6 * 33], s[7 * 33]);
        *(GAS v4u*)(WT + (size_t)(n0 + n) * K + k0 + 8 * c) = o; }
    LDS_WAIT(); asm volatile("" ::: "memory");
}
__device__ __forceinline__ void rms_row_to_bf16(const float* xrow, const float* w, bf16* orow, int lane) {
    const GAS f32x4* xr = (const GAS f32x4*)xrow + lane; const GAS f32x4* wr = (const GAS f32x4*)w + lane;
    f32x4 v[8]; float s = 0.f;
#pragma unroll
    for (int j = 0; j < 8; ++j) { v[j] = xr[64 * j]; s += (v[j].x * v[j].x + v[j].y * v[j].y) + (v[j].z * v[j].z + v[j].w * v[j].w); }
    const float rstd = 1.0f / sqrtf(wave_sum(s) * (1.0f / DM) + EPS);
    GAS v2u* o8 = (GAS v2u*)orow + lane;
#pragma unroll
    for (int j = 0; j < 8; ++j) { const f32x4 ww = wr[64 * j]; v2u o; o.x = cvtpk(v[j].x * rstd * ww.x, v[j].y * rstd * ww.y); o.y = cvtpk(v[j].z * rstd * ww.z, v[j].w * rstd * ww.w); o8[64 * j] = o; }
}

__device__ __forceinline__ void normfrag_item(const bf16* src, int ld, int row0, int col0, const float* wt, float scale, unsigned char* dst, int lane) {
    const int r = lane & 31, h = lane >> 5;
    const bf16* rp = src + (size_t)(row0 + r) * ld + col0 + 8 * h;
    v4u raw[8]; float ss = 0.f;
#pragma unroll
    for (int s = 0; s < 8; ++s) { raw[s] = *(const GAS v4u*)(rp + 16 * s);
        const float a0 = bflo(raw[s].x), a1 = bfhi(raw[s].x), a2 = bflo(raw[s].y), a3 = bfhi(raw[s].y), a4 = bflo(raw[s].z), a5 = bfhi(raw[s].z), a6 = bflo(raw[s].w), a7 = bfhi(raw[s].w);
        ss += (a0 * a0 + a1 * a1) + (a2 * a2 + a3 * a3) + (a4 * a4 + a5 * a5) + (a6 * a6 + a7 * a7); }
    ss += __shfl_xor(ss, 32);
    const float rstd = scale / sqrtf(ss * (1.0f / 128.0f) + EPS);
#pragma unroll
    for (int s = 0; s < 8; ++s) { const f32x4 w0 = *(const GAS f32x4*)(wt + 16 * s + 8 * h), w1 = *(const GAS f32x4*)(wt + 16 * s + 8 * h + 4);
        v4u o; o.x = cvtpk(bflo(raw[s].x) * rstd * w0.x, bfhi(raw[s].x) * rstd * w0.y); o.y = cvtpk(bflo(raw[s].y) * rstd * w0.z, bfhi(raw[s].y) * rstd * w0.w);
        o.z = cvtpk(bflo(raw[s].z) * rstd * w1.x, bfhi(raw[s].z) * rstd * w1.y); o.w = cvtpk(bflo(raw[s].w) * rstd * w1.z, bfhi(raw[s].w) * rstd * w1.w);
        *(GAS v4u*)(dst + (size_t)(s * 64 + lane) * 16) = o; }
}

constexpr int DP_LD = 132, DP_LL = 68;
constexpr int DP_Q = 0, DP_K = 64 * DP_LD, DP_V = 2 * 64 * DP_LD, DP_L = 3 * 64 * DP_LD, DP_S = DP_L + 64 * DP_LL;
struct DnIn { const bf16* proj; const float* convw; const float* alog; const float* dtb; unsigned char* dnf; float* gc; };

__device__ __forceinline__ void dn_prep_chunk(const DnIn& I, LAS float* L, int chunk, int tid) {
    const int lane = tid & 63, wave = __builtin_amdgcn_readfirstlane(tid >> 6);
    const int b = chunk / 192, h = (chunk / 32) % 6, n = chunk & 31;
    const int t0 = b * SEQ + 64 * n;
    LAS float* QS = L + DP_Q; LAS float* KS = L + DP_K; LAS float* VS = L + DP_V; LAS float* LM = L + DP_L;
    LAS float* sb = L + DP_S; LAS float* sG = sb + 64; LAS float* seG = sb + 128; LAS float* srq = sb + 192; LAS float* srk = sb + 256;
    unsigned char* rec = I.dnf + (size_t)chunk * CH_BYTES;
    if (tid < 384) {
        const int ch2 = tid % 192, tg = tid / 192, which = ch2 >> 6, cp = ch2 & 63;
        const int gcol = which * 768 + h * 128 + 2 * cp;
        float w0[4], w1[4];
#pragma unroll
        for (int k = 0; k < 4; ++k) { w0[k] = I.convw[k * 2304 + gcol]; w1[k] = I.convw[k * 2304 + gcol + 1]; }
        const int p0 = 64 * n + 32 * tg - 3;
        const bf16* src = I.proj + ((long)(b * SEQ + p0) * LDP + gcol);
        float xa[35], xb[35];
#pragma unroll
        for (int i = 0; i < 35; ++i) { unsigned u = 0u; if (p0 + i >= 0) u = *(const GAS unsigned*)(src + (long)i * LDP); xa[i] = bflo(u); xb[i] = bfhi(u); }
        LAS float* dst = L + which * 64 * DP_LD + (32 * tg) * DP_LD + 2 * cp;
#pragma unroll
        for (int j = 0; j < 32; ++j) {
            const float ya = (w0[0] * xa[j] + w0[1] * xa[j + 1]) + (w0[2] * xa[j + 2] + w0[3] * xa[j + 3]);
            const float yb = (w1[0] * xb[j] + w1[1] * xb[j + 1]) + (w1[2] * xb[j + 2] + w1[3] * xb[j + 3]);
            dst[j * DP_LD] = siluf(ya); dst[j * DP_LD + 1] = siluf(yb); }
    } else if (tid >= 448) {
        const int i = lane;
        const bf16* pr = I.proj + (size_t)(t0 + i) * LDP + PC_BA;
        const float bb = bf2f(pr[h]), aa = bf2f(pr[6 + h]);
        const float beta = 1.0f / (1.0f + __expf(-bb));
        const float xx = aa + I.dtb[h];
        const float sp = xx > 20.f ? xx : log1pf(__expf(xx));
        float g = -__expf(I.alog[h]) * sp;
#pragma unroll
        for (int o = 1; o < 64; o <<= 1) { const float t = __shfl_up(g, o); if (lane >= o) g += t; }
        sb[i] = beta; sG[i] = g; seG[i] = __expf(g);
        if (i == 63) I.gc[chunk] = __expf(g);
    }
    __syncthreads();
    for (int rr = 0; rr < 16; ++rr) {
        const int row = wave * 16 + rr; const int which = row >> 6, i = row & 63;
        const LAS float* p = L + which * 64 * DP_LD + i * DP_LD + 2 * lane;
        const float a = p[0], c = p[1];
        const float ss = wave_sum(a * a + c * c);
        if (lane == 0) { if (which == 0) srq[i] = 0.08838834764831845f / sqrtf(ss + EPS); else srk[i] = 1.0f / sqrtf(ss + EPS); }
    }
    __syncthreads();
    for (int e = tid; e < 2 * 64 * 64; e += 512) {
        const int which = e >> 12, i = (e >> 6) & 63, c2 = e & 63;
        LAS float* p = L + which * 64 * DP_LD + i * DP_LD + 2 * c2; const float sc = which ? srk[i] : srq[i];
        p[0] *= sc; p[1] *= sc; }
    __syncthreads();
    {
        const int it = wave & 3, c = lane & 15, q = lane >> 4; const bool isP = wave >= 4;
        const LAS float* X = isP ? QS : KS;
        bf16x8 bfr[4];
#pragma unroll
        for (int s = 0; s < 4; ++s) { const LAS float* p = X + (16 * it + c) * DP_LD + 32 * s + 8 * q; bfr[s] = pack8(*(const LAS f32x4*)p, *(const LAS f32x4*)(p + 4)); }
        f32x4 ct[4];
#pragma unroll
        for (int jt = 0; jt < 4; ++jt) { ct[jt] = (f32x4){0.f, 0.f, 0.f, 0.f};
            if (jt <= it) {
#pragma unroll
                for (int s = 0; s < 4; ++s) { const LAS float* p = KS + (16 * jt + c) * DP_LD + 32 * s + 8 * q; const bf16x8 af = pack8(*(const LAS f32x4*)p, *(const LAS f32x4*)(p + 4));
                    ct[jt] = __builtin_amdgcn_mfma_f32_16x16x32_bf16(af, bfr[s], ct[jt], 0, 0, 0); } } }
        const int i = 16 * it + c; const float Gi = sG[i], bi = sb[i];
        if (!isP) {
#pragma unroll
            for (int jt = 0; jt < 4; ++jt) if (jt <= it) { f32x4 o;
#pragma unroll
                for (int r = 0; r < 4; ++r) { const int j = 16 * jt + 4 * q + r; o[r] = (i > j) ? bi * ct[jt][r] * __expf(Gi - sG[j]) : 0.f; }
                *(LAS f32x4*)(LM + i * DP_LL + 16 * jt + 4 * q) = o; }
        } else {
#pragma unroll
            for (int s = 0; s < 2; ++s) { f32x4 lo, hi;
#pragma unroll
                for (int r = 0; r < 4; ++r) { const int j0 = 32 * s + 4 * q + r, j1 = j0 + 16;
                    lo[r] = (i >= j0) ? ct[2 * s][r] * __expf(Gi - sG[j0]) : 0.f; hi[r] = (i >= j1) ? ct[2 * s + 1][r] * __expf(Gi - sG[j1]) : 0.f; }
                *(GAS bf16x8*)(rec + CH_P + (size_t)((it * 2 + s) * 64 + lane) * 16) = pack8(lo, hi); }
        }
    }
    __syncthreads();
    {
        const int c = lane & 15, q = lane >> 4; const float G63 = sG[63];
#pragma unroll
        for (int f = 0; f < 2; ++f) { const int fi = wave * 2 + f, mt = fi >> 2, s = fi & 3;
            const int i = 16 * mt + c; const float e = seG[i]; const LAS float* p = QS + i * DP_LD + 32 * s + 4 * q;
            const f32x4 lo = *(const LAS f32x4*)p * e, hi = *(const LAS f32x4*)(p + 16) * e;
            *(GAS bf16x8*)(rec + CH_QG + (size_t)(fi * 64 + lane) * 16) = pack8(lo, hi); }
#pragma unroll
        for (int f = 0; f < 2; ++f) { const int fi = wave * 2 + f, mt = fi >> 1, s = fi & 1;
            const int dk = 16 * mt + c; f32x4 lo, hi;
#pragma unroll
            for (int r = 0; r < 4; ++r) { const int p0 = 32 * s + 4 * q + r, p1 = p0 + 16; lo[r] = KS[p0 * DP_LD + dk] * __expf(G63 - sG[p0]); hi[r] = KS[p1 * DP_LD + dk] * __expf(G63 - sG[p1]); }
            *(GAS bf16x8*)(rec + CH_KD + (size_t)(fi * 64 + lane) * 16) = pack8(lo, hi); }
    }
    __syncthreads();
    if (tid < 256) {
        const int c = tid; const bool isk = c >= 128; LAS float* R = (isk ? KS : VS) + (c & 127);
        int vz; asm volatile("v_mov_b32 %0, 0" : "=v"(vz));
        const LAS float* LMv = LM + vz; const LAS float* sbv = sb + vz; const LAS float* seGv = seG + vz;
        float X[64];
#pragma unroll
        for (int i = 0; i < 64; ++i) {
            float acc = R[i * DP_LD] * sbv[i]; if (isk) acc *= seGv[i];
#pragma unroll
            for (int j4 = 0; j4 < (i + 3) / 4; ++j4) { const f32x4 l = *(const LAS f32x4*)(LMv + i * DP_LL + 4 * j4);
#pragma unroll
                for (int jj = 0; jj < 4; ++jj) { const int j = 4 * j4 + jj; if (j < i) acc -= l[jj] * X[j]; } }
            X[i] = acc; R[i * DP_LD] = acc; asm volatile("" ::: "memory"); }
    } else {
        const int c = lane & 15, q = lane >> 4;
#pragma unroll
        for (int f = 0; f < 8; ++f) { const int fi = (wave - 4) * 8 + f, sl = fi >> 2, mt = fi & 3;
            v2u zo; float zz[4];
#pragma unroll
            for (int r = 0; r < 4; ++r) { const int pos = 16 * mt + 4 * q + r; zz[r] = siluf(bf2f(I.proj[(size_t)(t0 + pos) * LDP + PC_DNZ + h * 128 + 16 * sl + c])); }
            zo.x = cvtpk(zz[0], zz[1]); zo.y = cvtpk(zz[2], zz[3]);
            *(GAS v2u*)(rec + CH_ZG + (size_t)(fi * 64 + lane) * 8) = zo; }
    }
    __syncthreads();
    {
        const int c = lane & 15, q = lane >> 4;
#pragma unroll
        for (int f = 0; f < 2; ++f) { const int fi = wave * 2 + f, mt = fi >> 2, s = fi & 3; const int i = 16 * mt + c; const LAS float* p = KS + i * DP_LD + 32 * s + 4 * q;
            const f32x4 lo = -*(const LAS f32x4*)p, hi = -*(const LAS f32x4*)(p + 16);
            *(GAS bf16x8*)(rec + CH_W + (size_t)(fi * 64 + lane) * 16) = pack8(lo, hi); }
#pragma unroll
        for (int f = 0; f < 4; ++f) { const int fi = wave * 4 + f, sl = fi >> 2, mt = fi & 3;
            v2u uo; float uu[4];
#pragma unroll
            for (int r = 0; r < 4; ++r) { const int pos = 16 * mt + 4 * q + r; uu[r] = VS[pos * DP_LD + 16 * sl + c]; }
            uo.x = cvtpk(uu[0], uu[1]); uo.y = cvtpk(uu[2], uu[3]);
            *(GAS v2u*)(rec + CH_U + (size_t)(fi * 64 + lane) * 8) = uo; }
    }
    __syncthreads();
}

constexpr int SC_BUF = 57344, SC_RED = 2 * SC_BUF, SC_RS = SC_RED + 2048;
struct ScanIn { const unsigned char* dnf; const float* gc; const float* onw; bf16* odn; };
__device__ __forceinline__ void dn_scan(const ScanIn& I, LAS unsigned char* lds, int bh, int tid) {
    const int lane = tid & 63, sl = __builtin_amdgcn_readfirstlane(tid >> 6), c = lane & 15, q = lane >> 4;
    const int b = bh / 6, h = bh % 6;
    const unsigned char* rec0 = I.dnf + (size_t)(bh * 32) * CH_BYTES;
    LAS float* red = (LAS float*)(lds + SC_RED); LAS float* rsv = (LAS float*)(lds + SC_RS);
    const float onw = I.onw[16 * sl + c];
    f32x4 S[8];
#pragma unroll
    for (int i = 0; i < 8; ++i) S[i] = (f32x4){0.f, 0.f, 0.f, 0.f};
    v2u Ucur[4], Zcur[4], Unxt[4], Znxt[4];
#pragma unroll
    for (int i = 0; i < 7; ++i) __builtin_amdgcn_global_load_lds((const unsigned*)(rec0 + (size_t)(sl * 7 + i) * 1024 + lane * 16), (LAS unsigned*)(lds + (sl * 7 + i) * 1024), 16, 0, 0);
#pragma unroll
    for (int mt = 0; mt < 4; ++mt) { Unxt[mt] = *(const GAS v2u*)(rec0 + CH_U + (size_t)((sl * 4 + mt) * 64 + lane) * 8); Znxt[mt] = *(const GAS v2u*)(rec0 + CH_ZG + (size_t)((sl * 4 + mt) * 64 + lane) * 8); }
    for (int n = 0; n < 32; ++n) {
        VM_WAIT(); __syncthreads();
#pragma unroll
        for (int mt = 0; mt < 4; ++mt) { Ucur[mt] = Unxt[mt]; Zcur[mt] = Znxt[mt]; }
        const float gcv = I.gc[bh * 32 + n];
        if (n + 1 < 32) {
            const unsigned char* rec = rec0 + (size_t)(n + 1) * CH_BYTES; LAS unsigned char* dstb = lds + ((n + 1) & 1) * SC_BUF;
#pragma unroll
            for (int i = 0; i < 7; ++i) __builtin_amdgcn_global_load_lds((const unsigned*)(rec + (size_t)(sl * 7 + i) * 1024 + lane * 16), (LAS unsigned*)(dstb + (sl * 7 + i) * 1024), 16, 0, 0);
#pragma unroll
            for (int mt = 0; mt < 4; ++mt) { Unxt[mt] = *(const GAS v2u*)(rec + CH_U + (size_t)((sl * 4 + mt) * 64 + lane) * 8); Znxt[mt] = *(const GAS v2u*)(rec + CH_ZG + (size_t)((sl * 4 + mt) * 64 + lane) * 8); }
        }
        const LAS unsigned char* fb = lds + (n & 1) * SC_BUF + lane * 16;
        bf16x8 Sb[4];
#pragma unroll
        for (int s = 0; s < 4; ++s) Sb[s] = pack8(S[2 * s], S[2 * s + 1]);
        f32x4 d[4], o[4];
#pragma unroll
        for (int mt = 0; mt < 4; ++mt) { d[mt] = (f32x4){bflo(Ucur[mt].x), bfhi(Ucur[mt].x), bflo(Ucur[mt].y), bfhi(Ucur[mt].y)}; o[mt] = (f32x4){0.f, 0.f, 0.f, 0.f}; }
#pragma unroll
        for (int mt = 0; mt < 4; ++mt)
#pragma unroll
            for (int s = 0; s < 4; ++s) {
                d[mt] = __builtin_amdgcn_mfma_f32_16x16x32_bf16(*(const LAS bf16x8*)(fb + CH_W + (mt * 4 + s) * 1024), Sb[s], d[mt], 0, 0, 0);
                o[mt] = __builtin_amdgcn_mfma_f32_16x16x32_bf16(*(const LAS bf16x8*)(fb + CH_QG + (mt * 4 + s) * 1024), Sb[s], o[mt], 0, 0, 0); }
        bf16x8 Db[2];
#pragma unroll
        for (int s = 0; s < 2; ++s) Db[s] = pack8(d[2 * s], d[2 * s + 1]);
#pragma unroll
        for (int mt = 0; mt < 4; ++mt)
#pragma unroll
            for (int s = 0; s < 2; ++s) o[mt] = __builtin_amdgcn_mfma_f32_16x16x32_bf16(*(const LAS bf16x8*)(fb + CH_P + (mt * 2 + s) * 1024), Db[s], o[mt], 0, 0, 0);
#pragma unroll
        for (int mt = 0; mt < 8; ++mt) { S[mt] = S[mt] * gcv;
#pragma unroll
            for (int s = 0; s < 2; ++s) S[mt] = __builtin_amdgcn_mfma_f32_16x16x32_bf16(*(const LAS bf16x8*)(fb + CH_KD + (mt * 2 + s) * 1024), Db[s], S[mt], 0, 0, 0); }
#pragma unroll
        for (int mt = 0; mt < 4; ++mt) { f32x4 ss = o[mt] * o[mt];
#pragma unroll
            for (int r = 0; r < 4; ++r) { float v = ss[r]; v += __shfl_xor(v, 1); v += __shfl_xor(v, 2); v += __shfl_xor(v, 4); v += __shfl_xor(v, 8); ss[r] = v; }
            if (c == 0) *(LAS f32x4*)(red + sl * 64 + 16 * mt + 4 * q) = ss; }
        __syncthreads();
        { const int pos = 8 * sl + (lane >> 3); float v = red[(lane & 7) * 64 + pos]; v += __shfl_xor(v, 1); v += __shfl_xor(v, 2); v += __shfl_xor(v, 4);
          if ((lane & 7) == 0) rsv[pos] = 1.0f / sqrtf(v * (1.0f / 128.0f) + EPS); }
        __syncthreads();
        bf16* orow = I.odn + (size_t)(b * SEQ + 64 * n) * 768 + h * 128 + 16 * sl + c;
#pragma unroll
        for (int mt = 0; mt < 4; ++mt) { const f32x4 r4 = *(const LAS f32x4*)(rsv + 16 * mt + 4 * q);
            const f32x4 z4 = (f32x4){bflo(Zcur[mt].x), bfhi(Zcur[mt].x), bflo(Zcur[mt].y), bfhi(Zcur[mt].y)};
#pragma unroll
            for (int r = 0; r < 4; ++r) { const float v = o[mt][r] * r4[r] * onw * z4[r]; orow[(size_t)(16 * mt + 4 * q + r) * 768] = (bf16)(cvtpk(v, 0.f) & 0xffffu); } }
    }
    VM_WAIT(); __syncthreads();
}

__constant__ unsigned char T5_BUCKET[128] = {0,1,2,3,4,5,6,7,8,9,10,11,12,13,14,15,16,16,16,17,17,18,18,18,19,19,19,20,20,20,20,21,21,21,21,22,22,22,22,22,23,23,23,23,23,23,24,24,24,24,24,24,25,25,25,25,25,25,25,26,26,26,26,26,26,26,26,27,27,27,27,27,27,27,27,27,27,28,28,28,28,28,28,28,28,28,28,29,29,29,29,29,29,29,29,29,29,29,29,30,30,30,30,30,30,30,30,30,30,30,30,30,30,31,31,31,31,31,31,31,31,31,31,31,31,31,31,31};
struct AttnIn { const unsigned char *qf, *kf, *vt, *mqf, *mkf, *mvt; bf16 *oswa, *omem; const float* sinks; };
__device__ __forceinline__ float ex2(float v) { return __builtin_amdgcn_exp2f(v); }

__device__ __forceinline__ void swa_item(const AttnIn& I, const LAS float* biasT, int item, int lane) {
    const int qt = item & 63, hq = (item >> 6) % 6, b = item / 384, kvh = hq / 3;
    const int r32 = lane & 31, hh = lane >> 5;
    bf16x8 qfr[8];
    { const unsigned char* p = I.qf + ((size_t)((b * 6 + hq) * 64 + qt) * 8) * 1024 + lane * 16;
#pragma unroll
      for (int s = 0; s < 8; ++s) qfr[s] = *(const GAS bf16x8*)(p + s * 1024); }
    f32x16 S[5];
#pragma unroll
    for (int i = 0; i < 5; ++i) { const int kt = qt - 4 + i;
#pragma unroll
        for (int r = 0; r < 16; ++r) S[i][r] = 0.f;
        if (kt >= 0) { const unsigned char* p = I.kf + ((size_t)((b * 2 + kvh) * 64 + kt) * 8) * 1024 + lane * 16; bf16x8 kfr[8];
#pragma unroll
            for (int s = 0; s < 8; ++s) kfr[s] = *(const GAS bf16x8*)(p + s * 1024);
#pragma unroll
            for (int s = 0; s < 8; ++s) S[i] = __builtin_amdgcn_mfma_f32_32x32x16_bf16(kfr[s], qfr[s], S[i], 0, 0, 0); } }
    const float sink2 = I.sinks[hq] * LOG2E; const LAS float* bt = biasT + hq * 128;
    float m = sink2;
#pragma unroll
    for (int i = 0; i < 5; ++i) { const int kt = qt - 4 + i;
#pragma unroll
        for (int r = 0; r < 16; ++r) { const int koff = (r & 3) + 8 * (r >> 2) + 4 * hh; const int dist = 32 * (4 - i) + r32 - koff;
            const bool valid = (kt >= 0) && (dist >= 0) && (dist < 128);
            const float v = valid ? S[i][r] + bt[dist & 127] : -INFINITY; S[i][r] = v; m = fmaxf(m, v); } }
    m = fmaxf(m, __shfl_xor(m, 32));
    float l = 0.f;
#pragma unroll
    for (int i = 0; i < 5; ++i)
#pragma unroll
        for (int r = 0; r < 16; ++r) { const float p = ex2(S[i][r] - m); S[i][r] = p; l += p; }
    l += __shfl_xor(l, 32); l += ex2(sink2 - m);
    f32x16 O[4];
#pragma unroll
    for (int dt = 0; dt < 4; ++dt)
#pragma unroll
        for (int r = 0; r < 16; ++r) O[dt][r] = 0.f;
#pragma unroll
    for (int i = 0; i < 5; ++i) { const int kt = qt - 4 + i;
        if (kt >= 0) { const unsigned char* p = I.vt + ((size_t)((b * 2 + kvh) * 64 + kt) * 8) * 1024 + lane * 16;
#pragma unroll
            for (int s = 0; s < 2; ++s) { const bf16x8 pf = pack8((f32x4){S[i][8 * s], S[i][8 * s + 1], S[i][8 * s + 2], S[i][8 * s + 3]}, (f32x4){S[i][8 * s + 4], S[i][8 * s + 5], S[i][8 * s + 6], S[i][8 * s + 7]});
#pragma unroll
                for (int dt = 0; dt < 4; ++dt) O[dt] = __builtin_amdgcn_mfma_f32_32x32x16_bf16(*(const GAS bf16x8*)(p + (s * 4 + dt) * 1024), pf, O[dt], 0, 0, 0); } } }
    const float inv = 1.0f / l;
    bf16* orow = I.oswa + (size_t)(b * SEQ + 32 * qt + r32) * 768 + hq * 128 + 4 * hh;
#pragma unroll
    for (int dt = 0; dt < 4; ++dt)
#pragma unroll
        for (int g = 0; g < 4; ++g) { v2u w; w.x = cvtpk(O[dt][4 * g] * inv, O[dt][4 * g + 1] * inv); w.y = cvtpk(O[dt][4 * g + 2] * inv, O[dt][4 * g + 3] * inv);
            *(GAS v2u*)(orow + 32 * dt + 8 * g) = w; }
}

__device__ __forceinline__ void mem_item(const AttnIn& I, int item, int lane) {
    const int qt = item & 63, h = (item >> 6) & 3, b = item >> 8;
    const int r32 = lane & 31, hh = lane >> 5;
    bf16x8 qfr[8];
    { const unsigned char* p = I.mqf + ((size_t)((b * 4 + h) * 64 + qt) * 8) * 1024 + lane * 16;
#pragma unroll
      for (int s = 0; s < 8; ++s) qfr[s] = *(const GAS bf16x8*)(p + s * 1024); }
    f32x16 O[4];
#pragma unroll
    for (int dt = 0; dt < 4; ++dt)
#pragma unroll
        for (int r = 0; r < 16; ++r) O[dt][r] = 0.f;
    float m = -INFINITY, l = 0.f;
#pragma unroll 1
    for (int half = 0; half < 2; ++half) {
        f32x16 S[4];
#pragma unroll
        for (int i = 0; i < 4; ++i) { const int kt = half * 4 + i;
#pragma unroll
            for (int r = 0; r < 16; ++r) S[i][r] = 0.f;
            const unsigned char* p = I.mkf + ((size_t)((b * 4 + h) * 8 + kt) * 8) * 1024 + lane * 16; bf16x8 kfr[8];
#pragma unroll
            for (int s = 0; s < 8; ++s) kfr[s] = *(const GAS bf16x8*)(p + s * 1024);
#pragma unroll
            for (int s = 0; s < 8; ++s) S[i] = __builtin_amdgcn_mfma_f32_32x32x16_bf16(kfr[s], qfr[s], S[i], 0, 0, 0);
            asm volatile("" ::: "memory"); }
        float mh = m;
#pragma unroll
        for (int i = 0; i < 4; ++i)
#pragma unroll
            for (int r = 0; r < 16; ++r) mh = fmaxf(mh, S[i][r]);
        mh = fmaxf(mh, __shfl_xor(mh, 32));
        const float alpha = ex2(m - mh); m = mh;
        float ls = 0.f;
#pragma unroll
        for (int i = 0; i < 4; ++i)
#pragma unroll
            for (int r = 0; r < 16; ++r) { const float p = ex2(S[i][r] - m); S[i][r] = p; ls += p; }
        ls += __shfl_xor(ls, 32); l = l * alpha + ls;
#pragma unroll
        for (int dt = 0; dt < 4; ++dt) O[dt] = O[dt] * alpha;
#pragma unroll
        for (int i = 0; i < 4; ++i) { const int kt = half * 4 + i; const unsigned char* p = I.mvt + ((size_t)((b * 4 + h) * 8 + kt) * 8) * 1024 + lane * 16;
#pragma unroll
            for (int s = 0; s < 2; ++s) { const bf16x8 pf = pack8((f32x4){S[i][8 * s], S[i][8 * s + 1], S[i][8 * s + 2], S[i][8 * s + 3]}, (f32x4){S[i][8 * s + 4], S[i][8 * s + 5], S[i][8 * s + 6], S[i][8 * s + 7]});
#pragma unroll
                for (int dt = 0; dt < 4; ++dt) O[dt] = __builtin_amdgcn_mfma_f32_32x32x16_bf16(*(const GAS bf16x8*)(p + (s * 4 + dt) * 1024), pf, O[dt], 0, 0, 0); }
            asm volatile("" ::: "memory"); }
    }
    const float inv = 1.0f / l;
    bf16* orow = I.omem + (size_t)(b * SEQ + 32 * qt + r32) * 512 + h * 128 + 4 * hh;
#pragma unroll
    for (int dt = 0; dt < 4; ++dt)
#pragma unroll
        for (int g = 0; g < 4; ++g) { v2u w; w.x = cvtpk(O[dt][4 * g] * inv, O[dt][4 * g + 1] * inv); w.y = cvtpk(O[dt][4 * g + 2] * inv, O[dt][4 * g + 3] * inv);
            *(GAS v2u*)(orow + 32 * dt + 8 * g) = w; }
}

#ifndef PH_MASK
#define PH_MASK 0xff
#endif
struct Args { const float* in[23]; float* out; unsigned char* ws; int ph_lo, ph_hi; };
__global__ void __launch_bounds__(NWAVES * 64, 2) hyb_fwd(Args args) {
    extern __shared__ __attribute__((aligned(16))) unsigned char lds_raw[];
    LAS unsigned char* lds = (LAS unsigned char*)lds_raw;
    volatile LAS unsigned* MISC = (volatile LAS unsigned*)(lds + MISC_OFF);
    const int tid = threadIdx.x, lane = tid & 63, wave = __builtin_amdgcn_readfirstlane(tid >> 6);
    const int G = gridDim.x, bx = blockIdx.x;
    unsigned char* ws = args.ws;
    const float* x = args.in[0]; const float* mem = args.in[1]; const float* attn_norm_w = args.in[2]; const float* w_in = args.in[3];
    const float* dn_conv_w = args.in[4]; const float* dn_A_log = args.in[5]; const float* dn_dt_bias = args.in[6]; const float* dn_out_norm_w = args.in[7];
    const float* swa_q_norm_w = args.in[8]; const float* swa_k_norm_w = args.in[9]; const float* swa_sinks = args.in[10]; const float* rel_bias = args.in[11];
    const float* mem_norm_w = args.in[12]; const float* w_mem_kv = args.in[13]; const float* xq_norm_w = args.in[14]; const float* xk_norm_w = args.in[15];
    const float* p_dn = args.in[16]; const float* p_swa = args.in[17]; const float* p_mem = args.in[18]; const float* w_out = args.in[19];
    const float* mlp_norm_w = args.in[20]; const float* w_up = args.in[21]; const float* w_down = args.in[22];
    float* out = args.out;
    bf16* WoutT = (bf16*)(ws + WS_WOUT); bf16* PdnT = (bf16*)(ws + WS_PDN); bf16* PswaT = (bf16*)(ws + WS_PSWA); bf16* PmemT = (bf16*)(ws + WS_PMEM);
    bf16* WinT = (bf16*)(ws + WS_WIN); bf16* WmkvT = (bf16*)(ws + WS_WMKV); bf16* memn = (bf16*)(ws + WS_MEMN);
    bf16* WupT = (bf16*)(ws + WS_WUP); bf16* WdnT = (bf16*)(ws + WS_WDN);
    bf16* xn = (bf16*)(ws + WS_XN); bf16* proj = (bf16*)(ws + WS_PROJ); bf16* gates = (bf16*)(ws + WS_GATES);
    bf16* odn = (bf16*)(ws + WS_ODN); bf16* oswa = (bf16*)(ws + WS_OSWA); bf16* omem = (bf16*)(ws + WS_OMEM); bf16* merged = (bf16*)(ws + WS_MERGED);
    bf16* memk = (bf16*)(ws + WS_MEMK); bf16* Hb = (bf16*)(ws + WS_H);
    float* ssq = (float*)(ws + WS_SSQ); float* gcarr = (float*)(ws + WS_GC);

    for (int u = tid; u < (LDS_BYTES - LDSCTL_OFF) / 4; u += NWAVES * 64) ((LAS unsigned*)(lds + LDSCTL_OFF))[u] = 0u;
    __syncthreads();
    XcdBarrier bar = xcd_barrier_post((unsigned*)(ws + WS_CTL) + CW_BAR, MISC + 8);
    const int lo = args.ph_lo, hi = args.ph_hi;
#define IN(k) (lo <= (k) && (k) < hi && ((PH_MASK >> (k)) & 1))
#define SEAM(k) do { if ((k) + 1 < hi) xcd_barrier(bar); } while (0)
    const int gw = bx * NWAVES + wave, NGW = G * NWAVES;

    if (lo <= 0 && 0 < hi) {
        if (IN(0)) {
        LAS float* scr = (LAS float*)(lds + RING_OFF + wave * 16384);
        constexpr int I_WIN = 32 * (NWIN / 32), I_MKV = 32 * 32, I_PDN = 12 * 64, I_PSWA = 12 * 64, I_PMEM = 8 * 64, I_WOUT = 32 * 64;
        constexpr int NITEMS = I_WIN + I_MKV + I_PDN + I_PSWA + I_PMEM + I_WOUT;
        for (int it = gw; it < NITEMS; it += NGW) {
            int r = it;
            if (r < I_WIN) { p0_transpose_item<1>(w_in, DM, NIN, nullptr, WinT, scr, r, NWIN / 32, lane); continue; } r -= I_WIN;
            if (r < I_MKV) { p0_transpose_item<0>(w_mem_kv, DM, 1024, nullptr, WmkvT, scr, r, 32, lane); continue; } r -= I_MKV;
            if (r < I_PDN) { p0_transpose_item<0>(p_dn, 768, DM, nullptr, PdnT, scr, r, 64, lane); continue; } r -= I_PDN;
            if (r < I_PSWA) { p0_transpose_item<0>(p_swa, 768, DM, nullptr, PswaT, scr, r, 64, lane); continue; } r -= I_PSWA;
            if (r < I_PMEM) { p0_transpose_item<0>(p_mem, 512, DM, nullptr, PmemT, scr, r, 64, lane); continue; } r -= I_PMEM;
            p0_transpose_item<0>(w_out, DM, DM, nullptr, WoutT, scr, r, 64, lane);
        }
        for (int m = gw; m < MT + MMEM; m += NGW) {
            if (m < MT) rms_row_to_bf16(x + (size_t)m * DM, attn_norm_w, xn + (size_t)m * DM, lane);
            else rms_row_to_bf16(mem + (size_t)(m - MT) * DM, mem_norm_w, memn + (size_t)(m - MT) * DM, lane);
        }
        }
        SEAM(0);
    }
    if (lo <= 1 && 1 < hi) {
        if (IN(1)) {
        { pg8::Gemm g{xn, WinT, MT, NMAIN, DM}; pg8::StaticOrder S; S.init(MT, NMAIN, G, bx);
          pg8::EpiProj E{proj, gates, LDP, LDG};
          pg8::gemm_phase<pg8::EpiProj, pg8::StaticOrder, true, true>(lds + RING_OFF, g, S, E); }
        { pg8::Gemm g{WinT + (size_t)NMAIN * DM, xn, 256, MT, DM}; pg8::StaticOrder S; S.init(256, MT, G, (bx - 96 + G) % G);
          pg8::EpiVt<2, SEQ> E{ws + WS_VT};
          pg8::gemm_phase<pg8::EpiVt<2, SEQ>, pg8::StaticOrder, true, true>(lds + RING_OFF, g, S, E); }
        { pg8::Gemm g{memn, WmkvT, MMEM, 512, DM}; pg8::StaticOrder S; S.init(MMEM, 512, G, (bx - 128 + G) % G);
          pg8::EpiPlain E{memk, 512};
          pg8::gemm_phase<pg8::EpiPlain, pg8::StaticOrder, true, true>(lds + RING_OFF, g, S, E); }
        { pg8::Gemm g{WmkvT + (size_t)512 * DM, memn, 512, MMEM, DM}; pg8::StaticOrder S; S.init(512, MMEM, G, (bx - 136 + G) % G);
          pg8::EpiVt<4, MEML> E{ws + WS_MVT};
          pg8::gemm_phase<pg8::EpiVt<4, MEML>, pg8::StaticOrder, true, true>(lds + RING_OFF, g, S, E); }
        }
        SEAM(1);
    }
    if (lo <= 2 && 2 < hi) {
        if (IN(2)) {
        DnIn DI{proj, dn_conv_w, dn_A_log, dn_dt_bias, ws + WS_DNF, gcarr};
        for (int chunk = bx; chunk < NCHUNK; chunk += G) dn_prep_chunk(DI, (LAS float*)(lds + RING_OFF), chunk, tid);
        for (int it = gw; it < 3200; it += NGW) {
            if (it < 1536) { const int grp = it >> 6, tile = it & 63, b = grp / 6, hq = grp % 6;
                normfrag_item(proj, LDP, b * SEQ + 32 * tile, PC_SQ + hq * 128, swa_q_norm_w, QSCALE, ws + WS_QF + (size_t)it * 8192, lane); }
            else if (it < 2048) { const int i2 = it - 1536, grp = i2 >> 6, tile = i2 & 63, b = grp >> 1, kvh = grp & 1;
                normfrag_item(proj, LDP, b * SEQ + 32 * tile, PC_SK + kvh * 128, swa_k_norm_w, 1.0f, ws + WS_KF + (size_t)i2 * 8192, lane); }
            else if (it < 3072) { const int i3 = it - 2048, grp = i3 >> 6, tile = i3 & 63, b = grp >> 2, h = grp & 3;
                normfrag_item(proj, LDP, b * SEQ + 32 * tile, PC_MQ + h * 128, xq_norm_w, QSCALE, ws + WS_MQF + (size_t)i3 * 8192, lane); }
            else { const int i4 = it - 3072, grp = i4 >> 3, tile = i4 & 7, b = grp >> 2, h = grp & 3;
                normfrag_item(memk, 512, b * MEML + 32 * tile, h * 128, xk_norm_w, 1.0f, ws + WS_MKF + (size_t)i4 * 8192, lane); }
        }
        }
        SEAM(2);
    }
    if (lo <= 3 && 3 < hi) {
        if (IN(3)) {
        if (bx < 24) {
#ifndef NO_SCAN
            ScanIn SI{ws + WS_DNF, gcarr, dn_out_norm_w, odn}; dn_scan(SI, lds + RING_OFF, bx, tid);
#endif
        }
        else {
            LAS float* biasT = (LAS float*)(lds + RING_OFF);
            for (int e = tid; e < 768; e += NWAVES * 64) { const int hq = e >> 7, dist = e & 127; biasT[e] = rel_bias[T5_BUCKET[dist] * 6 + hq] * LOG2E; }
            __syncthreads();
            AttnIn AI{ws + WS_QF, ws + WS_KF, ws + WS_VT, ws + WS_MQF, ws + WS_MKF, ws + WS_MVT, oswa, omem, swa_sinks};
            const int aw = (bx - 24) * NWAVES + wave, NAW = (G - 24) * NWAVES;
            for (int it = aw; it < 2560; it += NAW) {
#ifndef NO_MEM
                if (it < 1024) mem_item(AI, it, lane);
#endif
#ifndef NO_SWA
                if (it >= 1024) swa_item(AI, biasT, it - 1024, lane);
#endif
            }
        }
        }
        SEAM(3);
    }
    if (lo <= 4 && 4 < hi) {
        if (IN(4)) {
        { LAS float* scr = (LAS float*)(lds + RING_OFF + wave * 16384);
          constexpr int I_UP = 32 * 256, I_DN = 128 * 64;
          for (int it = gw; it < I_UP + I_DN; it += NGW) {
              if (it < I_UP) p0_transpose_item<0>(w_up, DM, DFF, mlp_norm_w, WupT, scr, it, 256, lane);
              else p0_transpose_item<0>(w_down, DFF, DM, nullptr, WdnT, scr, it - I_UP, 64, lane); }
          __syncthreads(); }
        { pg8::Gemm g{oswa, PswaT, MT, DM, 768}; pg8::StaticOrder S; S.init(MT, DM, G, bx);
          pg8::EpiMerge<0> E{gates + 2048, out, merged, LDG, DM};
          pg8::gemm_phase<pg8::EpiMerge<0>, pg8::StaticOrder, false, true>(lds + RING_OFF, g, S, E); }
        { pg8::Gemm g{omem, PmemT, MT, DM, 512}; pg8::StaticOrder S; S.init(MT, DM, G, bx);
          pg8::EpiMerge<1> E{gates + 4096, out, merged, LDG, DM};
          pg8::gemm_phase<pg8::EpiMerge<1>, pg8::StaticOrder, false, true>(lds + RING_OFF, g, S, E); }
        { pg8::Gemm g{odn, PdnT, MT, DM, 768}; pg8::StaticOrder S; S.init(MT, DM, G, bx);
          pg8::EpiMerge<2> E{gates, out, merged, LDG, DM};
          pg8::gemm_phase<pg8::EpiMerge<2>, pg8::StaticOrder, false, true>(lds + RING_OFF, g, S, E); }
        }
        SEAM(4);
    }
    if (lo <= 5 && 5 < hi) {
        if (IN(5)) {
        pg8::Gemm g{merged, WoutT, MT, DM, DM}; pg8::StaticOrder S; S.init(MT, DM, G, bx);
        pg8::EpiOut E{x, out, xn, ssq, DM};
        pg8::gemm_phase<pg8::EpiOut, pg8::StaticOrder, false, true>(lds + RING_OFF, g, S, E);
        }
        SEAM(5);
    }
    if (lo <= 6 && 6 < hi) {
        if (IN(6)) {
        pg8::Gemm g{xn, WupT, MT, DFF, DM}; pg8::StaticOrder S; S.init(MT, DFF, G, bx);
        pg8::EpiUp E{ssq, Hb, DFF, 1.0f / DM, EPS};
        pg8::gemm_phase<pg8::EpiUp, pg8::StaticOrder, true, true>(lds + RING_OFF, g, S, E);
        }
        SEAM(6);
    }
    if (lo <= 7 && 7 < hi) {
        if (IN(7)) {
        pg8::Gemm g{Hb, WdnT, MT, DM, DFF}; pg8::StaticOrder S; S.init(MT, DM, G, bx);
        pg8::EpiDown E{out, DM};
        pg8::gemm_phase<pg8::EpiDown, pg8::StaticOrder, false, true>(lds + RING_OFF, g, S, E);
        }
    }
#undef IN
#undef SEAM
}

#ifndef N_LAUNCHES
#define N_LAUNCHES 1
#endif
extern "C" void kernel_launch(void* const* d_in, const int* in_sizes, int n_in, void* d_out, int out_size, void* d_ws, size_t ws_size, hipStream_t stream) {
    static int grid = 0;
    if (grid == 0) {
        if (n_in != 23 || out_size != MT * DM || ws_size < WS_END) { fprintf(stderr, "kernel_launch: unexpected shapes (n_in %d, out %d, ws %zu)\n", n_in, out_size, ws_size); grid = -1; return; }
        int dev = 0, cus = 0, per_cu = 0;
        if (hipGetDevice(&dev) != hipSuccess || hipDeviceGetAttribute(&cus, hipDeviceAttributeMultiprocessorCount, dev) != hipSuccess) { grid = -1; return; }
        if (hipFuncSetAttribute((const void*)hyb_fwd, hipFuncAttributeMaxDynamicSharedMemorySize, LDS_BYTES) != hipSuccess) { fprintf(stderr, "kernel_launch: hipFuncSetAttribute failed\n"); grid = -1; return; }
        if (hipOccupancyMaxActiveBlocksPerMultiprocessor(&per_cu, (const void*)hyb_fwd, NWAVES * 64, LDS_BYTES) != hipSuccess || per_cu < 1) { fprintf(stderr, "kernel_launch: occupancy query says %d\n", per_cu); per_cu = 1; }
        (void)hipGetLastError();
        grid = cus;
        if (grid > 256) grid = 256;
    }
    if (grid < 0) return;
    (void)hipMemsetAsync((char*)d_ws + WS_CTL, 0, CTL_ZERO_BYTES, stream);
    Args a{};
    for (int i = 0; i < 23; ++i) a.in[i] = (const float*)d_in[i];
    a.out = (float*)d_out; a.ws = (unsigned char*)d_ws;
#if N_LAUNCHES == 1
    a.ph_lo = 0; a.ph_hi = 8;
    hipLaunchKernelGGL(hyb_fwd, dim3(grid), dim3(NWAVES * 64), LDS_BYTES, stream, a);
#else
    for (int p = 0; p < 8; ++p) { a.ph_lo = p; a.ph_hi = p + 1; hipLaunchKernelGGL(hyb_fwd, dim3(grid), dim3(NWAVES * 64), LDS_BYTES, stream, a); }
#endif
}
```

```cpp
#include <hip/hip_runtime.h>
#include <cstdio>
#include <cstdint>
namespace pg8 {
#define PG8_LAS __attribute__((address_space(3)))
typedef unsigned short bf16_t;
typedef short bf16x8 __attribute__((ext_vector_type(8)));
typedef float f32x4 __attribute__((ext_vector_type(4)));
typedef unsigned u32x4 __attribute__((ext_vector_type(4)));
constexpr int BM = 256, BK = 64, HALF = 128, HTB = HALF * BK * 2  , STAGE_BYTES = 8 * HTB, NXCD = 8, WGM = 8;

__host__ __device__ __forceinline__ int lds_byte(int r, int c) { const int st = (r >> 4) * 2 + (c >> 5), rr = r & 15, cc = c & 31, ob = rr * 64 + cc * 2; return st * 1024 + (ob ^ (((ob >> 9) & 1) << 5)); }
__host__ __device__ __forceinline__ void stage_rc(int b, int& R, int& C) { const int st = b / 1024, sb = b % 1024, swz = sb ^ (((sb >> 9) & 1) << 5); R = (st >> 1) * 16 + swz / 64; C = (st & 1) * 32 + (swz % 64) / 2; }
__host__ __device__ __forceinline__ int perm32(int rho) { const int n = rho >> 4, i = rho & 15; return 8 * (i >> 2) + 4 * n + (i & 3); }

struct Unit { int pm, pn; };
struct Gemm { const bf16_t* A; const bf16_t* Bt; int M, N, K; };

struct StaticOrder {
    static constexpr bool VAR_NT = false;
    int nM, nN, nwg, G, c, cap, wgm;
    __host__ __device__ void init(int M, int N, int G_, int c_) { nM = M / BM; nN = N / BM; nwg = nM * nN; G = G_; c = c_; cap = nwg; wgm = WGM; }
    __host__ __device__ bool next(int i, Unit& u) const {
        const long L = (long)i * G + c; if (L >= cap) return false;
        int wgid = (int)L; { const int q = nwg / NXCD, r = nwg % NXCD, xcd = wgid % NXCD, off = wgid / NXCD; wgid = (xcd < r ? xcd * (q + 1) : r * (q + 1) + (xcd - r) * q) + off; }
        const int nig = wgm * nN, gid = wgid / nig, fm = gid * wgm, gsz = (nM - fm) < wgm ? (nM - fm) : wgm;
        u.pm = fm + ((wgid % nig) % gsz); u.pn = (wgid % nig) / gsz; return true;
    }
    __device__ __forceinline__ void a_ready(const Unit&) const {}
    __device__ __forceinline__ void done(const Unit&) const {}
};

__device__ __forceinline__ unsigned cvt_pk_bf16(float lo, float hi) { unsigned r; asm volatile("v_cvt_pk_bf16_f32 %0, %1, %2" : "=v"(r) : "v"(lo), "v"(hi)); return r; }
typedef float f32x2 __attribute__((ext_vector_type(2)));
__device__ __forceinline__ f32x2 gelu_pk(f32x2 v) {
    const f32x2 av = __builtin_elementwise_abs(v), d = av * 0.2316418882f + 1.0f;
    f32x2 t; t.x = __builtin_amdgcn_rcpf(d.x); t.y = __builtin_amdgcn_rcpf(d.y);
    f32x2 q = t * 0.5307027145f + (-0.7265760135f); q = q * t + 0.7107068705f; q = q * t + (-0.142248368f); q = q * t + 0.127414796f; q = q * t;
    const f32x2 s = (v * v) * (-0.72134752044f);
    f32x2 e; e.x = __builtin_amdgcn_exp2f(s.x); e.y = __builtin_amdgcn_exp2f(s.y);
    const f32x2 m = v * (q * e), r = v - m;
    f32x2 o; o.x = v.x < 0.f ? m.x : r.x; o.y = v.y < 0.f ? m.y : r.y; return o;
}

template <int ACT  > struct EpiBf16 {
    static constexpr bool PERM = true, AFTER_DRAIN = false, INPLACE = false; static_assert(ACT == 0 || ACT == 1, "EpiBf16: ACT is 0 (none) or 1 (gelu_pk)");
    bf16_t* O; int ldc; const float* bias; int split_cols; size_t split_stride; float scale0;
    __device__ __forceinline__ void operator()(const f32x4 (&acc)[2][2][4][2], const Unit& u, int wr, int wc, int fr, int fq) const {
        const int row0 = u.pm * BM + wr * 64 + fr; int colt = u.pn * BM; bf16_t* base = O;
        float sc = 1.f; if (split_cols) { const int t = colt / split_cols; base += (size_t)t * split_stride; colt -= t * split_cols; if (t == 0) sc = scale0; }
        const int col0 = colt + wc * 32 + 8 * fq, bcol0 = u.pn * BM + wc * 32 + 8 * fq;
        f32x4 bv[2][2];
#pragma unroll
        for (int bj = 0; bj < 2; ++bj)
#pragma unroll
            for (int n = 0; n < 2; ++n) bv[bj][n] = bias ? *(const f32x4*)(bias + bcol0 + bj * HALF + 4 * n) : (f32x4){0.f, 0.f, 0.f, 0.f};
#pragma unroll
        for (int ai = 0; ai < 2; ++ai)
#pragma unroll
            for (int m = 0; m < 4; ++m) { bf16_t* rowp = base + (size_t)(row0 + ai * HALF + m * 16) * ldc + col0;
#pragma unroll
                for (int bj = 0; bj < 2; ++bj) { f32x4 v0 = acc[ai][bj][m][0] + bv[bj][0], v1 = acc[ai][bj][m][1] + bv[bj][1];
                    if (ACT == 1) { f32x2 a = gelu_pk((f32x2){v0[0], v0[1]}), b = gelu_pk((f32x2){v0[2], v0[3]}), c = gelu_pk((f32x2){v1[0], v1[1]}), d = gelu_pk((f32x2){v1[2], v1[3]});
                        v0 = (f32x4){a.x, a.y, b.x, b.y}; v1 = (f32x4){c.x, c.y, d.x, d.y}; }
                    v0 = v0 * sc; v1 = v1 * sc; u32x4 w; w.x = cvt_pk_bf16(v0[0], v0[1]); w.y = cvt_pk_bf16(v0[2], v0[3]); w.z = cvt_pk_bf16(v1[0], v1[1]); w.w = cvt_pk_bf16(v1[2], v1[3]);
                    *(u32x4*)(rowp + bj * HALF) = w; } }
    }
};
template <class Epi, class Sched, bool ALIGN_EPI = false, bool SP2 = false>
__device__ __forceinline__ void gemm_phase(PG8_LAS unsigned char* lds, const Gemm g, const Sched& S, const Epi& E) {
    const int tid = threadIdx.x, wid = __builtin_amdgcn_readfirstlane(tid >> 6), lane = tid & 63, wr = wid >> 2, wc = wid & 3, fr = lane & 15, fq = lane >> 4;
    const int K = g.K; int nt = K / BK;
    unsigned voffA[2], voffB[2];
#pragma unroll
    for (int i = 0; i < 2; ++i) { int R, C; stage_rc(tid * 16 + i * 8192, R, C); const int Rb = Epi::PERM ? ((R & ~31) + perm32(R & 31)) : R;
        voffA[i] = (unsigned)(R * K + C) * 2u; voffB[i] = (unsigned)(Rb * K + C) * 2u; }
    const size_t kstep = (size_t)(BK * 2);
    const size_t hstep = (size_t)HALF * K * 2;
    const size_t tstep = 2 * hstep;
    const unsigned ldsw = (unsigned)wid * 1024u;
    const int aoff = lds_byte(wr * 64 + fr, fq * 8), boff = lds_byte(wc * 32 + fr, fq * 8);
#define PG8_SA(b, h) (((b) * 2 + (h)) * HTB)
#define PG8_SB(b, h) ((4 + (b) * 2 + (h)) * HTB)
#define PG8_STAGE(bufoff, gbase, voff) do { _Pragma("unroll") for (int _i = 0; _i < 2; ++_i) \
        __builtin_amdgcn_global_load_lds((const unsigned*)((const char*)(gbase) + (voff)[_i]), (PG8_LAS unsigned*)(lds + (bufoff) + ldsw + _i * 8192), 16, 0, 0); } while (0)
#define PG8_LDA(dst, b, h) do { _Pragma("unroll") for (int m = 0; m < 4; ++m) _Pragma("unroll") for (int k = 0; k < 2; ++k) dst[m][k] = *(const PG8_LAS bf16x8*)(lds + PG8_SA(b, h) + aoff + m * 2048 + k * 1024); } while (0)
#define PG8_LDB(dst, b, h) do { _Pragma("unroll") for (int n = 0; n < 2; ++n) _Pragma("unroll") for (int k = 0; k < 2; ++k) dst[n][k] = *(const PG8_LAS bf16x8*)(lds + PG8_SB(b, h) + boff + n * 2048 + k * 1024); } while (0)
#define PG8_MMA(ai, bj, At, Bt) do { __builtin_amdgcn_s_setprio(1); _Pragma("unroll") for (int m = 0; m < 4; ++m) _Pragma("unroll") for (int n = 0; n < 2; ++n) _Pragma("unroll") for (int k = 0; k < 2; ++k) \
        acc[ai][bj][m][n] = __builtin_amdgcn_mfma_f32_16x16x32_bf16(Bt[n][k], At[m][k], acc[ai][bj][m][n], 0, 0, 0); __builtin_amdgcn_s_setprio(0); } while (0)
#define PG8_WAIT_V(n) asm volatile("s_waitcnt vmcnt(" #n ")" ::: "memory")
#define PG8_WAIT_L(n) asm volatile("s_waitcnt lgkmcnt(" #n ")" ::: "memory")
#define PG8_BAR __builtin_amdgcn_s_barrier()
#define PG8_SCHED __builtin_amdgcn_sched_barrier(0)
    Unit cur, nxt; int ui = 0;
    if (!S.next(0, cur)) return;
    if constexpr (Sched::VAR_NT) nt = S.unit_nt(cur);
    f32x4 acc[2][2][4][2];
#pragma unroll
    for (int a = 0; a < 2; ++a)
#pragma unroll
        for (int b = 0; b < 2; ++b)
#pragma unroll
            for (int m = 0; m < 4; ++m)
#pragma unroll
                for (int n = 0; n < 2; ++n) acc[a][b][m][n] = (f32x4){0.f, 0.f, 0.f, 0.f};
    bf16x8 At[4][2], B0[2][2], B1[2][2];
    const char* cA = (const char*)g.A + (size_t)cur.pm * tstep; const char* cB = (const char*)g.Bt + (size_t)cur.pn * tstep;
    S.a_ready(cur);
    if constexpr (SP2) {
        PG8_STAGE(PG8_SB(0, 0), cB, voffB); PG8_STAGE(PG8_SB(0, 1), cB + hstep, voffB); PG8_STAGE(PG8_SA(0, 0), cA, voffA); PG8_STAGE(PG8_SA(0, 1), cA + hstep, voffA);
        if (wr == 1) PG8_BAR;
        PG8_WAIT_V(2); PG8_BAR;
        PG8_STAGE(PG8_SB(1, 0), cB + kstep, voffB); PG8_STAGE(PG8_SA(1, 0), cA + kstep, voffA); PG8_STAGE(PG8_SB(1, 1), cB + hstep + kstep, voffB);
        PG8_WAIT_V(6); PG8_BAR;
    } else {
        PG8_STAGE(PG8_SB(0, 0), cB, voffB); PG8_STAGE(PG8_SA(0, 0), cA, voffA); PG8_STAGE(PG8_SB(0, 1), cB + hstep, voffB); PG8_STAGE(PG8_SA(0, 1), cA + hstep, voffA);
        if (wr == 1) PG8_BAR;
        PG8_WAIT_V(4); PG8_BAR;
        PG8_STAGE(PG8_SB(1, 0), cB + kstep, voffB); PG8_STAGE(PG8_SA(1, 0), cA + kstep, voffA); PG8_STAGE(PG8_SB(1, 1), cB + hstep + kstep, voffB);
        PG8_WAIT_V(6); PG8_BAR;
    }
    for (;;) {
        const bool has_next = S.next(ui + 1, nxt);
        const char* nA = has_next ? (const char*)g.A + (size_t)nxt.pm * tstep : cA; const char* nB = has_next ? (const char*)g.Bt + (size_t)nxt.pn * tstep : cB;
        for (int t = 0; t < nt; t += 2) {
            const bool last = (t == nt - 2);
            const char* a1 = cA + (size_t)(t + 1) * kstep;
            const char* a2 = last ? nA : cA + (size_t)(t + 2) * kstep; const char* b2 = last ? nB : cB + (size_t)(t + 2) * kstep;
            const char* a3 = a2 + kstep; const char* b3 = b2 + kstep;
            if (last && has_next) S.a_ready(nxt);
            if constexpr (SP2) {
            PG8_LDB(B0, 0, 0); PG8_LDB(B1, 0, 1); PG8_SCHED; PG8_LDA(At, 0, 0); PG8_STAGE(PG8_SA(1, 1), a1 + hstep, voffA);
            PG8_WAIT_V(8); PG8_WAIT_L(0); PG8_BAR; PG8_MMA(0, 0, At, B0); PG8_MMA(0, 1, At, B1); PG8_BAR; PG8_SCHED;
            PG8_LDA(At, 0, 1); PG8_STAGE(PG8_SB(0, 0), b2, voffB); PG8_STAGE(PG8_SB(0, 1), b2 + hstep, voffB); PG8_STAGE(PG8_SA(0, 0), a2, voffA);
            PG8_WAIT_V(8); PG8_WAIT_L(0); PG8_BAR; PG8_MMA(1, 0, At, B0); PG8_MMA(1, 1, At, B1); PG8_BAR; PG8_SCHED;
            PG8_LDB(B0, 1, 0); PG8_LDB(B1, 1, 1); PG8_SCHED; PG8_LDA(At, 1, 0); PG8_STAGE(PG8_SA(0, 1), a2 + hstep, voffA);
            PG8_WAIT_V(8); PG8_WAIT_L(0); PG8_BAR; PG8_MMA(0, 0, At, B0); PG8_MMA(0, 1, At, B1); PG8_BAR; PG8_SCHED;
            PG8_LDA(At, 1, 1); PG8_STAGE(PG8_SB(1, 0), b3, voffB); PG8_STAGE(PG8_SB(1, 1), b3 + hstep, voffB); PG8_STAGE(PG8_SA(1, 0), a3, voffA);
            PG8_WAIT_V(8); PG8_WAIT_L(0); PG8_BAR; PG8_MMA(1, 0, At, B0); PG8_MMA(1, 1, At, B1); PG8_BAR; PG8_SCHED;
            } else {
            PG8_LDB(B0, 0, 0); PG8_SCHED; PG8_LDA(At, 0, 0); PG8_STAGE(PG8_SA(1, 1), a1 + hstep, voffA);
            PG8_WAIT_L(8); PG8_BAR; PG8_WAIT_L(0); PG8_MMA(0, 0, At, B0); PG8_BAR; PG8_SCHED;
            PG8_LDB(B1, 0, 1); PG8_STAGE(PG8_SB(0, 0), b2, voffB);
            PG8_BAR; PG8_WAIT_L(0); PG8_MMA(0, 1, At, B1); PG8_BAR;
            PG8_LDA(At, 0, 1); PG8_STAGE(PG8_SA(0, 0), a2, voffA);
            PG8_BAR; PG8_WAIT_L(0); PG8_MMA(1, 0, At, B0); PG8_BAR; PG8_SCHED;
            PG8_STAGE(PG8_SB(0, 1), b2 + hstep, voffB);
            PG8_WAIT_V(6); PG8_BAR; PG8_MMA(1, 1, At, B1); PG8_BAR;
            PG8_LDB(B0, 1, 0); PG8_SCHED; PG8_LDA(At, 1, 0); PG8_STAGE(PG8_SA(0, 1), a2 + hstep, voffA);
            PG8_WAIT_L(8); PG8_BAR; PG8_WAIT_L(0); PG8_MMA(0, 0, At, B0); PG8_BAR; PG8_SCHED;
            PG8_LDB(B1, 1, 1); PG8_STAGE(PG8_SB(1, 0), b3, voffB);
            PG8_BAR; PG8_WAIT_L(0); PG8_MMA(0, 1, At, B1); PG8_BAR;
            PG8_LDA(At, 1, 1); PG8_STAGE(PG8_SA(1, 0), a3, voffA);
            PG8_BAR; PG8_WAIT_L(0); PG8_MMA(1, 0, At, B0); PG8_BAR; PG8_SCHED;
            PG8_STAGE(PG8_SB(1, 1), b3 + hstep, voffB);
            PG8_WAIT_V(6); PG8_BAR; PG8_MMA(1, 1, At, B1); PG8_BAR;
            }
        }
        if constexpr (ALIGN_EPI) { if (wr == 0) PG8_BAR; }
        bool keep_acc = false;
        if constexpr (Epi::INPLACE) { keep_acc = E.inplace(acc, cur, wr, wc, fr, fq); S.done(cur); }
        else if constexpr (!Epi::AFTER_DRAIN) { E(acc, cur, wr, wc, fr, fq); S.done(cur); }
        if (!has_next) break;
        if (!keep_acc)
#pragma unroll
        for (int a = 0; a < 2; ++a)
#pragma unroll
            for (int b = 0; b < 2; ++b)
#pragma unroll
                for (int m = 0; m < 4; ++m)
#pragma unroll
                    for (int n = 0; n < 2; ++n) acc[a][b][m][n] = (f32x4){0.f, 0.f, 0.f, 0.f};
        cur = nxt; cA = nA; cB = nB; ++ui;
        if constexpr (Sched::VAR_NT) nt = S.unit_nt(cur);
        if constexpr (ALIGN_EPI) { if (wr == 1) PG8_BAR; }
    }
    PG8_WAIT_V(0);
    if constexpr (!ALIGN_EPI) { if (wr == 0) PG8_BAR; }
    PG8_BAR;
    if constexpr (Epi::AFTER_DRAIN) { E.fused(acc, cur, wr, wc, fr, fq, lds, wid, lane); S.done(cur); }
#undef PG8_SA
#undef PG8_SB
#undef PG8_STAGE
#undef PG8_LDA
#undef PG8_LDB
#undef PG8_MMA
#undef PG8_WAIT_V
#undef PG8_WAIT_L
#undef PG8_BAR
#undef PG8_SCHED
}
}

namespace pg8 {
typedef float f32x2e __attribute__((ext_vector_type(2))); typedef __bf16 bf16x2e __attribute__((ext_vector_type(2)));
__device__ __forceinline__ unsigned cvtpk(float lo, float hi) { f32x2e v = {lo, hi}; bf16x2e b = __builtin_convertvector(v, bf16x2e); return __builtin_bit_cast(unsigned, b); }
__device__ __forceinline__ float bflo(unsigned u) { return __builtin_bit_cast(float, u << 16); }
__device__ __forceinline__ float bfhi(unsigned u) { return __builtin_bit_cast(float, u & 0xffff0000u); }
__device__ __forceinline__ void st16_wt(void* p, u32x4 v) { asm volatile("global_store_dwordx4 %0, %1, off sc1\n\ts_nop 1" :: "v"(p), "v"(v) : "memory"); }
__device__ __forceinline__ float sigm(float v) { return __builtin_amdgcn_rcpf(1.0f + __expf(-v)); }

struct EpiProj {
    static constexpr bool PERM = true, AFTER_DRAIN = false, INPLACE = false;
    bf16_t* proj; bf16_t* gates; int ldp, ldg;
    __device__ __forceinline__ void operator()(const f32x4 (&acc)[2][2][4][2], const Unit& u, int wr, int wc, int fr, int fq) const {
        const int row0 = u.pm * BM + wr * 64 + fr; const int pn = u.pn; const bool isg = (pn >= 19);
        bf16_t* base = isg ? gates : proj; const int ld = isg ? ldg : ldp; const int colt = isg ? (pn - 19) * BM : pn * BM;
        const int col0 = colt + wc * 32 + 8 * fq;
#pragma unroll
        for (int ai = 0; ai < 2; ++ai)
#pragma unroll
            for (int m = 0; m < 4; ++m) { bf16_t* rowp = base + (size_t)(row0 + ai * HALF + m * 16) * ld + col0;
#pragma unroll
                for (int bj = 0; bj < 2; ++bj) { f32x4 v0 = acc[ai][bj][m][0], v1 = acc[ai][bj][m][1];
                    if (isg) { v0 = (f32x4){sigm(v0[0]), sigm(v0[1]), sigm(v0[2]), sigm(v0[3])}; v1 = (f32x4){sigm(v1[0]), sigm(v1[1]), sigm(v1[2]), sigm(v1[3])}; }
                    u32x4 w; w.x = cvtpk(v0[0], v0[1]); w.y = cvtpk(v0[2], v0[3]); w.z = cvtpk(v1[0], v1[1]); w.w = cvtpk(v1[2], v1[3]);
                    *(u32x4*)(rowp + bj * HALF) = w; } }
    }
};
struct EpiPlain {
    static constexpr bool PERM = true, AFTER_DRAIN = false, INPLACE = false;
    bf16_t* O; int ldc;
    __device__ __forceinline__ void operator()(const f32x4 (&acc)[2][2][4][2], const Unit& u, int wr, int wc, int fr, int fq) const {
        const int row0 = u.pm * BM + wr * 64 + fr; const int col0 = u.pn * BM + wc * 32 + 8 * fq;
#pragma unroll
        for (int ai = 0; ai < 2; ++ai)
#pragma unroll
            for (int m = 0; m < 4; ++m) { bf16_t* rowp = O + (size_t)(row0 + ai * HALF + m * 16) * ldc + col0;
#pragma unroll
                for (int bj = 0; bj < 2; ++bj) { const f32x4 v0 = acc[ai][bj][m][0], v1 = acc[ai][bj][m][1];
                    u32x4 w; w.x = cvtpk(v0[0], v0[1]); w.y = cvtpk(v0[2], v0[3]); w.z = cvtpk(v1[0], v1[1]); w.w = cvtpk(v1[2], v1[3]);
                    *(u32x4*)(rowp + bj * HALF) = w; } }
    }
};
template <int NH, int SEQL> struct EpiVt {
    static constexpr bool PERM = true, AFTER_DRAIN = false, INPLACE = false;
    unsigned char* vt;
    __device__ __forceinline__ void operator()(const f32x4 (&acc)[2][2][4][2], const Unit& u, int wr, int wc, int fr, int fq) const {
        constexpr int NKT = SEQL / 32;
        const int row0 = u.pm * BM + wr * 64 + fr; const int col0 = u.pn * BM + wc * 32 + 8 * fq;
#pragma unroll
        for (int ai = 0; ai < 2; ++ai)
#pragma unroll
            for (int m = 0; m < 4; ++m) { const int drow = row0 + ai * HALF + m * 16; const int hh = drow >> 7, d = drow & 127, dt = d >> 5, dl = d & 31;
#pragma unroll
                for (int bj = 0; bj < 2; ++bj) { const int t0 = col0 + bj * HALF; const int b = t0 / SEQL, tt = t0 % SEQL, kt = tt >> 5, s = (tt >> 4) & 1, o8 = (tt >> 3) & 1;
                    const size_t blk = ((((size_t)(b * NH + hh) * NKT + kt) * 2 + s) * 4 + dt);
                    unsigned char* p = vt + blk * 1024 + dl * 16 + o8 * 8;
                    const f32x4 v0 = acc[ai][bj][m][0], v1 = acc[ai][bj][m][1];
                    unsigned long long w0 = (unsigned long long)cvtpk(v0[0], v0[1]) | ((unsigned long long)cvtpk(v0[2], v0[3]) << 32);
                    unsigned long long w1 = (unsigned long long)cvtpk(v1[0], v1[1]) | ((unsigned long long)cvtpk(v1[2], v1[3]) << 32);
                    *(unsigned long long*)p = w0; *(unsigned long long*)(p + 512) = w1; } }
    }
};
struct MergeOrder {
    static constexpr bool VAR_NT = true;
    __device__ __forceinline__ int unit_nt(const Unit& u) const { return (u.pm >> 5) == 2 ? 8 : 12; }
    StaticOrder so;
    __device__ void init(int M, int N, int G_, int c_) { so.init(M, N, G_, c_); }
    __device__ bool next(int i, Unit& u) const { const int ib = i / 3, br = i - 3 * ib; if (!so.next(ib, u)) return false; u.pm += 32 * br; u.pn += 8 * br; return true; }
    __device__ __forceinline__ void a_ready(const Unit&) const {}
    __device__ __forceinline__ void done(const Unit&) const {}
};
struct EpiMergeAll {
    static constexpr bool PERM = true, AFTER_DRAIN = false, INPLACE = true;
    const bf16_t* gates; bf16_t* merged; int ldg, ldc;
    __device__ __forceinline__ bool inplace(f32x4 (&acc)[2][2][4][2], const Unit& u, int wr, int wc, int fr, int fq) const {
        const int br = u.pm >> 5, pm = u.pm & 31, pn = u.pn & 7;
        const int row0 = pm * BM + wr * 64 + fr; const int col0 = pn * BM + wc * 32 + 8 * fq;
        const bf16_t* gb = gates + br * 2048; const bf16_t* gd = gates + (br < 2 ? br + 1 : 2) * 2048;
        const f32x4 tiny = (f32x4){1e-20f, 1e-20f, 1e-20f, 1e-20f};
        const bool last = br == 2;
#pragma unroll
        for (int am = 0; am < 4; ++am) { const int ai = am >> 1, m0 = (am & 1) * 2;
            u32x4 g[2][2], gn[2][2];
#pragma unroll
            for (int mm = 0; mm < 2; ++mm)
#pragma unroll
                for (int bj = 0; bj < 2; ++bj) { const size_t off = (size_t)(row0 + ai * HALF + (m0 + mm) * 16) * ldg + col0 + bj * HALF;
                    g[mm][bj] = *(const u32x4*)(gb + off); gn[mm][bj] = *(const u32x4*)(gd + off); }
            __builtin_amdgcn_sched_barrier(0);
#pragma unroll
            for (int mm = 0; mm < 2; ++mm)
#pragma unroll
                for (int bj = 0; bj < 2; ++bj) { const int m = m0 + mm; const u32x4 gg = g[mm][bj], gq = gn[mm][bj];
                    f32x4 s0 = (f32x4){bflo(gg.x), bfhi(gg.x), bflo(gg.y), bfhi(gg.y)}, s1 = (f32x4){bflo(gg.z), bfhi(gg.z), bflo(gg.w), bfhi(gg.w)};
                    f32x4 d0 = (f32x4){bflo(gq.x), bfhi(gq.x), bflo(gq.y), bfhi(gq.y)}, d1 = (f32x4){bflo(gq.z), bfhi(gq.z), bflo(gq.w), bfhi(gq.w)};
                    s0 = __builtin_elementwise_max(s0, tiny); s1 = __builtin_elementwise_max(s1, tiny);
                    d0 = __builtin_elementwise_max(d0, tiny); d1 = __builtin_elementwise_max(d1, tiny);
                    if (last) { d0 = (f32x4){1.f, 1.f, 1.f, 1.f}; d1 = d0; }
                    s0 = s0 * (f32x4){__builtin_amdgcn_rcpf(d0[0]), __builtin_amdgcn_rcpf(d0[1]), __builtin_amdgcn_rcpf(d0[2]), __builtin_amdgcn_rcpf(d0[3])};
                    s1 = s1 * (f32x4){__builtin_amdgcn_rcpf(d1[0]), __builtin_amdgcn_rcpf(d1[1]), __builtin_amdgcn_rcpf(d1[2]), __builtin_amdgcn_rcpf(d1[3])};
                    const f32x4 v0 = acc[ai][bj][m][0] * s0, v1 = acc[ai][bj][m][1] * s1;
                    acc[ai][bj][m][0] = v0; acc[ai][bj][m][1] = v1;
                    if (last) { u32x4 w; w.x = cvtpk(v0[0], v0[1]); w.y = cvtpk(v0[2], v0[3]); w.z = cvtpk(v1[0], v1[1]); w.w = cvtpk(v1[2], v1[3]);
                        *(u32x4*)(merged + (size_t)(row0 + ai * HALF + m * 16) * ldc + col0 + bj * HALF) = w; } }
        }
        return !last;
    }
};
struct EpiOut {
    static constexpr bool PERM = true, AFTER_DRAIN = false, INPLACE = false;
    const float* x; float* out; bf16_t* xn2; float* ssq; int ldc; float sscale;
    __device__ __forceinline__ void operator()(const f32x4 (&acc)[2][2][4][2], const Unit& u, int wr, int wc, int fr, int fq) const {
        const int row0 = u.pm * BM + wr * 64 + fr; const int col0 = u.pn * BM + wc * 32 + 8 * fq;
#pragma unroll
        for (int am = 0; am < 4; ++am) { const int ai = am >> 1, m0 = (am & 1) * 2;
            f32x4 xv[2][2][2];
#pragma unroll
            for (int mm = 0; mm < 2; ++mm)
#pragma unroll
                for (int bj = 0; bj < 2; ++bj) { const size_t off = (size_t)(row0 + ai * HALF + (m0 + mm) * 16) * ldc + col0 + bj * HALF;
                    xv[mm][bj][0] = *(const f32x4*)(x + off); xv[mm][bj][1] = *(const f32x4*)(x + off + 4); }
            __builtin_amdgcn_sched_barrier(0);
#pragma unroll
            for (int mm = 0; mm < 2; ++mm) { const int m = m0 + mm; const size_t r = (size_t)(row0 + ai * HALF + m * 16); float rs = 0.f;
#pragma unroll
                for (int bj = 0; bj < 2; ++bj) { const size_t off = r * ldc + col0 + bj * HALF;
                    const f32x4 v0 = acc[ai][bj][m][0] + xv[mm][bj][0], v1 = acc[ai][bj][m][1] + xv[mm][bj][1];
                    rs += (v0[0] * v0[0] + v0[1] * v0[1]) + (v0[2] * v0[2] + v0[3] * v0[3]) + (v1[0] * v1[0] + v1[1] * v1[1]) + (v1[2] * v1[2] + v1[3] * v1[3]);
                    u32x4 w; w.x = cvtpk(v0[0], v0[1]); w.y = cvtpk(v0[2], v0[3]); w.z = cvtpk(v1[0], v1[1]); w.w = cvtpk(v1[2], v1[3]); *(u32x4*)(xn2 + off) = w; }
                rs += __shfl_xor(rs, 16); rs += __shfl_xor(rs, 32);
                if (fq == 0) atomicAdd(ssq + r, rs * sscale); }
        }
    }
};
struct EpiUp {
    static constexpr bool PERM = true, AFTER_DRAIN = false, INPLACE = false;
    const float* ssq; bf16_t* H; int ldc; float inv_d, eps;
    __device__ __forceinline__ void operator()(const f32x4 (&acc)[2][2][4][2], const Unit& u, int wr, int wc, int fr, int fq) const {
        const int row0 = u.pm * BM + wr * 64 + fr; const int col0 = u.pn * BM + wc * 32 + 8 * fq;
        float sq[2][4];
#pragma unroll
        for (int ai = 0; ai < 2; ++ai)
#pragma unroll
            for (int m = 0; m < 4; ++m) sq[ai][m] = ssq[row0 + ai * HALF + m * 16];
        __builtin_amdgcn_sched_barrier(0);
#pragma unroll
        for (int ai = 0; ai < 2; ++ai)
#pragma unroll
            for (int m = 0; m < 4; ++m) { const size_t r = (size_t)(row0 + ai * HALF + m * 16); const float rstd = 1.0f / sqrtf(sq[ai][m] * inv_d + eps);
#pragma unroll
                for (int bj = 0; bj < 2; ++bj) { const int c = col0 + bj * HALF;
                    f32x4 v0 = acc[ai][bj][m][0] * rstd, v1 = acc[ai][bj][m][1] * rstd;
                    v0 = __builtin_elementwise_max(v0, (f32x4){0.f, 0.f, 0.f, 0.f}); v1 = __builtin_elementwise_max(v1, (f32x4){0.f, 0.f, 0.f, 0.f});
                    v0 = v0 * v0; v1 = v1 * v1;
                    u32x4 w; w.x = cvtpk(v0[0], v0[1]); w.y = cvtpk(v0[2], v0[3]); w.z = cvtpk(v1[0], v1[1]); w.w = cvtpk(v1[2], v1[3]); *(u32x4*)(H + r * ldc + c) = w; } }
    }
};
struct EpiDown {
    static constexpr bool PERM = true, AFTER_DRAIN = false, INPLACE = false;
    const bf16_t* x1; float* out; int ldc; float scale;
    __device__ __forceinline__ void operator()(const f32x4 (&acc)[2][2][4][2], const Unit& u, int wr, int wc, int fr, int fq) const {
        const int row0 = u.pm * BM + wr * 64 + fr; const int col0 = u.pn * BM + wc * 32 + 8 * fq;
#pragma unroll
        for (int ai = 0; ai < 2; ++ai) {
            u32x4 g[4][2];
#pragma unroll
            for (int m = 0; m < 4; ++m)
#pragma unroll
                for (int bj = 0; bj < 2; ++bj) g[m][bj] = *(const u32x4*)(x1 + (size_t)(row0 + ai * HALF + m * 16) * ldc + col0 + bj * HALF);
            __builtin_amdgcn_sched_barrier(0);
#pragma unroll
            for (int m = 0; m < 4; ++m)
#pragma unroll
                for (int bj = 0; bj < 2; ++bj) { const size_t off = (size_t)(row0 + ai * HALF + m * 16) * ldc + col0 + bj * HALF; const u32x4 gg = g[m][bj];
                    const f32x4 v0 = (f32x4){bflo(gg.x), bfhi(gg.x), bflo(gg.y), bfhi(gg.y)} + acc[ai][bj][m][0] * scale, v1 = (f32x4){bflo(gg.z), bfhi(gg.z), bflo(gg.w), bfhi(gg.w)} + acc[ai][bj][m][1] * scale;
                    *(f32x4*)(out + off) = v0; *(f32x4*)(out + off + 4) = v1; }
        }
    }
};
}

constexpr int NWAVES = 8;
constexpr int DM = 2048, NBATCH = 4, SEQ = 2048, MT = NBATCH * SEQ;
constexpr int MEML = 256, MMEM = NBATCH * MEML;
constexpr int NIN = 11020;
constexpr int NMAIN = 11008;
constexpr int NWIN = 11264;
constexpr int LDP = 4864, LDG = 6144, DFF = 8192;
constexpr float EPS = 1e-6f;
constexpr float LOG2E = 1.4426950408889634f;
constexpr float QSCALE = 0.08838834764831845f * 1.4426950408889634f;
constexpr int PC_DNZ = 2304, PC_SQ = 3072, PC_SK = 3840, PC_MQ = 4096, PC_BA = 4608;
constexpr int P1_CAP = 1232, NTAIL = 1376 - 1232;
constexpr int NCHUNK = NBATCH * 6 * 32;
constexpr int CH_W = 0, CH_QG = 16384, CH_KD = 32768, CH_P = 49152, CH_U = 57344, CH_ZG = 73728, CH_BYTES = 90112;

constexpr size_t MiB = 1u << 20;
constexpr size_t WS_CTL = 0, CTL_ZERO_BYTES = 1 * MiB;
constexpr size_t WS_SSQ = 512 * 1024;
constexpr size_t WS_WOUT = 1 * MiB, WS_PDN = 9 * MiB, WS_PSWA = 12 * MiB, WS_PMEM = 15 * MiB;
constexpr size_t WS_WUP = 18 * MiB, WS_WDN = 50 * MiB;
constexpr size_t WS_RHS = 18 * MiB;
constexpr size_t WS_DNF2 = 82 * MiB;
constexpr size_t DO_WIN = 0, DO_WMKV = 44 * MiB, DO_MEMN = 48 * MiB;
constexpr int DNF_SPLIT = 23 * 32;
static_assert((size_t)DNF_SPLIT * CH_BYTES <= (size_t)64 * MiB && WS_DNF2 + (size_t)32 * CH_BYTES <= 85 * MiB && DO_MEMN + 4 * MiB <= 64 * MiB, "d_out scratch map");
constexpr size_t WS_XN = 85 * MiB;
constexpr size_t WS_PROJ = 117 * MiB;
constexpr size_t WS_ODN = 117 * MiB, WS_OSWA = 129 * MiB, WS_OMEM = 141 * MiB, WS_MERGED = 153 * MiB;
constexpr size_t WS_GATES = 193 * MiB;
constexpr size_t WS_VT = 289 * MiB, WS_MVT = 293 * MiB, WS_MEMK = 294 * MiB;
constexpr size_t WS_QF = 295 * MiB, WS_KF = 307 * MiB, WS_MQF = 311 * MiB, WS_MKF = 319 * MiB, WS_GC = 320 * MiB, WS_LG = 321 * MiB, WS_WTAIL = 328 * MiB;
constexpr size_t WS_H = 117 * MiB;
constexpr size_t WS_END = 334 * MiB;
static_assert(WS_PROJ + (size_t)MT * LDP * 2 <= WS_GATES && WS_GATES + (size_t)MT * LDG * 2 <= WS_VT, "ws map");
static_assert(WS_H + (size_t)MT * DFF * 2 <= WS_VT, "ws map 2");
constexpr int CW_BAR = 4096;

constexpr int RING_OFF = 0, RING_BYTES = 131072;
constexpr int LDS_BYTES = 147456;
constexpr int LDSCTL_OFF = LDS_BYTES - 1024, MISC_OFF = LDSCTL_OFF + 320;
#define GAS __attribute__((address_space(1)))
#define LAS __attribute__((address_space(3)))
typedef unsigned short bf16;
typedef unsigned v4u __attribute__((ext_vector_type(4)));
typedef float f32x4 __attribute__((ext_vector_type(4)));
typedef short bf16x8 __attribute__((ext_vector_type(8)));
typedef GAS unsigned gu32;
typedef GAS unsigned long long gu64;
#define RLX_AGENT __ATOMIC_RELAXED, __HIP_MEMORY_SCOPE_AGENT
#define LDS_WAIT() asm volatile("s_waitcnt lgkmcnt(0)" ::: "memory")
#define VM_WAIT() asm volatile("s_waitcnt vmcnt(0)" ::: "memory")
__device__ __forceinline__ unsigned long long rt() { return __builtin_amdgcn_s_memrealtime(); }
__device__ __forceinline__ unsigned f2bf(float f) { unsigned u = __builtin_bit_cast(unsigned, f); return (u + 0x7fffu + ((u >> 16) & 1u)) >> 16; }
__device__ __forceinline__ unsigned pk2(float lo, float hi) { return f2bf(lo) | (f2bf(hi) << 16); }

#define XB_TMO      128
#define XB_XCNT(j)  (256  + 64 * (j))
#define XB_XSUB(j)  (1280 + 64 * (j))
#define XB_XGEN(j)  (2304 + 64 * (j))
#define XB_TOP      3328
#define XB_TOPGEN   3392
#define XCD_BAR_WORDS 3456
#define XB_SPIN_CAP (1u << 18)

__device__ __forceinline__ unsigned xb_ld(unsigned* p)              { return __hip_atomic_load(p, __ATOMIC_RELAXED, __HIP_MEMORY_SCOPE_AGENT); }
__device__ __forceinline__ unsigned xb_add(unsigned* p, unsigned v) { return __hip_atomic_fetch_add(p, v, __ATOMIC_RELAXED, __HIP_MEMORY_SCOPE_AGENT); }
__device__ __forceinline__ unsigned xb_xcc_id() { return (unsigned)__builtin_amdgcn_s_getreg((3 << 11) | 20) & 0xFu; }
#define XB_SPIN(cond, bar) do { unsigned _sp = 0; while (cond) { __builtin_amdgcn_s_sleep(1); \
    if ((++_sp & 255u) == 0u) { if (xb_ld(&(bar)[XB_TMO])) break; if (_sp > XB_SPIN_CAP) { atomicAdd(&(bar)[XB_TMO], 1u); break; } } } } while (0)

struct XcdBarrier {
    unsigned* bar; unsigned x;
    volatile LAS unsigned* st;
};

__device__ __forceinline__ XcdBarrier xcd_barrier_post(unsigned* bar, volatile LAS unsigned* st) {
    XcdBarrier b; b.bar = bar; b.x = xb_xcc_id(); b.st = st;
    if (threadIdx.x == 0) (void)xb_add(&bar[XB_XCNT(b.x)], 1u);
    return b;
}
__device__ __forceinline__ void xcd_barrier_complete(unsigned* bar, unsigned x, unsigned& nloc, unsigned& nx) {
    const unsigned G = gridDim.x * gridDim.y * gridDim.z;
    unsigned sum, cnt, mine, sp = 0u;
    for (;;) {
        sum = 0u; cnt = 0u; mine = 0u;
#pragma unroll
        for (unsigned j = 0; j < 16; ++j) { const unsigned c = xb_ld(&bar[XB_XCNT(j)]); sum += c; cnt += (c > 0u) ? 1u : 0u; mine = (j == x) ? c : mine; }
        if (sum == G) break;
        __builtin_amdgcn_s_sleep(1);
        if ((++sp & 255u) == 0u) { if (xb_ld(&bar[XB_TMO])) break; if (sp > XB_SPIN_CAP) { atomicAdd(&bar[XB_TMO], 1u); break; } }
    }
    nloc = mine > 0u ? mine : 1u; nx = cnt > 0u ? cnt : 1u;
}

__device__ __forceinline__ void xcd_barrier(const XcdBarrier& b) {
    asm volatile("s_waitcnt vmcnt(0)" ::: "memory");
    __syncthreads();
    if (threadIdx.x == 0) {
        unsigned* bar = b.bar;
        __builtin_amdgcn_s_waitcnt(0);
        unsigned nloc = b.st[0], nx = b.st[1];
        if (nloc == 0u) { xcd_barrier_complete(bar, b.x, nloc, nx); b.st[0] = nloc; b.st[1] = nx; }
        const unsigned old = xb_add(&bar[XB_XSUB(b.x)], 1u);
        const unsigned gen = old / nloc;
        if (old + 1u == (gen + 1u) * nloc) {
            __builtin_amdgcn_fence(__ATOMIC_RELEASE, "agent");
            asm volatile("s_waitcnt vmcnt(0)" ::: "memory");
            const unsigned og = xb_add(&bar[XB_TOP], 1u);
            const unsigned tg = og / nx;
            if (og + 1u == (tg + 1u) * nx) xb_add(&bar[XB_TOPGEN], 1u);
            else XB_SPIN(xb_ld(&bar[XB_TOPGEN]) == tg, bar);
            __builtin_amdgcn_fence(__ATOMIC_ACQUIRE, "agent");
            xb_add(&bar[XB_XGEN(b.x)], 1u);
            asm volatile("s_waitcnt vmcnt(0)" ::: "memory");
        } else {
            XB_SPIN(xb_ld(&bar[XB_XGEN(b.x)]) == gen, bar);
            __builtin_amdgcn_fence(__ATOMIC_ACQUIRE, "agent");
            asm volatile("s_waitcnt vmcnt(0)" ::: "memory");
        }
    }
    __syncthreads();
}

typedef unsigned v2u __attribute__((ext_vector_type(2)));
typedef float f32x16 __attribute__((ext_vector_type(16)));
using pg8::cvtpk; using pg8::bflo; using pg8::bfhi;
__device__ __forceinline__ float bf2f(unsigned short b) { return __builtin_bit_cast(float, (unsigned)b << 16); }
__device__ __forceinline__ float wave_sum(float v) {
#pragma unroll
    for (int o = 1; o < 64; o <<= 1) v += __shfl_xor(v, o);
    return v;
}
__device__ __forceinline__ bf16x8 pack8(f32x4 a, f32x4 b) {
    v4u w; w.x = cvtpk(a[0], a[1]); w.y = cvtpk(a[2], a[3]); w.z = cvtpk(b[0], b[1]); w.w = cvtpk(b[2], b[3]);
    return __builtin_bit_cast(bf16x8, w);
}
__device__ __forceinline__ float siluf(float y) { return y * __builtin_amdgcn_rcpf(1.0f + __expf(-y)); }

struct DnfMap { unsigned char* a; unsigned char* b; __device__ __forceinline__ unsigned char* rec(int chunk) const { return chunk < DNF_SPLIT ? a + (size_t)chunk * CH_BYTES : b + (size_t)(chunk - DNF_SPLIT) * CH_BYTES; } };
template <int MODE> __device__ __forceinline__ int colmap(int nr_in) {
    int nr = nr_in;
    if (MODE == 0) return nr;
    if (MODE == 2) nr += 38 * 256;
    if (nr < 3072) return nr;
    if (nr < 4096) return nr + 12;
    if (nr < 4608) return nr + 268;
    if (nr < 4620) return nr - 4608 + 3072;
    if (nr < 4864) return -1;
    if (nr < 11008) return nr + 12;
    return nr - 11008 + 4108;
}
template <int MODE> __device__ __forceinline__ void tr_load(const float* W, int N, int item, int nblk, int lane, f32x4 (&v)[8]) {
    const int kb = item / nblk, nb = item % nblk, n4 = lane & 7, g = lane >> 3;
    const int kk0 = 64 * kb + 8 * g, n = 32 * nb + 4 * n4;
    const int src = colmap<MODE>(n); const int srcc = src < 0 ? 0 : src;
    const GAS f32x4* p = (const GAS f32x4*)(W + (size_t)kk0 * N + srcc);
#pragma unroll
    for (int i = 0; i < 8; ++i) v[i] = p[(size_t)i * (N / 4)];
}
template <int MODE> __device__ __forceinline__ void tr_store(const float* kscale, bf16* WT, int ldt, int item, int nblk, int lane, f32x4 (&v)[8]) {
    const int kb = item / nblk, nb = item % nblk, n4 = lane & 7, g = lane >> 3;
    const int kk0 = 64 * kb + 8 * g, n = 32 * nb + 4 * n4;
    if (colmap<MODE>(n) < 0) {
#pragma unroll
        for (int i = 0; i < 8; ++i) v[i] = (f32x4){0.f, 0.f, 0.f, 0.f}; }
    if (kscale) { const f32x4 s0 = *(const GAS f32x4*)(kscale + kk0), s1 = *(const GAS f32x4*)(kscale + kk0 + 4);
        v[0] = v[0] * s0.x; v[1] = v[1] * s0.y; v[2] = v[2] * s0.z; v[3] = v[3] * s0.w; v[4] = v[4] * s1.x; v[5] = v[5] * s1.y; v[6] = v[6] * s1.z; v[7] = v[7] * s1.w; }
#pragma unroll
    for (int e = 0; e < 4; ++e) { v4u o; o.x = cvtpk(v[0][e], v[1][e]); o.y = cvtpk(v[2][e], v[3][e]); o.z = cvtpk(v[4][e], v[5][e]); o.w = cvtpk(v[6][e], v[7][e]);
        *(GAS v4u*)(WT + (size_t)(n + e) * ldt + kk0) = o; }
}
template <int MODE> __device__ __forceinline__ void transpose_matrix(const float* W, int K, int N, const float* kscale, bf16* WT, int ldt, int nrows, int gw, int NGW, int lane) {
    const int nblk = nrows / 32, nitems = (K / 64) * nblk;
    for (int it = gw; it < nitems; it += 4 * NGW) {
        f32x4 va[8], vb[8], vc[8], vd[8]; const int it2 = it + NGW, it3 = it + 2 * NGW, it4 = it + 3 * NGW;
        tr_load<MODE>(W, N, it, nblk, lane, va);
        if (it2 < nitems) tr_load<MODE>(W, N, it2, nblk, lane, vb);
        if (it3 < nitems) tr_load<MODE>(W, N, it3, nblk, lane, vc);
        if (it4 < nitems) tr_load<MODE>(W, N, it4, nblk, lane, vd);
        tr_store<MODE>(kscale, WT, ldt, it, nblk, lane, va);
        if (it2 < nitems) tr_store<MODE>(kscale, WT, ldt, it2, nblk, lane, vb);
        if (it3 < nitems) tr_store<MODE>(kscale, WT, ldt, it3, nblk, lane, vc);
        if (it4 < nitems) tr_store<MODE>(kscale, WT, ldt, it4, nblk, lane, vd);
    }
}
__device__ __forceinline__ void rms_load(const float* xrow, int lane, f32x4 (&v)[8]) {
    const GAS f32x4* xr = (const GAS f32x4*)xrow + lane;
#pragma unroll
    for (int j = 0; j < 8; ++j) v[j] = xr[64 * j];
}
__device__ __forceinline__ void rms_finish(const float* w, bf16* orow, int lane, f32x4 (&v)[8]) {
    const GAS f32x4* wr = (const GAS f32x4*)w + lane; float s = 0.f;
#pragma unroll
    for (int j = 0; j < 8; ++j) s += (v[j].x * v[j].x + v[j].y * v[j].y) + (v[j].z * v[j].z + v[j].w * v[j].w);
    const float rstd = 1.0f / sqrtf(wave_sum(s) * (1.0f / DM) + EPS);
    GAS v2u* o8 = (GAS v2u*)orow + lane;
#pragma unroll
    for (int j = 0; j < 8; ++j) { const f32x4 ww = wr[64 * j]; v2u o; o.x = cvtpk(v[j].x * rstd * ww.x, v[j].y * rstd * ww.y); o.y = cvtpk(v[j].z * rstd * ww.z, v[j].w * rstd * ww.w); o8[64 * j] = o; }
}

__device__ __forceinline__ void normfrag_item(const bf16* src, int ld, int row0, int col0, const float* wt, float scale, unsigned char* dst, int lane) {
    const int r = lane & 31, h = lane >> 5;
    const bf16* rp = src + (size_t)(row0 + r) * ld + col0 + 8 * h;
    v4u raw[8]; f32x4 w0[8], w1[8]; float ss = 0.f;
#pragma unroll
    for (int s = 0; s < 8; ++s) { raw[s] = *(const GAS v4u*)(rp + 16 * s); w0[s] = *(const GAS f32x4*)(wt + 16 * s + 8 * h); w1[s] = *(const GAS f32x4*)(wt + 16 * s + 8 * h + 4); }
    __builtin_amdgcn_sched_barrier(0);
#pragma unroll
    for (int s = 0; s < 8; ++s) {
        const float a0 = bflo(raw[s].x), a1 = bfhi(raw[s].x), a2 = bflo(raw[s].y), a3 = bfhi(raw[s].y), a4 = bflo(raw[s].z), a5 = bfhi(raw[s].z), a6 = bflo(raw[s].w), a7 = bfhi(raw[s].w);
        ss += (a0 * a0 + a1 * a1) + (a2 * a2 + a3 * a3) + (a4 * a4 + a5 * a5) + (a6 * a6 + a7 * a7); }
    ss += __shfl_xor(ss, 32);
    const float rstd = scale / sqrtf(ss * (1.0f / 128.0f) + EPS);
#pragma unroll
    for (int s = 0; s < 8; ++s) {
        v4u o; o.x = cvtpk(bflo(raw[s].x) * rstd * w0[s].x, bfhi(raw[s].x) * rstd * w0[s].y); o.y = cvtpk(bflo(raw[s].y) * rstd * w0[s].z, bfhi(raw[s].y) * rstd * w0[s].w);
        o.z = cvtpk(bflo(raw[s].z) * rstd * w1[s].x, bfhi(raw[s].z) * rstd * w1[s].y); o.w = cvtpk(bflo(raw[s].w) * rstd * w1[s].z, bfhi(raw[s].w) * rstd * w1[s].w);
        *(GAS v4u*)(dst + (size_t)(s * 64 + lane) * 16) = o; }
}

constexpr int DP_LD = 132, DP_LL = 68;
constexpr int DP_Q = 0, DP_K = 64 * DP_LD, DP_V = 2 * 64 * DP_LD, DP_L = 3 * 64 * DP_LD, DP_S = DP_L + 64 * DP_LL;
struct DnIn { const bf16* proj; const float* convw; const float* alog; const float* dtb; DnfMap dnf; float* gc; unsigned char* lg; unsigned char* rhs; };

__device__ __forceinline__ void dn_conv_issue(const DnIn& I, int chunk, int tid, unsigned (&uraw)[35]) {
    if (tid < 384) {
        const int b = chunk / 192, h = (chunk / 32) % 6, n = chunk & 31;
        const int ch2 = tid % 192, tg = tid / 192, which = ch2 >> 6, cp = ch2 & 63;
        const int gcol = which * 768 + h * 128 + 2 * cp;
        const int p0 = 64 * n + 32 * tg - 3;
        const bf16* src = I.proj + ((long)(b * SEQ + p0) * LDP + gcol);
#pragma unroll
        for (int i = 0; i < 35; ++i) { const int ic = (p0 + i >= 0) ? i : -p0;
            uraw[i] = *(const GAS unsigned*)(src + (long)ic * LDP); }
    }
}
__device__ __forceinline__ void dn_prep_chunk(const DnIn& I, LAS float* L, int chunk, int next_chunk, int tid_in, unsigned (&uraw)[35]) {
    int tz; asm volatile("v_mov_b32 %0, 0" : "=v"(tz));
    const int tid = tid_in + tz;
    const int lane = tid & 63, wave = __builtin_amdgcn_readfirstlane(tid >> 6);
    const int b = chunk / 192, h = (chunk / 32) % 6, n = chunk & 31;
    const int t0 = b * SEQ + 64 * n;
    LAS float* QS = L + DP_Q; LAS float* KS = L + DP_K; LAS float* VS = L + DP_V; LAS float* LM = L + DP_L;
    LAS float* sb = L + DP_S; LAS float* sG = sb + 64; LAS float* seG = sb + 128; LAS float* srq = sb + 192; LAS float* srk = sb + 256;
    unsigned char* rec = I.dnf.rec(chunk);
    unsigned short zraw[4][4];
    { const int c = lane & 15, q = lane >> 4;
#pragma unroll
      for (int f = 0; f < 4; ++f) { const int fi = wave * 4 + f, sl = fi >> 2, mt = fi & 3;
#pragma unroll
          for (int r = 0; r < 4; ++r) zraw[f][r] = I.proj[(size_t)(t0 + 16 * mt + 4 * q + r) * LDP + PC_DNZ + h * 128 + 16 * sl + c]; } }
    if (tid < 384) {
        const int ch2 = tid % 192, tg = tid / 192, which = ch2 >> 6, cp = ch2 & 63;
        const int gcol = which * 768 + h * 128 + 2 * cp;
        float w0[4], w1[4];
#pragma unroll
        for (int k = 0; k < 4; ++k) { w0[k] = I.convw[k * 2304 + gcol]; w1[k] = I.convw[k * 2304 + gcol + 1]; }
        const int p0 = 64 * n + 32 * tg - 3;
        float xa[35], xb[35];
#pragma unroll
        for (int i = 0; i < 35; ++i) { unsigned u = uraw[i]; if (p0 + i < 0) u = 0u; xa[i] = bflo(u); xb[i] = bfhi(u); }
        if (next_chunk < NCHUNK) dn_conv_issue(I, next_chunk, tid, uraw);
        LAS float* dst = L + which * 64 * DP_LD + (32 * tg) * DP_LD + 2 * cp;
#pragma unroll
        for (int j = 0; j < 32; ++j) {
            const float ya = (w0[0] * xa[j] + w0[1] * xa[j + 1]) + (w0[2] * xa[j + 2] + w0[3] * xa[j + 3]);
            const float yb = (w1[0] * xb[j] + w1[1] * xb[j + 1]) + (w1[2] * xb[j + 2] + w1[3] * xb[j + 3]);
            dst[j * DP_LD] = siluf(ya); dst[j * DP_LD + 1] = siluf(yb); if ((j & 7) == 7) asm volatile("" ::: "memory"); }
    } else if (tid >= 448) {
        const int i = lane;
        const bf16* pr = I.proj + (size_t)(t0 + i) * LDP + PC_BA;
        const float bb = bf2f(pr[h]), aa = bf2f(pr[6 + h]);
        const float beta = 1.0f / (1.0f + __expf(-bb));
        const float xx = aa + I.dtb[h];
        const float sp = xx > 20.f ? xx : log1pf(__expf(xx));
        float g = -__expf(I.alog[h]) * sp;
#pragma unroll
        for (int o = 1; o < 64; o <<= 1) { const float t = __shfl_up(g, o); if (lane >= o) g += t; }
        sb[i] = beta; sG[i] = g; seG[i] = __expf(g);
        if (i == 63) I.gc[chunk] = __expf(g);
    }
    __syncthreads();
    {
        const int row = tid >> 2, part = tid & 3, which = row >> 6, i = row & 63;
        const LAS float* p = L + which * 64 * DP_LD + i * DP_LD + 32 * part;
        float ss = 0.f;
#pragma unroll
        for (int k = 0; k < 8; ++k) { const f32x4 v = *(const LAS f32x4*)(p + 4 * k); ss += (v.x * v.x + v.y * v.y) + (v.z * v.z + v.w * v.w); }
        ss += __shfl_xor(ss, 1); ss += __shfl_xor(ss, 2);
        if (part == 0) { if (which == 0) srq[i] = 0.08838834764831845f / sqrtf(ss + EPS); else srk[i] = 1.0f / sqrtf(ss + EPS); }
    }
    __syncthreads();
    for (int e = tid; e < 2 * 64 * 64; e += 512) {
        const int which = e >> 12, i = (e >> 6) & 63, c2 = e & 63;
        LAS float* p = L + which * 64 * DP_LD + i * DP_LD + 2 * c2; const float sc = which ? srk[i] : srq[i];
        p[0] *= sc; p[1] *= sc; }
    __syncthreads();
    {
        const int it = wave & 3, c = lane & 15, q = lane >> 4; const bool isP = wave >= 4;
        const LAS float* X = isP ? QS : KS;
        bf16x8 bfr[4];
#pragma unroll
        for (int s = 0; s < 4; ++s) { const LAS float* p = X + (16 * it + c) * DP_LD + 32 * s + 8 * q; bfr[s] = pack8(*(const LAS f32x4*)p, *(const LAS f32x4*)(p + 4)); }
        f32x4 ct[4];
#pragma unroll
        for (int jt = 0; jt < 4; ++jt) { ct[jt] = (f32x4){0.f, 0.f, 0.f, 0.f};
            if (jt <= it) {
#pragma unroll
                for (int s = 0; s < 4; ++s) { const LAS float* p = KS + (16 * jt + c) * DP_LD + 32 * s + 8 * q; const bf16x8 af = pack8(*(const LAS f32x4*)p, *(const LAS f32x4*)(p + 4));
                    ct[jt] = __builtin_amdgcn_mfma_f32_16x16x32_bf16(af, bfr[s], ct[jt], 0, 0, 0); } } }
        const int i = 16 * it + c; const float Gi = sG[i], bi = sb[i];
        if (!isP) {
#pragma unroll
            for (int jt = 0; jt < 4; ++jt) if (jt <= it) { f32x4 o;
#pragma unroll
                for (int r = 0; r < 4; ++r) { const int j = 16 * jt + 4 * q + r; o[r] = (i > j) ? bi * ct[jt][r] * __expf(Gi - sG[j]) : 0.f; }
                const int j4 = 4 * jt + q, a = (i - 1) >> 2, bb = (i - 1) & 3;
                if (i >= 1 && j4 <= a) *(LAS f32x4*)(LM + 4 * ((a + 1) * (2 * a + bb) + j4)) = o; }
        } else {
#pragma unroll
            for (int s = 0; s < 2; ++s) { f32x4 lo, hi;
#pragma unroll
                for (int r = 0; r < 4; ++r) { const int j0 = 32 * s + 4 * q + r, j1 = j0 + 16;
                    lo[r] = (i >= j0) ? ct[2 * s][r] * __expf(Gi - sG[j0]) : 0.f; hi[r] = (i >= j1) ? ct[2 * s + 1][r] * __expf(Gi - sG[j1]) : 0.f; }
                *(GAS bf16x8*)(rec + CH_P + (size_t)((it * 2 + s) * 64 + lane) * 16) = pack8(lo, hi); }
        }
    }
    __syncthreads();
    {
        const int c = lane & 15, q = lane >> 4; const float G63 = sG[63];
#pragma unroll
        for (int f = 0; f < 2; ++f) { const int fi = wave * 2 + f, mt = fi >> 2, s = fi & 3;
            const int i = 16 * mt + c; const float e = seG[i]; const LAS float* p = QS + i * DP_LD + 32 * s + 4 * q;
            const f32x4 lo = *(const LAS f32x4*)p * e, hi = *(const LAS f32x4*)(p + 16) * e;
            *(GAS bf16x8*)(rec + CH_QG + (size_t)(fi * 64 + lane) * 16) = pack8(lo, hi); }
#pragma unroll
        for (int f = 0; f < 2; ++f) { const int fi = wave * 2 + f, mt = fi >> 1, s = fi & 1;
            const int dk = 16 * mt + c; f32x4 lo, hi;
#pragma unroll
            for (int r = 0; r < 4; ++r) { const int p0 = 32 * s + 4 * q + r, p1 = p0 + 16; lo[r] = KS[p0 * DP_LD + dk] * __expf(G63 - sG[p0]); hi[r] = KS[p1 * DP_LD + dk] * __expf(G63 - sG[p1]); }
            *(GAS bf16x8*)(rec + CH_KD + (size_t)(fi * 64 + lane) * 16) = pack8(lo, hi); }
    }
    {
        for (int t = tid; t < 528; t += 512) *(GAS f32x4*)(I.lg + (size_t)chunk * 8448 + (size_t)t * 16) = *(const LAS f32x4*)(LM + 4 * t);
#pragma unroll
        for (int e = 0; e < 4; ++e) { const int gi = tid + 512 * e, i = gi >> 5, c8 = (gi & 31) * 8;
            const bool isk = c8 >= 128; const LAS float* p = (isk ? KS : VS) + i * DP_LD + (c8 & 127);
            const float sc = sb[i] * (isk ? seG[i] : 1.0f);
            const f32x4 a = *(const LAS f32x4*)p * sc, bq = *(const LAS f32x4*)(p + 4) * sc;
            *(GAS bf16x8*)(I.rhs + ((size_t)chunk * 64 + i) * 512 + c8 * 2) = pack8(a, bq); }
        const int c = lane & 15, q = lane >> 4;
#pragma unroll
        for (int f = 0; f < 4; ++f) { const int fi = wave * 4 + f, sl = fi >> 2, mt = fi & 3;
            v2u zo; float zz[4];
#pragma unroll
            for (int r = 0; r < 4; ++r) zz[r] = siluf(bf2f(zraw[f][r]));
            zo.x = cvtpk(zz[0], zz[1]); zo.y = cvtpk(zz[2], zz[3]);
            *(GAS v2u*)(rec + CH_ZG + (size_t)(fi * 64 + lane) * 8) = zo; }
    }
    __syncthreads();
}

__device__ __forceinline__ void dn_solve_item(const unsigned char* lg, const unsigned char* rhs, const DnfMap& dnf, LAS float* Lw, int item, int lane) {
    const int chunk = item >> 2, g = item & 3;
    const unsigned char* lsrc = lg + (size_t)chunk * 8448;
#pragma unroll
    for (int k = 0; k < 9; ++k) { const int t = lane + 64 * k; const int tc = t < 528 ? t : 527; const f32x4 v = *(const GAS f32x4*)(lsrc + (size_t)tc * 16); if (t < 528) *(LAS f32x4*)(Lw + 4 * t) = v; }
    const bf16* rp = (const bf16*)(rhs + (size_t)chunk * 64 * 512) + 64 * g + lane;
    float X[64];
    unsigned short xr[64];
#pragma unroll
    for (int i = 0; i < 64; ++i) xr[i] = rp[i * 256];
    __builtin_amdgcn_sched_barrier(0);
#pragma unroll
    for (int i = 0; i < 64; ++i) X[i] = bf2f(xr[i]);
    asm volatile("s_waitcnt vmcnt(0) lgkmcnt(0)" ::: "memory");
    int vz; asm volatile("v_mov_b32 %0, 0" : "=v"(vz));
    const LAS float* LMv = Lw + vz;
    f32x4 ring[8];
#pragma unroll
    for (int t = 0; t < 8; ++t) ring[t] = *(const LAS f32x4*)(LMv + 4 * t);
    int t = 0;
#pragma unroll
    for (int i = 1; i < 64; ++i) {
        float acc = X[i];
#pragma unroll
        for (int j4 = 0; j4 < (i + 3) / 4; ++j4) { const f32x4 l = ring[t & 7];
            if (t + 8 < 528) ring[t & 7] = *(const LAS f32x4*)(LMv + 4 * (t + 8));
#pragma unroll
            for (int jj = 0; jj < 4; ++jj) { const int j = 4 * j4 + jj; if (j < i) acc -= l[jj] * X[j]; }
            ++t; }
        X[i] = acc; asm volatile("" ::: "memory"); }
    unsigned char* rec = dnf.rec(chunk);
    if (g < 2) {
        const int dv = 64 * g + lane, sl = dv >> 4, c = dv & 15;
        bf16* base = (bf16*)(rec + CH_U) + (size_t)(sl * 4) * 256 + c * 4;
#pragma unroll
        for (int i = 0; i < 64; ++i) base[(i >> 4) * 256 + ((i & 15) >> 2) * 64 + (i & 3)] = (bf16)(cvtpk(X[i], 0.f) & 0xffffu);
    } else {
        const int dk = 64 * (g - 2) + lane, s = dk >> 5, o = dk & 31, qq = (o & 15) >> 2, j = ((o >> 4) << 2) + (o & 3);
        bf16* base = (bf16*)(rec + CH_W) + (size_t)s * 512 + qq * 128 + j;
#pragma unroll
        for (int i = 0; i < 64; ++i) base[(i >> 4) * 2048 + (i & 15) * 8] = (bf16)(cvtpk(-X[i], 0.f) & 0xffffu);
    }
}

constexpr int SC_BUF = 57344, SC_RED = 2 * SC_BUF, SC_RS = SC_RED + 2048;
#define LDS_BAR() do { asm volatile("s_waitcnt lgkmcnt(0)" ::: "memory"); __builtin_amdgcn_s_barrier(); asm volatile("" ::: "memory"); } while (0)
template <int CTRL> __device__ __forceinline__ float dpp_t(float v) { return __builtin_bit_cast(float, __builtin_amdgcn_update_dpp(0, __builtin_bit_cast(int, v), CTRL, 0xf, 0xf, false)); }
#define dpp_f(v, ctrl) dpp_t<ctrl>(v)
__device__ __forceinline__ float row16_sum(float v) { v += dpp_t<0xB1>(v); v += dpp_t<0x4E>(v); v += dpp_t<0x141>(v); v += dpp_t<0x140>(v); return v; }
struct ScanIn { DnfMap dnf; const float* gc; const float* onw; bf16* odn; int popt; };
__device__ __forceinline__ void dn_scan(const ScanIn& I, LAS unsigned char* lds, int bh, int tid) {
    const int lane = tid & 63, sl = __builtin_amdgcn_readfirstlane(tid >> 6), c = lane & 15, q = lane >> 4;
    const int b = bh / 6, h = bh % 6;
    const unsigned char* rec0 = I.dnf.rec(bh * 32);
    LAS float* red = (LAS float*)(lds + SC_RED); LAS float* rsv = (LAS float*)(lds + SC_RS);
    const float onw = I.onw[16 * sl + c];
    const float gc_all = I.gc[bh * 32 + (lane & 31)];
    f32x4 S[8];
#pragma unroll
    for (int i = 0; i < 8; ++i) S[i] = (f32x4){0.f, 0.f, 0.f, 0.f};
    v2u Ucur[4], Zcur[4], Unxt[4], Znxt[4];
#pragma unroll
    for (int i = 0; i < 7; ++i) __builtin_amdgcn_global_load_lds((const unsigned*)(rec0 + (size_t)(sl * 7 + i) * 1024 + lane * 16), (LAS unsigned*)(lds + (sl * 7 + i) * 1024), 16, 0, 0);
#pragma unroll
    for (int mt = 0; mt < 4; ++mt) { Unxt[mt] = *(const GAS v2u*)(rec0 + CH_U + (size_t)((sl * 4 + mt) * 64 + lane) * 8); Znxt[mt] = *(const GAS v2u*)(rec0 + CH_ZG + (size_t)((sl * 4 + mt) * 64 + lane) * 8); }
    for (int n = 0; n < 32; ++n) {
        VM_WAIT(); __syncthreads();
#pragma unroll
        for (int mt = 0; mt < 4; ++mt) { Ucur[mt] = Unxt[mt]; Zcur[mt] = Znxt[mt]; }
        const float gcv = __builtin_bit_cast(float, __builtin_amdgcn_readlane(__builtin_bit_cast(int, gc_all), n));
        if (n + 1 < 32) {
            const unsigned char* rec = rec0 + (size_t)((I.popt & 128) ? 0 : (n + 1)) * CH_BYTES;   LAS unsigned char* dstb = lds + ((n + 1) & 1) * SC_BUF;
#pragma unroll
            for (int i = 0; i < 7; ++i) __builtin_amdgcn_global_load_lds((const unsigned*)(rec + (size_t)(sl * 7 + i) * 1024 + lane * 16), (LAS unsigned*)(dstb + (sl * 7 + i) * 1024), 16, 0, 0);
#pragma unroll
            for (int mt = 0; mt < 4; ++mt) { Unxt[mt] = *(const GAS v2u*)(rec + CH_U + (size_t)((sl * 4 + mt) * 64 + lane) * 8); Znxt[mt] = *(const GAS v2u*)(rec + CH_ZG + (size_t)((sl * 4 + mt) * 64 + lane) * 8); }
        }
        const LAS unsigned char* fb = lds + (n & 1) * SC_BUF + lane * 16;
        bf16x8 Sb[4];
#pragma unroll
        for (int s = 0; s < 4; ++s) Sb[s] = pack8(S[2 * s], S[2 * s + 1]);
        f32x4 d[4], o[4];
#pragma unroll
        for (int mt = 0; mt < 4; ++mt) { d[mt] = (f32x4){bflo(Ucur[mt].x), bfhi(Ucur[mt].x), bflo(Ucur[mt].y), bfhi(Ucur[mt].y)}; o[mt] = (f32x4){0.f, 0.f, 0.f, 0.f}; }
#pragma unroll
        for (int mt = 0; mt < 4; ++mt)
#pragma unroll
            for (int s = 0; s < 4; ++s) {
                d[mt] = __builtin_amdgcn_mfma_f32_16x16x32_bf16(*(const LAS bf16x8*)(fb + CH_W + (mt * 4 + s) * 1024), Sb[s], d[mt], 0, 0, 0);
                o[mt] = __builtin_amdgcn_mfma_f32_16x16x32_bf16(*(const LAS bf16x8*)(fb + CH_QG + (mt * 4 + s) * 1024), Sb[s], o[mt], 0, 0, 0); }
        bf16x8 Db[2];
#pragma unroll
        for (int s = 0; s < 2; ++s) Db[s] = pack8(d[2 * s], d[2 * s + 1]);
#pragma unroll
        for (int mt = 0; mt < 4; ++mt)
#pragma unroll
            for (int s = 0; s < 2; ++s) o[mt] = __builtin_amdgcn_mfma_f32_16x16x32_bf16(*(const LAS bf16x8*)(fb + CH_P + (mt * 2 + s) * 1024), Db[s], o[mt], 0, 0, 0);
#pragma unroll
        for (int mt = 0; mt < 8; ++mt) { S[mt] = S[mt] * gcv;
#pragma unroll
            for (int s = 0; s < 2; ++s) S[mt] = __builtin_amdgcn_mfma_f32_16x16x32_bf16(*(const LAS bf16x8*)(fb + CH_KD + (mt * 2 + s) * 1024), Db[s], S[mt], 0, 0, 0); }
#pragma unroll
        for (int mt = 0; mt < 4; ++mt) { f32x4 ss = o[mt] * o[mt];
#pragma unroll
            for (int r = 0; r < 4; ++r) ss[r] = row16_sum(ss[r]);
            if (c == 0) *(LAS f32x4*)(red + sl * 64 + 16 * mt + 4 * q) = ss; }
        if (!(I.popt & 64)) {
        LDS_BAR();
        { const int pos = 8 * sl + (lane >> 3); float v = red[(lane & 7) * 64 + pos]; v += dpp_f(v, 0xB1); v += dpp_f(v, 0x4E); v += dpp_f(v, 0x141);
          if ((lane & 7) == 0) rsv[pos] = 1.0f / sqrtf(v * (1.0f / 128.0f) + EPS); }
        LDS_BAR(); }
        bf16* orow = I.odn + (size_t)(b * SEQ + 64 * n) * 768 + h * 128 + 16 * sl + c;
#pragma unroll
        for (int mt = 0; mt < 4; ++mt) { const f32x4 r4 = *(const LAS f32x4*)(rsv + 16 * mt + 4 * q);
            const f32x4 z4 = (f32x4){bflo(Zcur[mt].x), bfhi(Zcur[mt].x), bflo(Zcur[mt].y), bfhi(Zcur[mt].y)};
#pragma unroll
            for (int r = 0; r < 4; ++r) { const float v = o[mt][r] * r4[r] * onw * z4[r]; if (!(I.popt & 32)) orow[(size_t)(16 * mt + 4 * q + r) * 768] = (bf16)(cvtpk(v, 0.f) & 0xffffu); else asm volatile("" :: "v"(v)); } }
    }
    VM_WAIT(); __syncthreads();
}

__constant__ unsigned char T5_BUCKET[128] = {0,1,2,3,4,5,6,7,8,9,10,11,12,13,14,15,16,16,16,17,17,18,18,18,19,19,19,20,20,20,20,21,21,21,21,22,22,22,22,22,23,23,23,23,23,23,24,24,24,24,24,24,25,25,25,25,25,25,25,26,26,26,26,26,26,26,26,27,27,27,27,27,27,27,27,27,27,28,28,28,28,28,28,28,28,28,28,29,29,29,29,29,29,29,29,29,29,29,29,30,30,30,30,30,30,30,30,30,30,30,30,30,30,31,31,31,31,31,31,31,31,31,31,31,31,31,31,31};
struct AttnIn { const unsigned char *qf, *kf, *vt, *mqf, *mkf, *mvt; bf16 *oswa, *omem; const float* sinks; };
__device__ __forceinline__ float ex2(float v) { return __builtin_amdgcn_exp2f(v); }

__device__ __forceinline__ void ld8(const unsigned char* p, bf16x8 (&f)[8]) {
#pragma unroll
    for (int s = 0; s < 8; ++s) f[s] = *(const GAS bf16x8*)(p + s * 1024);
}
__device__ __forceinline__ bf16x8 pfrag(const f32x16& S, int s) { return pack8((f32x4){S[8 * s], S[8 * s + 1], S[8 * s + 2], S[8 * s + 3]}, (f32x4){S[8 * s + 4], S[8 * s + 5], S[8 * s + 6], S[8 * s + 7]}); }

__device__ __forceinline__ void swa_item(const AttnIn& I, const LAS float* biasT, int item, int lane) {
    const int qt = item & 63, hq = (item >> 6) % 6, b = item / 384, kvh = hq / 3;
    const int r32 = lane & 31, hh = lane >> 5;
    const unsigned char* kbase = I.kf + ((size_t)((b * 2 + kvh) * 64) * 8) * 1024 + lane * 16;
    const unsigned char* vbase = I.vt + ((size_t)((b * 2 + kvh) * 64) * 8) * 1024 + lane * 16;
#define KT(i) ((qt - 4 + (i)) < 0 ? 0 : (qt - 4 + (i)))
    bf16x8 qfr[8], ka[8], kb[8];
    ld8(I.qf + ((size_t)((b * 6 + hq) * 64 + qt) * 8) * 1024 + lane * 16, qfr);
    ld8(kbase + (size_t)KT(0) * 8192, ka);
    f32x16 S[5];
#pragma unroll
    for (int i = 0; i < 5; ++i) {
#pragma unroll
        for (int r = 0; r < 16; ++r) S[i][r] = 0.f;
        if (i & 1) { if (i + 1 < 5) ld8(kbase + (size_t)KT(i + 1) * 8192, ka); else ld8(vbase + (size_t)KT(0) * 8192, ka);
#pragma unroll
            for (int s = 0; s < 8; ++s) S[i] = __builtin_amdgcn_mfma_f32_32x32x16_bf16(kb[s], qfr[s], S[i], 0, 0, 0);
        } else { if (i + 1 < 5) ld8(kbase + (size_t)KT(i + 1) * 8192, kb); else ld8(vbase + (size_t)KT(0) * 8192, kb);
#pragma unroll
            for (int s = 0; s < 8; ++s) S[i] = __builtin_amdgcn_mfma_f32_32x32x16_bf16(ka[s], qfr[s], S[i], 0, 0, 0);
        }
    }
    const float sink2 = I.sinks[hq] * LOG2E; const LAS float* bt = biasT + hq * 128;
    float m = sink2;
#pragma unroll
    for (int i = 0; i < 5; ++i) {
#pragma unroll
        for (int r = 0; r < 16; ++r) { const int koff = (r & 3) + 8 * (r >> 2) + 4 * hh; const int dist = 32 * (4 - i) + r32 - koff;
            const bool valid = (qt - 4 + i >= 0) && (dist >= 0) && (dist < 128);
            const float v = valid ? S[i][r] + bt[dist & 127] : -INFINITY; S[i][r] = v; m = fmaxf(m, v); } }
    m = fmaxf(m, __shfl_xor(m, 32));
    float l = 0.f;
#pragma unroll
    for (int i = 0; i < 5; ++i)
#pragma unroll
        for (int r = 0; r < 16; ++r) { const float p = ex2(S[i][r] - m); S[i][r] = p; l += p; }
    l += __shfl_xor(l, 32); l += ex2(sink2 - m);
    f32x16 O[4];
#pragma unroll
    for (int dt = 0; dt < 4; ++dt)
#pragma unroll
        for (int r = 0; r < 16; ++r) O[dt][r] = 0.f;
#pragma unroll
    for (int i = 0; i < 5; ++i) {
        if (i + 1 < 5) { if (i & 1) ld8(vbase + (size_t)KT(i + 1) * 8192, kb); else ld8(vbase + (size_t)KT(i + 1) * 8192, ka); }
#pragma unroll
        for (int s = 0; s < 2; ++s) { const bf16x8 pf = pfrag(S[i], s);
#pragma unroll
            for (int dt = 0; dt < 4; ++dt) O[dt] = __builtin_amdgcn_mfma_f32_32x32x16_bf16((i & 1) ? ka[s * 4 + dt] : kb[s * 4 + dt], pf, O[dt], 0, 0, 0); }
    }
#undef KT
    const float inv = 1.0f / l;
    bf16* orow = I.oswa + (size_t)(b * SEQ + 32 * qt + r32) * 768 + hq * 128 + 4 * hh;
#pragma unroll
    for (int dt = 0; dt < 4; ++dt)
#pragma unroll
        for (int g = 0; g < 4; ++g) { v2u w; w.x = cvtpk(O[dt][4 * g] * inv, O[dt][4 * g + 1] * inv); w.y = cvtpk(O[dt][4 * g + 2] * inv, O[dt][4 * g + 3] * inv);
            *(GAS v2u*)(orow + 32 * dt + 8 * g) = w; }
}

__device__ __forceinline__ void mem_item(const AttnIn& I, int item, int lane) {
    const int qt = item & 63, h = (item >> 6) & 3, b = item >> 8;
    const int r32 = lane & 31, hh = lane >> 5;
    const unsigned char* kbase = I.mkf + ((size_t)((b * 4 + h) * 8) * 8) * 1024 + lane * 16;
    const unsigned char* vbase = I.mvt + ((size_t)((b * 4 + h) * 8) * 8) * 1024 + lane * 16;
    bf16x8 qfr[8], ka[8], kb[8];
    ld8(I.mqf + ((size_t)((b * 4 + h) * 64 + qt) * 8) * 1024 + lane * 16, qfr);
    ld8(kbase, ka);
    f32x16 O[4];
#pragma unroll
    for (int dt = 0; dt < 4; ++dt)
#pragma unroll
        for (int r = 0; r < 16; ++r) O[dt][r] = 0.f;
    float m = -INFINITY, l = 0.f;
#pragma unroll 1
    for (int half = 0; half < 2; ++half) {
        f32x16 S[4];
#pragma unroll
        for (int i = 0; i < 4; ++i) { const int kt = half * 4 + i;
#pragma unroll
            for (int r = 0; r < 16; ++r) S[i][r] = 0.f;
            const unsigned char* nxt = (i < 3) ? kbase + (size_t)(kt + 1) * 8192 : vbase + (size_t)(half * 4) * 8192;
            if (i & 1) { ld8(nxt, ka);
#pragma unroll
                for (int s = 0; s < 8; ++s) S[i] = __builtin_amdgcn_mfma_f32_32x32x16_bf16(kb[s], qfr[s], S[i], 0, 0, 0);
            } else { ld8(nxt, kb);
#pragma unroll
                for (int s = 0; s < 8; ++s) S[i] = __builtin_amdgcn_mfma_f32_32x32x16_bf16(ka[s], qfr[s], S[i], 0, 0, 0);
            } }
        float mh = m;
#pragma unroll
        for (int i = 0; i < 4; ++i)
#pragma unroll
            for (int r = 0; r < 16; ++r) mh = fmaxf(mh, S[i][r]);
        mh = fmaxf(mh, __shfl_xor(mh, 32));
        const float alpha = ex2(m - mh); m = mh;
        float ls = 0.f;
#pragma unroll
        for (int i = 0; i < 4; ++i)
#pragma unroll
            for (int r = 0; r < 16; ++r) { const float p = ex2(S[i][r] - m); S[i][r] = p; ls += p; }
        ls += __shfl_xor(ls, 32); l = l * alpha + ls;
#pragma unroll
        for (int dt = 0; dt < 4; ++dt) O[dt] = O[dt] * alpha;
#pragma unroll
        for (int i = 0; i < 4; ++i) { const int kt = half * 4 + i;
            const unsigned char* nxt = (i < 3) ? vbase + (size_t)(kt + 1) * 8192 : kbase + (size_t)(half == 0 ? 4 : 0) * 8192;
            if (i & 1) { ld8(nxt, ka); } else { ld8(nxt, kb); }
#pragma unroll
            for (int s = 0; s < 2; ++s) { const bf16x8 pf = pfrag(S[i], s);
#pragma unroll
                for (int dt = 0; dt < 4; ++dt) O[dt] = __builtin_amdgcn_mfma_f32_32x32x16_bf16((i & 1) ? kb[s * 4 + dt] : ka[s * 4 + dt], pf, O[dt], 0, 0, 0); } }
    }
    const float inv = 1.0f / l;
    bf16* orow = I.omem + (size_t)(b * SEQ + 32 * qt + r32) * 768 + h * 128 + 4 * hh;
#pragma unroll
    for (int dt = 0; dt < 4; ++dt)
#pragma unroll
        for (int g = 0; g < 4; ++g) { v2u w; w.x = cvtpk(O[dt][4 * g] * inv, O[dt][4 * g + 1] * inv); w.y = cvtpk(O[dt][4 * g + 2] * inv, O[dt][4 * g + 3] * inv);
            *(GAS v2u*)(orow + 32 * dt + 8 * g) = w; }
}

#ifndef PH_MASK
#define PH_MASK 0x1ff
#endif
#ifndef WGM_UP
#define WGM_UP 4
#endif
#ifndef WGM_DN
#define WGM_DN 4
#endif
#ifndef SP2_UP
#define SP2_UP true
#endif
#ifndef DUP_PHASE
#define DUP_PHASE -1
#endif
struct Args { const float* in[23]; float* out; unsigned char* ws; int ph_lo, ph_hi, opt, pad; };
__global__ void __launch_bounds__(NWAVES * 64, 2) hyb_fwd(Args args) {
    extern __shared__ __attribute__((aligned(16))) unsigned char lds_raw[];
    LAS unsigned char* lds = (LAS unsigned char*)lds_raw;
    volatile LAS unsigned* MISC = (volatile LAS unsigned*)(lds + MISC_OFF);
    const int tid = threadIdx.x, lane = tid & 63, wave = __builtin_amdgcn_readfirstlane(tid >> 6);
    const int G = gridDim.x, bx = blockIdx.x;
    unsigned char* ws = args.ws;
    const float* x = args.in[0]; const float* mem = args.in[1]; const float* attn_norm_w = args.in[2]; const float* w_in = args.in[3];
    const float* dn_conv_w = args.in[4]; const float* dn_A_log = args.in[5]; const float* dn_dt_bias = args.in[6]; const float* dn_out_norm_w = args.in[7];
    const float* swa_q_norm_w = args.in[8]; const float* swa_k_norm_w = args.in[9]; const float* swa_sinks = args.in[10]; const float* rel_bias = args.in[11];
    const float* mem_norm_w = args.in[12]; const float* w_mem_kv = args.in[13]; const float* xq_norm_w = args.in[14]; const float* xk_norm_w = args.in[15];
    const float* p_dn = args.in[16]; const float* p_swa = args.in[17]; const float* p_mem = args.in[18]; const float* w_out = args.in[19];
    const float* mlp_norm_w = args.in[20]; const float* w_up = args.in[21]; const float* w_down = args.in[22];
    float* out = args.out;
    bf16* WoutT = (bf16*)(ws + WS_WOUT); bf16* PdnT = (bf16*)(ws + WS_PDN); bf16* PswaT = (bf16*)(ws + WS_PSWA); bf16* PmemT = (bf16*)(ws + WS_PMEM);
    bf16* WinT = (bf16*)((unsigned char*)out + DO_WIN); bf16* WmkvT = (bf16*)((unsigned char*)out + DO_WMKV); bf16* memn = (bf16*)((unsigned char*)out + DO_MEMN);
    const DnfMap dnfm{(unsigned char*)out, ws + WS_DNF2};
    bf16* WupT = (bf16*)(ws + WS_WUP); bf16* WdnT = (bf16*)(ws + WS_WDN);
    bf16* xn = (bf16*)(ws + WS_XN); bf16* proj = (bf16*)(ws + WS_PROJ); bf16* gates = (bf16*)(ws + WS_GATES);
    bf16* odn = (bf16*)(ws + WS_ODN); bf16* oswa = (bf16*)(ws + WS_OSWA); bf16* omem = (bf16*)(ws + WS_OMEM); bf16* merged = (bf16*)(ws + WS_MERGED);
    bf16* memk = (bf16*)(ws + WS_MEMK); bf16* Hb = (bf16*)(ws + WS_H);
    float* ssq = (float*)(ws + WS_SSQ); float* gcarr = (float*)(ws + WS_GC);

    for (int u = tid; u < (LDS_BYTES - LDSCTL_OFF) / 4; u += NWAVES * 64) ((LAS unsigned*)(lds + LDSCTL_OFF))[u] = 0u;
    __syncthreads();
    XcdBarrier bar = xcd_barrier_post((unsigned*)(ws + WS_CTL) + CW_BAR, MISC + 8);
    const int lo = args.ph_lo, hi = args.ph_hi;
#define IN(k) (lo <= (k) && (k) < hi && ((PH_MASK >> (k)) & 1))
#ifdef DOUBLE_SEAM
#define SEAM(k) do { if ((k) + 1 < hi) { xcd_barrier(bar); xcd_barrier(bar); } } while (0)
#else
#define SEAM(k) do { if ((k) + 1 < hi) xcd_barrier(bar); } while (0)
#endif
    const int gw = bx * NWAVES + wave, NGW = G * NWAVES;

    if (lo <= 0 && 0 < hi) {
        for (int rep = 0; rep < ((DUP_PHASE == 0) ? 2 : 1); ++rep) if (IN(0)) { if (rep) xcd_barrier(bar);
        transpose_matrix<1>(w_in, DM, NIN, nullptr, WinT, DM, NWIN, gw, NGW, lane);
        transpose_matrix<2>(w_in, DM, NIN, nullptr, (bf16*)(ws + WS_WTAIL), DM, 1280, gw, NGW, lane);
        transpose_matrix<0>(w_mem_kv, DM, 1024, nullptr, WmkvT, DM, 1024, gw, NGW, lane);
        for (int m = gw; m < MT + MMEM; m += 2 * NGW) {
            f32x4 va[8], vb[8]; const int m2 = m + NGW; const bool two = m2 < MT + MMEM;
            rms_load(m < MT ? x + (size_t)m * DM : mem + (size_t)(m - MT) * DM, lane, va);
            if (two) rms_load(m2 < MT ? x + (size_t)m2 * DM : mem + (size_t)(m2 - MT) * DM, lane, vb);
            if (m < MT) rms_finish(attn_norm_w, xn + (size_t)m * DM, lane, va); else rms_finish(mem_norm_w, memn + (size_t)(m - MT) * DM, lane, va);
            if (two) { if (m2 < MT) rms_finish(attn_norm_w, xn + (size_t)m2 * DM, lane, vb); else rms_finish(mem_norm_w, memn + (size_t)(m2 - MT) * DM, lane, vb); }
        }
        }
        SEAM(0);
    }
    if (lo <= 1 && 1 < hi) {
        for (int rep = 0; rep < ((DUP_PHASE == 1) ? 2 : 1); ++rep) if (IN(1)) { if (rep) xcd_barrier(bar);
        { pg8::Gemm g{xn, WinT, MT, NMAIN, DM}; pg8::StaticOrder S; S.init(MT, NMAIN, G, bx); S.cap = P1_CAP; S.wgm = 4;
          pg8::EpiProj E{proj, gates, LDP, LDG};
          pg8::gemm_phase<pg8::EpiProj, pg8::StaticOrder, true, true>(lds + RING_OFF, g, S, E); }
        { pg8::Gemm g{WinT + (size_t)NMAIN * DM, xn, 256, MT, DM}; pg8::StaticOrder S; S.init(256, MT, G, (bx - 208 + G) % G);
          pg8::EpiVt<2, SEQ> E{ws + WS_VT};
          pg8::gemm_phase<pg8::EpiVt<2, SEQ>, pg8::StaticOrder, true, true>(lds + RING_OFF, g, S, E); }
        { pg8::Gemm g{memn, WmkvT, MMEM, 512, DM}; pg8::StaticOrder S; S.init(MMEM, 512, G, (bx - 240 + G) % G);
          pg8::EpiPlain E{memk, 512};
          pg8::gemm_phase<pg8::EpiPlain, pg8::StaticOrder, true, true>(lds + RING_OFF, g, S, E); }
        { pg8::Gemm g{WmkvT + (size_t)512 * DM, memn, 512, MMEM, DM}; pg8::StaticOrder S; S.init(512, MMEM, G, (bx - 248 + G) % G);
          pg8::EpiVt<4, MEML> E{ws + WS_MVT};
          pg8::gemm_phase<pg8::EpiVt<4, MEML>, pg8::StaticOrder, true, true>(lds + RING_OFF, g, S, E); }
        }
        SEAM(1);
    }
    if (lo <= 2 && 2 < hi) {
        for (int rep = 0; rep < ((DUP_PHASE == 2) ? 2 : 1); ++rep) if (IN(2)) { if (rep) xcd_barrier(bar);
        DnIn DI{proj, dn_conv_w, dn_A_log, dn_dt_bias, dnfm, gcarr, ws + WS_LG, ws + WS_RHS};
        { unsigned uraw[35];
          if (bx < NCHUNK) dn_conv_issue(DI, bx, tid, uraw);
          for (int chunk = bx; chunk < NCHUNK; chunk += G) dn_prep_chunk(DI, (LAS float*)(lds + RING_OFF), chunk, chunk + G, tid, uraw); }
        asm volatile("s_waitcnt vmcnt(0)" ::: "memory"); __syncthreads();
        { const int nmine = (NCHUNK - 1 - bx) / G + 1;
          for (int si = wave; si < 4 * nmine; si += NWAVES) dn_solve_item(ws + WS_LG, ws + WS_RHS, dnfm, (LAS float*)(lds + RING_OFF + wave * 8448), (bx + (si >> 2) * G) * 4 + (si & 3), lane); }
        { const int lw = (NWAVES - 1 - wave) * G + bx, nlight = NGW;
          for (int it = lw; it < 3200; it += nlight) {
            if (it < 1536) { const int grp = it >> 6, tile = it & 63, b = grp / 6, hq = grp % 6;
                normfrag_item(proj, LDP, b * SEQ + 32 * tile, PC_SQ + hq * 128, swa_q_norm_w, QSCALE, ws + WS_QF + (size_t)it * 8192, lane); }
            else if (it < 2048) { const int i2 = it - 1536, grp = i2 >> 6, tile = i2 & 63, b = grp >> 1, kvh = grp & 1;
                normfrag_item(proj, LDP, b * SEQ + 32 * tile, PC_SK + kvh * 128, swa_k_norm_w, 1.0f, ws + WS_KF + (size_t)i2 * 8192, lane); }
            else if (it < 3072) { const int i3 = it - 2048, grp = i3 >> 6, tile = i3 & 63, b = grp >> 2, h = grp & 3;
                normfrag_item(proj, LDP, b * SEQ + 32 * tile, PC_MQ + h * 128, xq_norm_w, QSCALE, ws + WS_MQF + (size_t)i3 * 8192, lane); }
            else { const int i4 = it - 3072, grp = i4 >> 3, tile = i4 & 7, b = grp >> 2, h = grp & 3;
                normfrag_item(memk, 512, b * MEML + 32 * tile, h * 128, xk_norm_w, 1.0f, ws + WS_MKF + (size_t)i4 * 8192, lane); }
          }
        }
        }
        SEAM(2);
    }
    if (lo <= 4 && 4 < hi) {
        for (int rep = 0; rep < ((DUP_PHASE == 4) ? 2 : 1); ++rep) if (IN(4)) { if (rep) xcd_barrier(bar);
        if (bx < 24) {
#ifndef NO_SCAN
            if (!(args.opt & 1)) { int tid_s = tid; asm volatile("" : "+v"(tid_s)); ScanIn SI{dnfm, gcarr, dn_out_norm_w, odn, args.opt}; dn_scan(SI, lds + RING_OFF, bx, tid_s); }
#endif
        }
        else if (!(args.opt & 2)) {
            LAS float* biasT = (LAS float*)(lds + RING_OFF);
            for (int e = tid; e < 768; e += NWAVES * 64) { const int hq = e >> 7, dist = e & 127; biasT[e] = rel_bias[T5_BUCKET[dist] * 6 + hq] * LOG2E; }
            __syncthreads();
            int lane_a = lane; asm volatile("" : "+v"(lane_a));
            AttnIn AI{ws + WS_QF, ws + WS_KF, ws + WS_VT, ws + WS_MQF, ws + WS_MKF, ws + WS_MVT, oswa, omem, swa_sinks};
            const int aw = (bx - 24) * NWAVES + wave, NAW = (G - 24) * NWAVES;
#ifndef NO_MEM
            for (int it = aw; it < 1024; it += NAW) mem_item(AI, it, lane_a);
#endif
#ifndef NO_SWA
            for (int it = (aw + NAW - (1024 % NAW)) % NAW; it < 1536; it += NAW) swa_item(AI, biasT, it, lane_a);
#endif
            const int ab = bx - 24, nab = G - 24, ntail = NTAIL < nab ? NTAIL : nab;
            __syncthreads();
            if (!(args.opt & 16)) { pg8::StaticOrder S; S.init(MT, NMAIN, 1 << 20, P1_CAP + ab); S.wgm = 4;
              if (ntail < NTAIL) S.cap = 0;
              const bf16* wt = (const bf16*)(ws + WS_WTAIL) - (size_t)38 * 256 * DM;
              pg8::Gemm g{xn, wt, MT, NMAIN, DM};
              pg8::EpiProj E{proj, gates, LDP, LDG};
              pg8::gemm_phase<pg8::EpiProj, pg8::StaticOrder, false, true>(lds + RING_OFF, g, S, E); }
            if (!(args.opt & 8)) {
            int lane2 = lane; asm volatile("" : "+v"(lane2));
            const int share = ab < ntail ? 1 : 3, Wt = NWAVES * (ntail + 3 * (nab - ntail));
            const int vb = ab < ntail ? (ab * NWAVES + wave) : (ntail * NWAVES + ((ab - ntail) * NWAVES + wave) * 3);
            for (int k = 0; k < share; ++k) {
                transpose_matrix<0>(w_up, DM, DFF, mlp_norm_w, WupT, DM, DFF, vb + k, Wt, lane2);
                transpose_matrix<0>(w_down, DFF, DM, nullptr, WdnT, DFF, DM, vb + k, Wt, lane2);
                transpose_matrix<0>(p_dn, 768, DM, nullptr, PdnT, 768, DM, vb + k, Wt, lane2);
                transpose_matrix<0>(p_swa, 768, DM, nullptr, PswaT, 768, DM, vb + k, Wt, lane2);
                transpose_matrix<0>(p_mem, 512, DM, nullptr, PmemT, 768, DM, vb + k, Wt, lane2);
                transpose_matrix<0>(w_out, DM, DM, nullptr, WoutT, DM, DM, vb + k, Wt, lane2); } }
        }
        }
        SEAM(4);
    }
    if (lo <= 5 && 5 < hi) {
        for (int rep = 0; rep < ((DUP_PHASE == 5) ? 2 : 1); ++rep) if (IN(5)) { if (rep) xcd_barrier(bar);
        if (!(args.opt & 16))
        { pg8::Gemm g{odn, PdnT, 3 * MT, 3 * DM, 768}; pg8::MergeOrder S; S.init(MT, DM, G, bx); S.so.wgm = 4;
          pg8::EpiMergeAll E{gates, merged, LDG, DM};
          pg8::gemm_phase<pg8::EpiMergeAll, pg8::MergeOrder, true, true>(lds + RING_OFF, g, S, E); }
        }
        SEAM(5);
    }
    if (lo <= 6 && 6 < hi) {
        for (int rep = 0; rep < ((DUP_PHASE == 6) ? 2 : 1); ++rep) if (IN(6)) { if (rep) xcd_barrier(bar);
        pg8::Gemm g{merged, WoutT, MT, DM, DM}; pg8::StaticOrder S; S.init(MT, DM, G, bx); S.wgm = 4;
        pg8::EpiOut E{x, (args.opt & 4) ? (float*)(ws + 225 * MiB) : out, xn, ssq, DM, rep ? 0.f : 1.f};
        pg8::gemm_phase<pg8::EpiOut, pg8::StaticOrder, false, true>(lds + RING_OFF, g, S, E);
        }
        SEAM(6);
    }
    if (lo <= 7 && 7 < hi) {
        for (int rep = 0; rep < ((DUP_PHASE == 7) ? 2 : 1); ++rep) if (IN(7)) { if (rep) xcd_barrier(bar);
        pg8::Gemm g{xn, WupT, MT, DFF, DM}; pg8::StaticOrder S; S.init(MT, DFF, G, bx); S.wgm = WGM_UP;
        pg8::EpiUp E{ssq, Hb, DFF, 1.0f / DM, EPS};
        pg8::gemm_phase<pg8::EpiUp, pg8::StaticOrder, true, SP2_UP>(lds + RING_OFF, g, S, E);
        }
        SEAM(7);
    }
    if (lo <= 8 && 8 < hi) {
        for (int rep = 0; rep < ((DUP_PHASE == 8) ? 2 : 1); ++rep) if (IN(8)) { if (rep) xcd_barrier(bar);
        pg8::Gemm g{Hb, WdnT, MT, DM, DFF}; pg8::StaticOrder S; S.init(MT, DM, G, bx); S.wgm = WGM_DN;
        pg8::EpiDown E{xn, out, DM, (rep || (args.opt & 4)) ? 0.f : 1.f};
        pg8::gemm_phase<pg8::EpiDown, pg8::StaticOrder, false, true>(lds + RING_OFF, g, S, E);
        }
    }
#undef IN
#undef SEAM
}

#ifndef N_LAUNCHES
#define N_LAUNCHES 1
#endif
extern "C" void kernel_launch(void* const* d_in, const int* in_sizes, int n_in, void* d_out, int out_size, void* d_ws, size_t ws_size, hipStream_t stream) {
    static int grid = 0;
    if (grid == 0) {
        if (n_in != 23 || out_size != MT * DM || ws_size < WS_END) { fprintf(stderr, "kernel_launch: unexpected shapes (n_in %d, out %d, ws %zu)\n", n_in, out_size, ws_size); grid = -1; return; }
        int dev = 0, cus = 0, per_cu = 0;
        if (hipGetDevice(&dev) != hipSuccess || hipDeviceGetAttribute(&cus, hipDeviceAttributeMultiprocessorCount, dev) != hipSuccess) { grid = -1; return; }
        if (hipFuncSetAttribute((const void*)hyb_fwd, hipFuncAttributeMaxDynamicSharedMemorySize, LDS_BYTES) != hipSuccess) { fprintf(stderr, "kernel_launch: hipFuncSetAttribute failed\n"); grid = -1; return; }
        if (hipOccupancyMaxActiveBlocksPerMultiprocessor(&per_cu, (const void*)hyb_fwd, NWAVES * 64, LDS_BYTES) != hipSuccess || per_cu < 1) { fprintf(stderr, "kernel_launch: occupancy query says %d\n", per_cu); per_cu = 1; }
        (void)hipGetLastError();
        grid = cus;
        if (grid > 256) grid = 256;
    }
    if (grid < 0) return;
    (void)hipMemsetAsync((char*)d_ws + WS_CTL, 0, CTL_ZERO_BYTES, stream);
    Args a{};
    for (int i = 0; i < 23; ++i) a.in[i] = (const float*)d_in[i];
    a.out = (float*)d_out; a.ws = (unsigned char*)d_ws;
#if N_LAUNCHES == 1
    a.ph_lo = 0; a.ph_hi = 9;
    hipLaunchKernelGGL(hyb_fwd, dim3(grid), dim3(NWAVES * 64), LDS_BYTES, stream, a);
#else
    for (int p = 0; p < 9; ++p) { a.ph_lo = p; a.ph_hi = p + 1; hipLaunchKernelGGL(hyb_fwd, dim3(grid), dim3(NWAVES * 64), LDS_BYTES, stream, a); }
#endif
#ifdef RERUN_PHASE
    a.ph_lo = RERUN_PHASE; a.ph_hi = RERUN_PHASE + 1; a.opt = RERUN_OPT;
    hipLaunchKernelGGL(hyb_fwd, dim3(grid), dim3(NWAVES * 64), LDS_BYTES, stream, a);
#endif
}
```

```cpp
#include <hip/hip_runtime.h>
#include <cstdio>
#include <cstdint>
namespace pg8 {
#define PG8_LAS __attribute__((address_space(3)))
typedef unsigned short bf16_t;
typedef short bf16x8 __attribute__((ext_vector_type(8)));
typedef float f32x4 __attribute__((ext_vector_type(4)));
typedef unsigned u32x4 __attribute__((ext_vector_type(4)));
constexpr int BM = 256, BK = 64, HALF = 128, HTB = HALF * BK * 2  , STAGE_BYTES = 8 * HTB, NXCD = 8, WGM = 8;

__host__ __device__ __forceinline__ int lds_byte(int r, int c) { const int st = (r >> 4) * 2 + (c >> 5), rr = r & 15, cc = c & 31, ob = rr * 64 + cc * 2; return st * 1024 + (ob ^ (((ob >> 9) & 1) << 5)); }
__host__ __device__ __forceinline__ void stage_rc(int b, int& R, int& C) { const int st = b / 1024, sb = b % 1024, swz = sb ^ (((sb >> 9) & 1) << 5); R = (st >> 1) * 16 + swz / 64; C = (st & 1) * 32 + (swz % 64) / 2; }
__host__ __device__ __forceinline__ int perm32(int rho) { const int n = rho >> 4, i = rho & 15; return 8 * (i >> 2) + 4 * n + (i & 3); }

struct Unit { int pm, pn; };
struct Gemm { const bf16_t* A; const bf16_t* Bt; int M, N, K; };

struct StaticOrder {
    static constexpr bool VAR_NT = false;
    int nM, nN, nwg, G, c, cap, wgm;
    __host__ __device__ void init(int M, int N, int G_, int c_) { nM = M / BM; nN = N / BM; nwg = nM * nN; G = G_; c = c_; cap = nwg; wgm = WGM; }
    __host__ __device__ bool next(int i, Unit& u) const {
        const long L = (long)i * G + c; if (L >= cap) return false;
        int wgid = (int)L; { const int q = nwg / NXCD, r = nwg % NXCD, xcd = wgid % NXCD, off = wgid / NXCD; wgid = (xcd < r ? xcd * (q + 1) : r * (q + 1) + (xcd - r) * q) + off; }
        const int nig = wgm * nN, gid = wgid / nig, fm = gid * wgm, gsz = (nM - fm) < wgm ? (nM - fm) : wgm;
        u.pm = fm + ((wgid % nig) % gsz); u.pn = (wgid % nig) / gsz; return true;
    }
    __device__ __forceinline__ void a_ready(const Unit&) const {}
    __device__ __forceinline__ void done(const Unit&) const {}
};

__device__ __forceinline__ unsigned cvt_pk_bf16(float lo, float hi) { unsigned r; asm volatile("v_cvt_pk_bf16_f32 %0, %1, %2" : "=v"(r) : "v"(lo), "v"(hi)); return r; }
typedef float f32x2 __attribute__((ext_vector_type(2)));
__device__ __forceinline__ f32x2 gelu_pk(f32x2 v) {
    const f32x2 av = __builtin_elementwise_abs(v), d = av * 0.2316418882f + 1.0f;
    f32x2 t; t.x = __builtin_amdgcn_rcpf(d.x); t.y = __builtin_amdgcn_rcpf(d.y);
    f32x2 q = t * 0.5307027145f + (-0.7265760135f); q = q * t + 0.7107068705f; q = q * t + (-0.142248368f); q = q * t + 0.127414796f; q = q * t;
    const f32x2 s = (v * v) * (-0.72134752044f);
    f32x2 e; e.x = __builtin_amdgcn_exp2f(s.x); e.y = __builtin_amdgcn_exp2f(s.y);
    const f32x2 m = v * (q * e), r = v - m;
    f32x2 o; o.x = v.x < 0.f ? m.x : r.x; o.y = v.y < 0.f ? m.y : r.y; return o;
}

template <int ACT  > struct EpiBf16 {
    static constexpr bool PERM = true, AFTER_DRAIN = false, INPLACE = false; static_assert(ACT == 0 || ACT == 1, "EpiBf16: ACT is 0 (none) or 1 (gelu_pk)");
    bf16_t* O; int ldc; const float* bias; int split_cols; size_t split_stride; float scale0;
    __device__ __forceinline__ void operator()(const f32x4 (&acc)[2][2][4][2], const Unit& u, int wr, int wc, int fr, int fq) const {
        const int row0 = u.pm * BM + wr * 64 + fr; int colt = u.pn * BM; bf16_t* base = O;
        float sc = 1.f; if (split_cols) { const int t = colt / split_cols; base += (size_t)t * split_stride; colt -= t * split_cols; if (t == 0) sc = scale0; }
        const int col0 = colt + wc * 32 + 8 * fq, bcol0 = u.pn * BM + wc * 32 + 8 * fq;
        f32x4 bv[2][2];
#pragma unroll
        for (int bj = 0; bj < 2; ++bj)
#pragma unroll
            for (int n = 0; n < 2; ++n) bv[bj][n] = bias ? *(const f32x4*)(bias + bcol0 + bj * HALF + 4 * n) : (f32x4){0.f, 0.f, 0.f, 0.f};
#pragma unroll
        for (int ai = 0; ai < 2; ++ai)
#pragma unroll
            for (int m = 0; m < 4; ++m) { bf16_t* rowp = base + (size_t)(row0 + ai * HALF + m * 16) * ldc + col0;
#pragma unroll
                for (int bj = 0; bj < 2; ++bj) { f32x4 v0 = acc[ai][bj][m][0] + bv[bj][0], v1 = acc[ai][bj][m][1] + bv[bj][1];
                    if (ACT == 1) { f32x2 a = gelu_pk((f32x2){v0[0], v0[1]}), b = gelu_pk((f32x2){v0[2], v0[3]}), c = gelu_pk((f32x2){v1[0], v1[1]}), d = gelu_pk((f32x2){v1[2], v1[3]});
                        v0 = (f32x4){a.x, a.y, b.x, b.y}; v1 = (f32x4){c.x, c.y, d.x, d.y}; }
                    v0 = v0 * sc; v1 = v1 * sc; u32x4 w; w.x = cvt_pk_bf16(v0[0], v0[1]); w.y = cvt_pk_bf16(v0[2], v0[3]); w.z = cvt_pk_bf16(v1[0], v1[1]); w.w = cvt_pk_bf16(v1[2], v1[3]);
                    *(u32x4*)(rowp + bj * HALF) = w; } }
    }
};
template <class Epi, class Sched, bool ALIGN_EPI = false, bool SP2 = false>
__device__ __forceinline__ void gemm_phase(PG8_LAS unsigned char* lds, const Gemm g, const Sched& S, const Epi& E) {
    const int tid = threadIdx.x, wid = __builtin_amdgcn_readfirstlane(tid >> 6), lane = tid & 63, wr = wid >> 2, wc = wid & 3, fr = lane & 15, fq = lane >> 4;
    const int K = g.K; int nt = K / BK;
    unsigned voffA[2], voffB[2];
#pragma unroll
    for (int i = 0; i < 2; ++i) { int R, C; stage_rc(tid * 16 + i * 8192, R, C); const int Rb = Epi::PERM ? ((R & ~31) + perm32(R & 31)) : R;
        voffA[i] = (unsigned)(R * K + C) * 2u; voffB[i] = (unsigned)(Rb * K + C) * 2u; }
    const size_t kstep = (size_t)(BK * 2);
    const size_t hstep = (size_t)HALF * K * 2;
    const size_t tstep = 2 * hstep;
    const unsigned ldsw = (unsigned)wid * 1024u;
    const int aoff = lds_byte(wr * 64 + fr, fq * 8), boff = lds_byte(wc * 32 + fr, fq * 8);
#define PG8_SA(b, h) (((b) * 2 + (h)) * HTB)
#define PG8_SB(b, h) ((4 + (b) * 2 + (h)) * HTB)
#define PG8_STAGE(bufoff, gbase, voff) do { _Pragma("unroll") for (int _i = 0; _i < 2; ++_i) \
        __builtin_amdgcn_global_load_lds((const unsigned*)((const char*)(gbase) + (voff)[_i]), (PG8_LAS unsigned*)(lds + (bufoff) + ldsw + _i * 8192), 16, 0, 0); } while (0)
#define PG8_LDA(dst, b, h) do { _Pragma("unroll") for (int m = 0; m < 4; ++m) _Pragma("unroll") for (int k = 0; k < 2; ++k) dst[m][k] = *(const PG8_LAS bf16x8*)(lds + PG8_SA(b, h) + aoff + m * 2048 + k * 1024); } while (0)
#define PG8_LDB(dst, b, h) do { _Pragma("unroll") for (int n = 0; n < 2; ++n) _Pragma("unroll") for (int k = 0; k < 2; ++k) dst[n][k] = *(const PG8_LAS bf16x8*)(lds + PG8_SB(b, h) + boff + n * 2048 + k * 1024); } while (0)
#define PG8_MMA(ai, bj, At, Bt) do { __builtin_amdgcn_s_setprio(1); _Pragma("unroll") for (int m = 0; m < 4; ++m) _Pragma("unroll") for (int n = 0; n < 2; ++n) _Pragma("unroll") for (int k = 0; k < 2; ++k) \
        acc[ai][bj][m][n] = __builtin_amdgcn_mfma_f32_16x16x32_bf16(Bt[n][k], At[m][k], acc[ai][bj][m][n], 0, 0, 0); __builtin_amdgcn_s_setprio(0); } while (0)
#define PG8_WAIT_V(n) asm volatile("s_waitcnt vmcnt(" #n ")" ::: "memory")
#define PG8_WAIT_L(n) asm volatile("s_waitcnt lgkmcnt(" #n ")" ::: "memory")
#define PG8_BAR __builtin_amdgcn_s_barrier()
#define PG8_SCHED __builtin_amdgcn_sched_barrier(0)
    Unit cur, nxt; int ui = 0;
    if (!S.next(0, cur)) return;
    if constexpr (Sched::VAR_NT) nt = S.unit_nt(cur);
    f32x4 acc[2][2][4][2];
#pragma unroll
    for (int a = 0; a < 2; ++a)
#pragma unroll
        for (int b = 0; b < 2; ++b)
#pragma unroll
            for (int m = 0; m < 4; ++m)
#pragma unroll
                for (int n = 0; n < 2; ++n) acc[a][b][m][n] = (f32x4){0.f, 0.f, 0.f, 0.f};
    bf16x8 At[4][2], B0[2][2], B1[2][2];
    const char* cA = (const char*)g.A + (size_t)cur.pm * tstep; const char* cB = (const char*)g.Bt + (size_t)cur.pn * tstep;
    S.a_ready(cur);
    if constexpr (SP2) {
        PG8_STAGE(PG8_SB(0, 0), cB, voffB); PG8_STAGE(PG8_SB(0, 1), cB + hstep, voffB); PG8_STAGE(PG8_SA(0, 0), cA, voffA); PG8_STAGE(PG8_SA(0, 1), cA + hstep, voffA);
        if (wr == 1) PG8_BAR;
        PG8_WAIT_V(2); PG8_BAR;
        PG8_STAGE(PG8_SB(1, 0), cB + kstep, voffB); PG8_STAGE(PG8_SA(1, 0), cA + kstep, voffA); PG8_STAGE(PG8_SB(1, 1), cB + hstep + kstep, voffB);
        PG8_WAIT_V(6); PG8_BAR;
    } else {
        PG8_STAGE(PG8_SB(0, 0), cB, voffB); PG8_STAGE(PG8_SA(0, 0), cA, voffA); PG8_STAGE(PG8_SB(0, 1), cB + hstep, voffB); PG8_STAGE(PG8_SA(0, 1), cA + hstep, voffA);
        if (wr == 1) PG8_BAR;
        PG8_WAIT_V(4); PG8_BAR;
        PG8_STAGE(PG8_SB(1, 0), cB + kstep, voffB); PG8_STAGE(PG8_SA(1, 0), cA + kstep, voffA); PG8_STAGE(PG8_SB(1, 1), cB + hstep + kstep, voffB);
        PG8_WAIT_V(6); PG8_BAR;
    }
    for (;;) {
        const bool has_next = S.next(ui + 1, nxt);
        const char* nA = has_next ? (const char*)g.A + (size_t)nxt.pm * tstep : cA; const char* nB = has_next ? (const char*)g.Bt + (size_t)nxt.pn * tstep : cB;
        for (int t = 0; t < nt; t += 2) {
            const bool last = (t == nt - 2);
            const char* a1 = cA + (size_t)(t + 1) * kstep;
            const char* a2 = last ? nA : cA + (size_t)(t + 2) * kstep; const char* b2 = last ? nB : cB + (size_t)(t + 2) * kstep;
            const char* a3 = a2 + kstep; const char* b3 = b2 + kstep;
            if (last && has_next) S.a_ready(nxt);
            if constexpr (SP2) {
            PG8_LDB(B0, 0, 0); PG8_LDB(B1, 0, 1); PG8_SCHED; PG8_LDA(At, 0, 0); PG8_STAGE(PG8_SA(1, 1), a1 + hstep, voffA);
            PG8_WAIT_V(8); PG8_WAIT_L(0); PG8_BAR; PG8_MMA(0, 0, At, B0); PG8_MMA(0, 1, At, B1); PG8_BAR; PG8_SCHED;
            PG8_LDA(At, 0, 1); PG8_STAGE(PG8_SB(0, 0), b2, voffB); PG8_STAGE(PG8_SB(0, 1), b2 + hstep, voffB); PG8_STAGE(PG8_SA(0, 0), a2, voffA);
            PG8_WAIT_V(8); PG8_WAIT_L(0); PG8_BAR; PG8_MMA(1, 0, At, B0); PG8_MMA(1, 1, At, B1); PG8_BAR; PG8_SCHED;
            PG8_LDB(B0, 1, 0); PG8_LDB(B1, 1, 1); PG8_SCHED; PG8_LDA(At, 1, 0); PG8_STAGE(PG8_SA(0, 1), a2 + hstep, voffA);
            PG8_WAIT_V(8); PG8_WAIT_L(0); PG8_BAR; PG8_MMA(0, 0, At, B0); PG8_MMA(0, 1, At, B1); PG8_BAR; PG8_SCHED;
            PG8_LDA(At, 1, 1); PG8_STAGE(PG8_SB(1, 0), b3, voffB); PG8_STAGE(PG8_SB(1, 1), b3 + hstep, voffB); PG8_STAGE(PG8_SA(1, 0), a3, voffA);
            PG8_WAIT_V(8); PG8_WAIT_L(0); PG8_BAR; PG8_MMA(1, 0, At, B0); PG8_MMA(1, 1, At, B1); PG8_BAR; PG8_SCHED;
            } else {
            PG8_LDB(B0, 0, 0); PG8_SCHED; PG8_LDA(At, 0, 0); PG8_STAGE(PG8_SA(1, 1), a1 + hstep, voffA);
            PG8_WAIT_L(8); PG8_BAR; PG8_WAIT_L(0); PG8_MMA(0, 0, At, B0); PG8_BAR; PG8_SCHED;
            PG8_LDB(B1, 0, 1); PG8_STAGE(PG8_SB(0, 0), b2, voffB);
            PG8_BAR; PG8_WAIT_L(0); PG8_MMA(0, 1, At, B1); PG8_BAR;
            PG8_LDA(At, 0, 1); PG8_STAGE(PG8_SA(0, 0), a2, voffA);
            PG8_BAR; PG8_WAIT_L(0); PG8_MMA(1, 0, At, B0); PG8_BAR; PG8_SCHED;
            PG8_STAGE(PG8_SB(0, 1), b2 + hstep, voffB);
            PG8_WAIT_V(6); PG8_BAR; PG8_MMA(1, 1, At, B1); PG8_BAR;
            PG8_LDB(B0, 1, 0); PG8_SCHED; PG8_LDA(At, 1, 0); PG8_STAGE(PG8_SA(0, 1), a2 + hstep, voffA);
            PG8_WAIT_L(8); PG8_BAR; PG8_WAIT_L(0); PG8_MMA(0, 0, At, B0); PG8_BAR; PG8_SCHED;
            PG8_LDB(B1, 1, 1); PG8_STAGE(PG8_SB(1, 0), b3, voffB);
            PG8_BAR; PG8_WAIT_L(0); PG8_MMA(0, 1, At, B1); PG8_BAR;
            PG8_LDA(At, 1, 1); PG8_STAGE(PG8_SA(1, 0), a3, voffA);
            PG8_BAR; PG8_WAIT_L(0); PG8_MMA(1, 0, At, B0); PG8_BAR; PG8_SCHED;
            PG8_STAGE(PG8_SB(1, 1), b3 + hstep, voffB);
            PG8_WAIT_V(6); PG8_BAR; PG8_MMA(1, 1, At, B1); PG8_BAR;
            }
        }
        if constexpr (ALIGN_EPI) { if (wr == 0) PG8_BAR; }
        bool keep_acc = false;
        if constexpr (Epi::INPLACE) { keep_acc = E.inplace(acc, cur, wr, wc, fr, fq); S.done(cur); }
        else if constexpr (!Epi::AFTER_DRAIN) { E(acc, cur, wr, wc, fr, fq); S.done(cur); }
        if (!has_next) break;
        if (!keep_acc)
#pragma unroll
        for (int a = 0; a < 2; ++a)
#pragma unroll
            for (int b = 0; b < 2; ++b)
#pragma unroll
                for (int m = 0; m < 4; ++m)
#pragma unroll
                    for (int n = 0; n < 2; ++n) acc[a][b][m][n] = (f32x4){0.f, 0.f, 0.f, 0.f};
        cur = nxt; cA = nA; cB = nB; ++ui;
        if constexpr (Sched::VAR_NT) nt = S.unit_nt(cur);
        if constexpr (ALIGN_EPI) { if (wr == 1) PG8_BAR; }
    }
    PG8_WAIT_V(0);
    if constexpr (!ALIGN_EPI) { if (wr == 0) PG8_BAR; }
    PG8_BAR;
    if constexpr (Epi::AFTER_DRAIN) { E.fused(acc, cur, wr, wc, fr, fq, lds, wid, lane); S.done(cur); }
#undef PG8_SA
#undef PG8_SB
#undef PG8_STAGE
#undef PG8_LDA
#undef PG8_LDB
#undef PG8_MMA
#undef PG8_WAIT_V
#undef PG8_WAIT_L
#undef PG8_BAR
#undef PG8_SCHED
}
}

namespace pg8 {
typedef float f32x2e __attribute__((ext_vector_type(2))); typedef __bf16 bf16x2e __attribute__((ext_vector_type(2)));
__device__ __forceinline__ unsigned cvtpk(float lo, float hi) { f32x2e v = {lo, hi}; bf16x2e b = __builtin_convertvector(v, bf16x2e); return __builtin_bit_cast(unsigned, b); }
__device__ __forceinline__ float bflo(unsigned u) { return __builtin_bit_cast(float, u << 16); }
__device__ __forceinline__ float bfhi(unsigned u) { return __builtin_bit_cast(float, u & 0xffff0000u); }
__device__ __forceinline__ void st16_wt(void* p, u32x4 v) { asm volatile("global_store_dwordx4 %0, %1, off sc1\n\ts_nop 1" :: "v"(p), "v"(v) : "memory"); }
__device__ __forceinline__ float sigm(float v) { return __builtin_amdgcn_rcpf(1.0f + __expf(-v)); }

struct EpiProj {
    static constexpr bool PERM = true, AFTER_DRAIN = false, INPLACE = false;
    bf16_t* proj; bf16_t* gates; int ldp, ldg;
    __device__ __forceinline__ void operator()(const f32x4 (&acc)[2][2][4][2], const Unit& u, int wr, int wc, int fr, int fq) const {
        const int row0 = u.pm * BM + wr * 64 + fr; const int pn = u.pn; const bool isg = (pn >= 19);
        bf16_t* base = isg ? gates : proj; const int ld = isg ? ldg : ldp; const int colt = isg ? (pn - 19) * BM : pn * BM;
        const int col0 = colt + wc * 32 + 8 * fq;
#pragma unroll
        for (int ai = 0; ai < 2; ++ai)
#pragma unroll
            for (int m = 0; m < 4; ++m) { bf16_t* rowp = base + (size_t)(row0 + ai * HALF + m * 16) * ld + col0;
#pragma unroll
                for (int bj = 0; bj < 2; ++bj) { f32x4 v0 = acc[ai][bj][m][0], v1 = acc[ai][bj][m][1];
                    if (isg) { v0 = (f32x4){sigm(v0[0]), sigm(v0[1]), sigm(v0[2]), sigm(v0[3])}; v1 = (f32x4){sigm(v1[0]), sigm(v1[1]), sigm(v1[2]), sigm(v1[3])}; }
                    u32x4 w; w.x = cvtpk(v0[0], v0[1]); w.y = cvtpk(v0[2], v0[3]); w.z = cvtpk(v1[0], v1[1]); w.w = cvtpk(v1[2], v1[3]);
                    *(u32x4*)(rowp + bj * HALF) = w; } }
    }
};
struct EpiPlain {
    static constexpr bool PERM = true, AFTER_DRAIN = false, INPLACE = false;
    bf16_t* O; int ldc;
    __device__ __forceinline__ void operator()(const f32x4 (&acc)[2][2][4][2], const Unit& u, int wr, int wc, int fr, int fq) const {
        const int row0 = u.pm * BM + wr * 64 + fr; const int col0 = u.pn * BM + wc * 32 + 8 * fq;
#pragma unroll
        for (int ai = 0; ai < 2; ++ai)
#pragma unroll
            for (int m = 0; m < 4; ++m) { bf16_t* rowp = O + (size_t)(row0 + ai * HALF + m * 16) * ldc + col0;
#pragma unroll
                for (int bj = 0; bj < 2; ++bj) { const f32x4 v0 = acc[ai][bj][m][0], v1 = acc[ai][bj][m][1];
                    u32x4 w; w.x = cvtpk(v0[0], v0[1]); w.y = cvtpk(v0[2], v0[3]); w.z = cvtpk(v1[0], v1[1]); w.w = cvtpk(v1[2], v1[3]);
                    *(u32x4*)(rowp + bj * HALF) = w; } }
    }
};
template <int NH, int SEQL> struct EpiVt {
    static constexpr bool PERM = true, AFTER_DRAIN = false, INPLACE = false;
    unsigned char* vt;
    __device__ __forceinline__ void operator()(const f32x4 (&acc)[2][2][4][2], const Unit& u, int wr, int wc, int fr, int fq) const {
        constexpr int NKT = SEQL / 32;
        const int row0 = u.pm * BM + wr * 64 + fr; const int col0 = u.pn * BM + wc * 32 + 8 * fq;
#pragma unroll
        for (int ai = 0; ai < 2; ++ai)
#pragma unroll
            for (int m = 0; m < 4; ++m) { const int drow = row0 + ai * HALF + m * 16; const int hh = drow >> 7, d = drow & 127, dt = d >> 5, dl = d & 31;
#pragma unroll
                for (int bj = 0; bj < 2; ++bj) { const int t0 = col0 + bj * HALF; const int b = t0 / SEQL, tt = t0 % SEQL, kt = tt >> 5, s = (tt >> 4) & 1, o8 = (tt >> 3) & 1;
                    const size_t blk = ((((size_t)(b * NH + hh) * NKT + kt) * 2 + s) * 4 + dt);
                    unsigned char* p = vt + blk * 1024 + dl * 16 + o8 * 8;
                    const f32x4 v0 = acc[ai][bj][m][0], v1 = acc[ai][bj][m][1];
                    unsigned long long w0 = (unsigned long long)cvtpk(v0[0], v0[1]) | ((unsigned long long)cvtpk(v0[2], v0[3]) << 32);
                    unsigned long long w1 = (unsigned long long)cvtpk(v1[0], v1[1]) | ((unsigned long long)cvtpk(v1[2], v1[3]) << 32);
                    *(unsigned long long*)p = w0; *(unsigned long long*)(p + 512) = w1; } }
    }
};
struct MergeOrder {
    static constexpr bool VAR_NT = true;
    __device__ __forceinline__ int unit_nt(const Unit& u) const { return (u.pm >> 5) == 2 ? 8 : 12; }
    StaticOrder so;
    __device__ void init(int M, int N, int G_, int c_) { so.init(M, N, G_, c_); }
    __device__ bool next(int i, Unit& u) const { const int ib = i / 3, br = i - 3 * ib; if (!so.next(ib, u)) return false; u.pm += 32 * br; u.pn += 8 * br; return true; }
    __device__ __forceinline__ void a_ready(const Unit&) const {}
    __device__ __forceinline__ void done(const Unit&) const {}
};
struct EpiMergeAll {
    static constexpr bool PERM = true, AFTER_DRAIN = false, INPLACE = true;
    const bf16_t* gates; bf16_t* merged; int ldg, ldc;
    __device__ __forceinline__ bool inplace(f32x4 (&acc)[2][2][4][2], const Unit& u, int wr, int wc, int fr, int fq) const {
        const int br = u.pm >> 5, pm = u.pm & 31, pn = u.pn & 7;
        const int row0 = pm * BM + wr * 64 + fr; const int col0 = pn * BM + wc * 32 + 8 * fq;
        const bf16_t* gb = gates + br * 2048; const bf16_t* gd = gates + (br < 2 ? br + 1 : 2) * 2048;
        const f32x4 tiny = (f32x4){1e-20f, 1e-20f, 1e-20f, 1e-20f};
        const bool last = br == 2;
#pragma unroll
        for (int am = 0; am < 4; ++am) { const int ai = am >> 1, m0 = (am & 1) * 2;
            u32x4 g[2][2], gn[2][2];
#pragma unroll
            for (int mm = 0; mm < 2; ++mm)
#pragma unroll
                for (int bj = 0; bj < 2; ++bj) { const size_t off = (size_t)(row0 + ai * HALF + (m0 + mm) * 16) * ldg + col0 + bj * HALF;
                    g[mm][bj] = *(const u32x4*)(gb + off); gn[mm][bj] = *(const u32x4*)(gd + off); }
            __builtin_amdgcn_sched_barrier(0);
#pragma unroll
            for (int mm = 0; mm < 2; ++mm)
#pragma unroll
                for (int bj = 0; bj < 2; ++bj) { const int m = m0 + mm; const u32x4 gg = g[mm][bj], gq = gn[mm][bj];
                    f32x4 s0 = (f32x4){bflo(gg.x), bfhi(gg.x), bflo(gg.y), bfhi(gg.y)}, s1 = (f32x4){bflo(gg.z), bfhi(gg.z), bflo(gg.w), bfhi(gg.w)};
                    f32x4 d0 = (f32x4){bflo(gq.x), bfhi(gq.x), bflo(gq.y), bfhi(gq.y)}, d1 = (f32x4){bflo(gq.z), bfhi(gq.z), bflo(gq.w), bfhi(gq.w)};
                    s0 = __builtin_elementwise_max(s0, tiny); s1 = __builtin_elementwise_max(s1, tiny);
                    d0 = __builtin_elementwise_max(d0, tiny); d1 = __builtin_elementwise_max(d1, tiny);
                    if (last) { d0 = (f32x4){1.f, 1.f, 1.f, 1.f}; d1 = d0; }
                    s0 = s0 * (f32x4){__builtin_amdgcn_rcpf(d0[0]), __builtin_amdgcn_rcpf(d0[1]), __builtin_amdgcn_rcpf(d0[2]), __builtin_amdgcn_rcpf(d0[3])};
                    s1 = s1 * (f32x4){__builtin_amdgcn_rcpf(d1[0]), __builtin_amdgcn_rcpf(d1[1]), __builtin_amdgcn_rcpf(d1[2]), __builtin_amdgcn_rcpf(d1[3])};
                    const f32x4 v0 = acc[ai][bj][m][0] * s0, v1 = acc[ai][bj][m][1] * s1;
                    acc[ai][bj][m][0] = v0; acc[ai][bj][m][1] = v1;
                    if (last) { u32x4 w; w.x = cvtpk(v0[0], v0[1]); w.y = cvtpk(v0[2], v0[3]); w.z = cvtpk(v1[0], v1[1]); w.w = cvtpk(v1[2], v1[3]);
                        *(u32x4*)(merged + (size_t)(row0 + ai * HALF + m * 16) * ldc + col0 + bj * HALF) = w; } }
        }
        return !last;
    }
};
struct EpiOut {
    static constexpr bool PERM = true, AFTER_DRAIN = false, INPLACE = false;
    const float* x; float* out; bf16_t* xn2; float* ssq; int ldc; float sscale;
    __device__ __forceinline__ void operator()(const f32x4 (&acc)[2][2][4][2], const Unit& u, int wr, int wc, int fr, int fq) const {
        const int row0 = u.pm * BM + wr * 64 + fr; const int col0 = u.pn * BM + wc * 32 + 8 * fq;
#pragma unroll
        for (int am = 0; am < 4; ++am) { const int ai = am >> 1, m0 = (am & 1) * 2;
            f32x4 xv[2][2][2];
#pragma unroll
            for (int mm = 0; mm < 2; ++mm)
#pragma unroll
                for (int bj = 0; bj < 2; ++bj) { const size_t off = (size_t)(row0 + ai * HALF + (m0 + mm) * 16) * ldc + col0 + bj * HALF;
                    xv[mm][bj][0] = *(const f32x4*)(x + off); xv[mm][bj][1] = *(const f32x4*)(x + off + 4); }
            __builtin_amdgcn_sched_barrier(0);
#pragma unroll
            for (int mm = 0; mm < 2; ++mm) { const int m = m0 + mm; const size_t r = (size_t)(row0 + ai * HALF + m * 16); float rs = 0.f;
#pragma unroll
                for (int bj = 0; bj < 2; ++bj) { const size_t off = r * ldc + col0 + bj * HALF;
                    const f32x4 v0 = acc[ai][bj][m][0] + xv[mm][bj][0], v1 = acc[ai][bj][m][1] + xv[mm][bj][1];
                    rs += (v0[0] * v0[0] + v0[1] * v0[1]) + (v0[2] * v0[2] + v0[3] * v0[3]) + (v1[0] * v1[0] + v1[1] * v1[1]) + (v1[2] * v1[2] + v1[3] * v1[3]);
                    u32x4 w; w.x = cvtpk(v0[0], v0[1]); w.y = cvtpk(v0[2], v0[3]); w.z = cvtpk(v1[0], v1[1]); w.w = cvtpk(v1[2], v1[3]); *(u32x4*)(xn2 + off) = w; }
                rs += __shfl_xor(rs, 16); rs += __shfl_xor(rs, 32);
                if (fq == 0) atomicAdd(ssq + r, rs * sscale); }
        }
    }
};
struct EpiUp {
    static constexpr bool PERM = true, AFTER_DRAIN = false, INPLACE = false;
    const float* ssq; bf16_t* H; int ldc; float inv_d, eps;
    __device__ __forceinline__ void operator()(const f32x4 (&acc)[2][2][4][2], const Unit& u, int wr, int wc, int fr, int fq) const {
        const int row0 = u.pm * BM + wr * 64 + fr; const int col0 = u.pn * BM + wc * 32 + 8 * fq;
        float sq[2][4];
#pragma unroll
        for (int ai = 0; ai < 2; ++ai)
#pragma unroll
            for (int m = 0; m < 4; ++m) sq[ai][m] = ssq[row0 + ai * HALF + m * 16];
        __builtin_amdgcn_sched_barrier(0);
#pragma unroll
        for (int ai = 0; ai < 2; ++ai)
#pragma unroll
            for (int m = 0; m < 4; ++m) { const size_t r = (size_t)(row0 + ai * HALF + m * 16); const float rstd = 1.0f / sqrtf(sq[ai][m] * inv_d + eps);
#pragma unroll
                for (int bj = 0; bj < 2; ++bj) { const int c = col0 + bj * HALF;
                    f32x4 v0 = acc[ai][bj][m][0] * rstd, v1 = acc[ai][bj][m][1] * rstd;
                    v0 = __builtin_elementwise_max(v0, (f32x4){0.f, 0.f, 0.f, 0.f}); v1 = __builtin_elementwise_max(v1, (f32x4){0.f, 0.f, 0.f, 0.f});
                    v0 = v0 * v0; v1 = v1 * v1;
                    u32x4 w; w.x = cvtpk(v0[0], v0[1]); w.y = cvtpk(v0[2], v0[3]); w.z = cvtpk(v1[0], v1[1]); w.w = cvtpk(v1[2], v1[3]); *(u32x4*)(H + r * ldc + c) = w; } }
    }
};
struct EpiDown {
    static constexpr bool PERM = true, AFTER_DRAIN = false, INPLACE = false;
    const bf16_t* x1; float* out; int ldc; float scale;
    __device__ __forceinline__ void operator()(const f32x4 (&acc)[2][2][4][2], const Unit& u, int wr, int wc, int fr, int fq) const {
        const int row0 = u.pm * BM + wr * 64 + fr; const int col0 = u.pn * BM + wc * 32 + 8 * fq;
#pragma unroll
        for (int ai = 0; ai < 2; ++ai) {
            u32x4 g[4][2];
#pragma unroll
            for (int m = 0; m < 4; ++m)
#pragma unroll
                for (int bj = 0; bj < 2; ++bj) g[m][bj] = *(const u32x4*)(x1 + (size_t)(row0 + ai * HALF + m * 16) * ldc + col0 + bj * HALF);
            __builtin_amdgcn_sched_barrier(0);
#pragma unroll
            for (int m = 0; m < 4; ++m)
#pragma unroll
                for (int bj = 0; bj < 2; ++bj) { const size_t off = (size_t)(row0 + ai * HALF + m * 16) * ldc + col0 + bj * HALF; const u32x4 gg = g[m][bj];
                    const f32x4 v0 = (f32x4){bflo(gg.x), bfhi(gg.x), bflo(gg.y), bfhi(gg.y)} + acc[ai][bj][m][0] * scale, v1 = (f32x4){bflo(gg.z), bfhi(gg.z), bflo(gg.w), bfhi(gg.w)} + acc[ai][bj][m][1] * scale;
                    *(f32x4*)(out + off) = v0; *(f32x4*)(out + off + 4) = v1; }
        }
    }
};
}

constexpr int NWAVES = 8;
constexpr int DM = 2048, NBATCH = 4, SEQ = 2048, MT = NBATCH * SEQ;
constexpr int MEML = 256, MMEM = NBATCH * MEML;
constexpr int NIN = 11020;
constexpr int NMAIN = 11008;
constexpr int NWIN = 11264;
constexpr int LDP = 4864, LDG = 6144, DFF = 8192;
constexpr float EPS = 1e-6f;
constexpr float LOG2E = 1.4426950408889634f;
constexpr float QSCALE = 0.08838834764831845f * 1.4426950408889634f;
constexpr int PC_DNZ = 2304, PC_SQ = 3072, PC_SK = 3840, PC_MQ = 4096, PC_BA = 4608;
constexpr int P1_CAP = 1232, NTAIL = 1376 - 1232;
constexpr int NCHUNK = NBATCH * 6 * 32;
constexpr int CH_W = 0, CH_QG = 16384, CH_KD = 32768, CH_P = 49152, CH_U = 57344, CH_ZG = 73728, CH_BYTES = 90112;

constexpr size_t MiB = 1u << 20;
constexpr size_t WS_CTL = 0, CTL_ZERO_BYTES = 1 * MiB;
constexpr size_t WS_SSQ = 512 * 1024;
constexpr size_t WS_WOUT = 1 * MiB, WS_PDN = 9 * MiB, WS_PSWA = 12 * MiB, WS_PMEM = 15 * MiB;
constexpr size_t WS_WUP = 18 * MiB, WS_WDN = 50 * MiB;
constexpr size_t WS_RHS = 18 * MiB;
constexpr size_t WS_DNF2 = 82 * MiB;
constexpr size_t DO_WIN = 0, DO_WMKV = 44 * MiB, DO_MEMN = 48 * MiB;
constexpr int DNF_SPLIT = 23 * 32;
static_assert((size_t)DNF_SPLIT * CH_BYTES <= (size_t)64 * MiB && WS_DNF2 + (size_t)32 * CH_BYTES <= 85 * MiB && DO_MEMN + 4 * MiB <= 64 * MiB, "d_out scratch map");
constexpr size_t WS_XN = 85 * MiB;
constexpr size_t WS_PROJ = 117 * MiB;
constexpr size_t WS_ODN = 117 * MiB, WS_OSWA = 129 * MiB, WS_OMEM = 141 * MiB, WS_MERGED = 153 * MiB;
constexpr size_t WS_GATES = 193 * MiB;
constexpr size_t WS_VT = 289 * MiB, WS_MVT = 293 * MiB, WS_MEMK = 294 * MiB;
constexpr size_t WS_QF = 295 * MiB, WS_KF = 307 * MiB, WS_MQF = 311 * MiB, WS_MKF = 319 * MiB, WS_GC = 320 * MiB, WS_LG = 321 * MiB, WS_WTAIL = 328 * MiB;
constexpr size_t WS_H = 117 * MiB;
constexpr size_t WS_END = 334 * MiB;
static_assert(WS_PROJ + (size_t)MT * LDP * 2 <= WS_GATES && WS_GATES + (size_t)MT * LDG * 2 <= WS_VT, "ws map");
static_assert(WS_H + (size_t)MT * DFF * 2 <= WS_VT, "ws map 2");
constexpr int CW_BAR = 4096;

constexpr int RING_OFF = 0, RING_BYTES = 131072;
constexpr int LDS_BYTES = 147456;
constexpr int LDSCTL_OFF = LDS_BYTES - 1024, MISC_OFF = LDSCTL_OFF + 320;
#define GAS __attribute__((address_space(1)))
#define LAS __attribute__((address_space(3)))
typedef unsigned short bf16;
typedef unsigned v4u __attribute__((ext_vector_type(4)));
typedef float f32x4 __attribute__((ext_vector_type(4)));
typedef short bf16x8 __attribute__((ext_vector_type(8)));
typedef GAS unsigned gu32;
typedef GAS unsigned long long gu64;
#define RLX_AGENT __ATOMIC_RELAXED, __HIP_MEMORY_SCOPE_AGENT
#define LDS_WAIT() asm volatile("s_waitcnt lgkmcnt(0)" ::: "memory")
#define VM_WAIT() asm volatile("s_waitcnt vmcnt(0)" ::: "memory")
__device__ __forceinline__ unsigned long long rt() { return __builtin_amdgcn_s_memrealtime(); }
__device__ __forceinline__ unsigned f2bf(float f) { unsigned u = __builtin_bit_cast(unsigned, f); return (u + 0x7fffu + ((u >> 16) & 1u)) >> 16; }
__device__ __forceinline__ unsigned pk2(float lo, float hi) { return f2bf(lo) | (f2bf(hi) << 16); }

#define XB_TMO      128
#define XB_XCNT(j)  (256  + 64 * (j))
#define XB_XSUB(j)  (1280 + 64 * (j))
#define XB_XGEN(j)  (2304 + 64 * (j))
#define XB_TOP      3328
#define XB_TOPGEN   3392
#define XCD_BAR_WORDS 3456
#define XB_SPIN_CAP (1u << 18)

__device__ __forceinline__ unsigned xb_ld(unsigned* p)              { return __hip_atomic_load(p, __ATOMIC_RELAXED, __HIP_MEMORY_SCOPE_AGENT); }
__device__ __forceinline__ unsigned xb_add(unsigned* p, unsigned v) { return __hip_atomic_fetch_add(p, v, __ATOMIC_RELAXED, __HIP_MEMORY_SCOPE_AGENT); }
__device__ __forceinline__ unsigned xb_xcc_id() { return (unsigned)__builtin_amdgcn_s_getreg((3 << 11) | 20) & 0xFu; }
#define XB_SPIN(cond, bar) do { unsigned _sp = 0; while (cond) { __builtin_amdgcn_s_sleep(1); \
    if ((++_sp & 255u) == 0u) { if (xb_ld(&(bar)[XB_TMO])) break; if (_sp > XB_SPIN_CAP) { atomicAdd(&(bar)[XB_TMO], 1u); break; } } } } while (0)

struct XcdBarrier {
    unsigned* bar; unsigned x;
    volatile LAS unsigned* st;
};

__device__ __forceinline__ XcdBarrier xcd_barrier_post(unsigned* bar, volatile LAS unsigned* st) {
    XcdBarrier b; b.bar = bar; b.x = xb_xcc_id(); b.st = st;
    if (threadIdx.x == 0) (void)xb_add(&bar[XB_XCNT(b.x)], 1u);
    return b;
}
__device__ __forceinline__ void xcd_barrier_complete(unsigned* bar, unsigned x, unsigned& nloc, unsigned& nx) {
    const unsigned G = gridDim.x * gridDim.y * gridDim.z;
    unsigned sum, cnt, mine, sp = 0u;
    for (;;) {
        sum = 0u; cnt = 0u; mine = 0u;
#pragma unroll
        for (unsigned j = 0; j < 16; ++j) { const unsigned c = xb_ld(&bar[XB_XCNT(j)]); sum += c; cnt += (c > 0u) ? 1u : 0u; mine = (j == x) ? c : mine; }
        if (sum == G) break;
        __builtin_amdgcn_s_sleep(1);
        if ((++sp & 255u) == 0u) { if (xb_ld(&bar[XB_TMO])) break; if (sp > XB_SPIN_CAP) { atomicAdd(&bar[XB_TMO], 1u); break; } }
    }
    nloc = mine > 0u ? mine : 1u; nx = cnt > 0u ? cnt : 1u;
}

__device__ __forceinline__ void xcd_barrier(const XcdBarrier& b) {
    asm volatile("s_waitcnt vmcnt(0)" ::: "memory");
    __syncthreads();
    if (threadIdx.x == 0) {
        unsigned* bar = b.bar;
        __builtin_amdgcn_s_waitcnt(0);
        unsigned nloc = b.st[0], nx = b.st[1];
        if (nloc == 0u) { xcd_barrier_complete(bar, b.x, nloc, nx); b.st[0] = nloc; b.st[1] = nx; }
        const unsigned old = xb_add(&bar[XB_XSUB(b.x)], 1u);
        const unsigned gen = old / nloc;
        if (old + 1u == (gen + 1u) * nloc) {
            __builtin_amdgcn_fence(__ATOMIC_RELEASE, "agent");
            asm volatile("s_waitcnt vmcnt(0)" ::: "memory");
            const unsigned og = xb_add(&bar[XB_TOP], 1u);
            const unsigned tg = og / nx;
            if (og + 1u == (tg + 1u) * nx) xb_add(&bar[XB_TOPGEN], 1u);
            else XB_SPIN(xb_ld(&bar[XB_TOPGEN]) == tg, bar);
            __builtin_amdgcn_fence(__ATOMIC_ACQUIRE, "agent");
            xb_add(&bar[XB_XGEN(b.x)], 1u);
            asm volatile("s_waitcnt vmcnt(0)" ::: "memory");
        } else {
            XB_SPIN(xb_ld(&bar[XB_XGEN(b.x)]) == gen, bar);
            __builtin_amdgcn_fence(__ATOMIC_ACQUIRE, "agent");
            asm volatile("s_waitcnt vmcnt(0)" ::: "memory");
        }
    }
    __syncthreads();
}

typedef unsigned v2u __attribute__((ext_vector_type(2)));
typedef float f32x16 __attribute__((ext_vector_type(16)));
using pg8::cvtpk; using pg8::bflo; using pg8::bfhi;
__device__ __forceinline__ float bf2f(unsigned short b) { return __builtin_bit_cast(float, (unsigned)b << 16); }
__device__ __forceinline__ float wave_sum(float v) {
#pragma unroll
    for (int o = 1; o < 64; o <<= 1) v += __shfl_xor(v, o);
    return v;
}
__device__ __forceinline__ bf16x8 pack8(f32x4 a, f32x4 b) {
    v4u w; w.x = cvtpk(a[0], a[1]); w.y = cvtpk(a[2], a[3]); w.z = cvtpk(b[0], b[1]); w.w = cvtpk(b[2], b[3]);
    return __builtin_bit_cast(bf16x8, w);
}
__device__ __forceinline__ float siluf(float y) { return y * __builtin_amdgcn_rcpf(1.0f + __expf(-y)); }

struct DnfMap { unsigned char* a; unsigned char* b; __device__ __forceinline__ unsigned char* rec(int chunk) const { return chunk < DNF_SPLIT ? a + (size_t)chunk * CH_BYTES : b + (size_t)(chunk - DNF_SPLIT) * CH_BYTES; } };
template <int MODE> __device__ __forceinline__ int colmap(int nr_in) {
    int nr = nr_in;
    if (MODE == 0) return nr;
    if (MODE == 2) nr += 38 * 256;
    if (nr < 3072) return nr;
    if (nr < 4096) return nr + 12;
    if (nr < 4608) return nr + 268;
    if (nr < 4620) return nr - 4608 + 3072;
    if (nr < 4864) return -1;
    if (nr < 11008) return nr + 12;
    return nr - 11008 + 4108;
}
template <int MODE> __device__ __forceinline__ void tr_load(const float* W, int N, int item, int nblk, int lane, f32x4 (&v)[8]) {
    const int kb = item / nblk, nb = item % nblk, n4 = lane & 7, g = lane >> 3;
    const int kk0 = 64 * kb + 8 * g, n = 32 * nb + 4 * n4;
    const int src = colmap<MODE>(n); const int srcc = src < 0 ? 0 : src;
    const GAS f32x4* p = (const GAS f32x4*)(W + (size_t)kk0 * N + srcc);
#pragma unroll
    for (int i = 0; i < 8; ++i) v[i] = p[(size_t)i * (N / 4)];
}
template <int MODE> __device__ __forceinline__ void tr_store(const float* kscale, bf16* WT, int ldt, int item, int nblk, int lane, f32x4 (&v)[8]) {
    const int kb = item / nblk, nb = item % nblk, n4 = lane & 7, g = lane >> 3;
    const int kk0 = 64 * kb + 8 * g, n = 32 * nb + 4 * n4;
    if (colmap<MODE>(n) < 0) {
#pragma unroll
        for (int i = 0; i < 8; ++i) v[i] = (f32x4){0.f, 0.f, 0.f, 0.f}; }
    if (kscale) { const f32x4 s0 = *(const GAS f32x4*)(kscale + kk0), s1 = *(const GAS f32x4*)(kscale + kk0 + 4);
        v[0] = v[0] * s0.x; v[1] = v[1] * s0.y; v[2] = v[2] * s0.z; v[3] = v[3] * s0.w; v[4] = v[4] * s1.x; v[5] = v[5] * s1.y; v[6] = v[6] * s1.z; v[7] = v[7] * s1.w; }
#pragma unroll
    for (int e = 0; e < 4; ++e) { v4u o; o.x = cvtpk(v[0][e], v[1][e]); o.y = cvtpk(v[2][e], v[3][e]); o.z = cvtpk(v[4][e], v[5][e]); o.w = cvtpk(v[6][e], v[7][e]);
        *(GAS v4u*)(WT + (size_t)(n + e) * ldt + kk0) = o; }
}
template <int MODE> __device__ __forceinline__ void transpose_matrix(const float* W, int K, int N, const float* kscale, bf16* WT, int ldt, int nrows, int gw, int NGW, int lane) {
    const int nblk = nrows / 32, nitems = (K / 64) * nblk;
    for (int it = gw; it < nitems; it += 4 * NGW) {
        f32x4 va[8], vb[8], vc[8], vd[8]; const int it2 = it + NGW, it3 = it + 2 * NGW, it4 = it + 3 * NGW;
        tr_load<MODE>(W, N, it, nblk, lane, va);
        if (it2 < nitems) tr_load<MODE>(W, N, it2, nblk, lane, vb);
        if (it3 < nitems) tr_load<MODE>(W, N, it3, nblk, lane, vc);
        if (it4 < nitems) tr_load<MODE>(W, N, it4, nblk, lane, vd);
        tr_store<MODE>(kscale, WT, ldt, it, nblk, lane, va);
        if (it2 < nitems) tr_store<MODE>(kscale, WT, ldt, it2, nblk, lane, vb);
        if (it3 < nitems) tr_store<MODE>(kscale, WT, ldt, it3, nblk, lane, vc);
        if (it4 < nitems) tr_store<MODE>(kscale, WT, ldt, it4, nblk, lane, vd);
    }
}
__device__ __forceinline__ void rms_load(const float* xrow, int lane, f32x4 (&v)[8]) {
    const GAS f32x4* xr = (const GAS f32x4*)xrow + lane;
#pragma unroll
    for (int j = 0; j < 8; ++j) v[j] = xr[64 * j];
}
__device__ __forceinline__ void rms_finish(const float* w, bf16* orow, int lane, f32x4 (&v)[8]) {
    const GAS f32x4* wr = (const GAS f32x4*)w + lane; float s = 0.f;
#pragma unroll
    for (int j = 0; j < 8; ++j) s += (v[j].x * v[j].x + v[j].y * v[j].y) + (v[j].z * v[j].z + v[j].w * v[j].w);
    const float rstd = 1.0f / sqrtf(wave_sum(s) * (1.0f / DM) + EPS);
    GAS v2u* o8 = (GAS v2u*)orow + lane;
#pragma unroll
    for (int j = 0; j < 8; ++j) { const f32x4 ww = wr[64 * j]; v2u o; o.x = cvtpk(v[j].x * rstd * ww.x, v[j].y * rstd * ww.y); o.y = cvtpk(v[j].z * rstd * ww.z, v[j].w * rstd * ww.w); o8[64 * j] = o; }
}

__device__ __forceinline__ void normfrag_item(const bf16* src, int ld, int row0, int col0, const float* wt, float scale, unsigned char* dst, int lane) {
    const int r = lane & 31, h = lane >> 5;
    const bf16* rp = src + (size_t)(row0 + r) * ld + col0 + 8 * h;
    v4u raw[8]; f32x4 w0[8], w1[8]; float ss = 0.f;
#pragma unroll
    for (int s = 0; s < 8; ++s) { raw[s] = *(const GAS v4u*)(rp + 16 * s); w0[s] = *(const GAS f32x4*)(wt + 16 * s + 8 * h); w1[s] = *(const GAS f32x4*)(wt + 16 * s + 8 * h + 4); }
    __builtin_amdgcn_sched_barrier(0);
#pragma unroll
    for (int s = 0; s < 8; ++s) {
        const float a0 = bflo(raw[s].x), a1 = bfhi(raw[s].x), a2 = bflo(raw[s].y), a3 = bfhi(raw[s].y), a4 = bflo(raw[s].z), a5 = bfhi(raw[s].z), a6 = bflo(raw[s].w), a7 = bfhi(raw[s].w);
        ss += (a0 * a0 + a1 * a1) + (a2 * a2 + a3 * a3) + (a4 * a4 + a5 * a5) + (a6 * a6 + a7 * a7); }
    ss += __shfl_xor(ss, 32);
    const float rstd = scale / sqrtf(ss * (1.0f / 128.0f) + EPS);
#pragma unroll
    for (int s = 0; s < 8; ++s) {
        v4u o; o.x = cvtpk(bflo(raw[s].x) * rstd * w0[s].x, bfhi(raw[s].x) * rstd * w0[s].y); o.y = cvtpk(bflo(raw[s].y) * rstd * w0[s].z, bfhi(raw[s].y) * rstd * w0[s].w);
        o.z = cvtpk(bflo(raw[s].z) * rstd * w1[s].x, bfhi(raw[s].z) * rstd * w1[s].y); o.w = cvtpk(bflo(raw[s].w) * rstd * w1[s].z, bfhi(raw[s].w) * rstd * w1[s].w);
        *(GAS v4u*)(dst + (size_t)(s * 64 + lane) * 16) = o; }
}

constexpr int DP_LD = 132, DP_LL = 68;
constexpr int DP_Q = 0, DP_K = 64 * DP_LD, DP_V = 2 * 64 * DP_LD, DP_L = 3 * 64 * DP_LD, DP_S = DP_L + 64 * DP_LL;
struct DnIn { const bf16* proj; const float* convw; const float* alog; const float* dtb; DnfMap dnf; float* gc; unsigned char* lg; unsigned char* rhs; };

__device__ __forceinline__ void dn_conv_issue(const DnIn& I, int chunk, int tid, unsigned (&uraw)[35]) {
    if (tid < 384) {
        const int b = chunk / 192, h = (chunk / 32) % 6, n = chunk & 31;
        const int ch2 = tid % 192, tg = tid / 192, which = ch2 >> 6, cp = ch2 & 63;
        const int gcol = which * 768 + h * 128 + 2 * cp;
        const int p0 = 64 * n + 32 * tg - 3;
        const bf16* src = I.proj + ((long)(b * SEQ + p0) * LDP + gcol);
#pragma unroll
        for (int i = 0; i < 35; ++i) { const int ic = (p0 + i >= 0) ? i : -p0;
            uraw[i] = *(const GAS unsigned*)(src + (long)ic * LDP); }
    }
}
__device__ __forceinline__ void dn_prep_chunk(const DnIn& I, LAS float* L, int chunk, int next_chunk, int tid_in, unsigned (&uraw)[35]) {
    int tz; asm volatile("v_mov_b32 %0, 0" : "=v"(tz));
    const int tid = tid_in + tz;
    const int lane = tid & 63, wave = __builtin_amdgcn_readfirstlane(tid >> 6);
    const int b = chunk / 192, h = (chunk / 32) % 6, n = chunk & 31;
    const int t0 = b * SEQ + 64 * n;
    LAS float* QS = L + DP_Q; LAS float* KS = L + DP_K; LAS float* VS = L + DP_V; LAS float* LM = L + DP_L;
    LAS float* sb = L + DP_S; LAS float* sG = sb + 64; LAS float* seG = sb + 128; LAS float* srq = sb + 192; LAS float* srk = sb + 256;
    unsigned char* rec = I.dnf.rec(chunk);
    unsigned short zraw[4][4];
    { const int c = lane & 15, q = lane >> 4;
#pragma unroll
      for (int f = 0; f < 4; ++f) { const int fi = wave * 4 + f, sl = fi >> 2, mt = fi & 3;
#pragma unroll
          for (int r = 0; r < 4; ++r) zraw[f][r] = I.proj[(size_t)(t0 + 16 * mt + 4 * q + r) * LDP + PC_DNZ + h * 128 + 16 * sl + c]; } }
    if (tid < 384) {
        const int ch2 = tid % 192, tg = tid / 192, which = ch2 >> 6, cp = ch2 & 63;
        const int gcol = which * 768 + h * 128 + 2 * cp;
        float w0[4], w1[4];
#pragma unroll
        for (int k = 0; k < 4; ++k) { w0[k] = I.convw[k * 2304 + gcol]; w1[k] = I.convw[k * 2304 + gcol + 1]; }
        const int p0 = 64 * n + 32 * tg - 3;
        float xa[35], xb[35];
#pragma unroll
        for (int i = 0; i < 35; ++i) { unsigned u = uraw[i]; if (p0 + i < 0) u = 0u; xa[i] = bflo(u); xb[i] = bfhi(u); }
        if (next_chunk < NCHUNK) dn_conv_issue(I, next_chunk, tid, uraw);
        LAS float* dst = L + which * 64 * DP_LD + (32 * tg) * DP_LD + 2 * cp;
#pragma unroll
        for (int j = 0; j < 32; ++j) {
            const float ya = (w0[0] * xa[j] + w0[1] * xa[j + 1]) + (w0[2] * xa[j + 2] + w0[3] * xa[j + 3]);
            const float yb = (w1[0] * xb[j] + w1[1] * xb[j + 1]) + (w1[2] * xb[j + 2] + w1[3] * xb[j + 3]);
            dst[j * DP_LD] = siluf(ya); dst[j * DP_LD + 1] = siluf(yb); if ((j & 7) == 7) asm volatile("" ::: "memory"); }
    } else if (tid >= 448) {
        const int i = lane;
        const bf16* pr = I.proj + (size_t)(t0 + i) * LDP + PC_BA;
        const float bb = bf2f(pr[h]), aa = bf2f(pr[6 + h]);
        const float beta = 1.0f / (1.0f + __expf(-bb));
        const float xx = aa + I.dtb[h];
        const float sp = xx > 20.f ? xx : log1pf(__expf(xx));
        float g = -__expf(I.alog[h]) * sp;
#pragma unroll
        for (int o = 1; o < 64; o <<= 1) { const float t = __shfl_up(g, o); if (lane >= o) g += t; }
        sb[i] = beta; sG[i] = g; seG[i] = __expf(g);
        if (i == 63) I.gc[chunk] = __expf(g);
    }
    __syncthreads();
    {
        const int row = tid >> 2, part = tid & 3, which = row >> 6, i = row & 63;
        const LAS float* p = L + which * 64 * DP_LD + i * DP_LD + 32 * part;
        float ss = 0.f;
#pragma unroll
        for (int k = 0; k < 8; ++k) { const f32x4 v = *(const LAS f32x4*)(p + 4 * k); ss += (v.x * v.x + v.y * v.y) + (v.z * v.z + v.w * v.w); }
        ss += __shfl_xor(ss, 1); ss += __shfl_xor(ss, 2);
        if (part == 0) { if (which == 0) srq[i] = 0.08838834764831845f / sqrtf(ss + EPS); else srk[i] = 1.0f / sqrtf(ss + EPS); }
    }
    __syncthreads();
    for (int e = tid; e < 2 * 64 * 64; e += 512) {
        const int which = e >> 12, i = (e >> 6) & 63, c2 = e & 63;
        LAS float* p = L + which * 64 * DP_LD + i * DP_LD + 2 * c2; const float sc = which ? srk[i] : srq[i];
        p[0] *= sc; p[1] *= sc; }
    __syncthreads();
    {
        const int it = wave & 3, c = lane & 15, q = lane >> 4; const bool isP = wave >= 4;
        const LAS float* X = isP ? QS : KS;
        bf16x8 bfr[4];
#pragma unroll
        for (int s = 0; s < 4; ++s) { const LAS float* p = X + (16 * it + c) * DP_LD + 32 * s + 8 * q; bfr[s] = pack8(*(const LAS f32x4*)p, *(const LAS f32x4*)(p + 4)); }
        f32x4 ct[4];
#pragma unroll
        for (int jt = 0; jt < 4; ++jt) { ct[jt] = (f32x4){0.f, 0.f, 0.f, 0.f};
            if (jt <= it) {
#pragma unroll
                for (int s = 0; s < 4; ++s) { const LAS float* p = KS + (16 * jt + c) * DP_LD + 32 * s + 8 * q; const bf16x8 af = pack8(*(const LAS f32x4*)p, *(const LAS f32x4*)(p + 4));
                    ct[jt] = __builtin_amdgcn_mfma_f32_16x16x32_bf16(af, bfr[s], ct[jt], 0, 0, 0); } } }
        const int i = 16 * it + c; const float Gi = sG[i], bi = sb[i];
        if (!isP) {
#pragma unroll
            for (int jt = 0; jt < 4; ++jt) if (jt <= it) { f32x4 o;
#pragma unroll
                for (int r = 0; r < 4; ++r) { const int j = 16 * jt + 4 * q + r; o[r] = (i > j) ? bi * ct[jt][r] * __expf(Gi - sG[j]) : 0.f; }
                const int j4 = 4 * jt + q, a = (i - 1) >> 2, bb = (i - 1) & 3;
                if (i >= 1 && j4 <= a) *(LAS f32x4*)(LM + 4 * ((a + 1) * (2 * a + bb) + j4)) = o; }
        } else {
#pragma unroll
            for (int s = 0; s < 2; ++s) { f32x4 lo, hi;
#pragma unroll
                for (int r = 0; r < 4; ++r) { const int j0 = 32 * s + 4 * q + r, j1 = j0 + 16;
                    lo[r] = (i >= j0) ? ct[2 * s][r] * __expf(Gi - sG[j0]) : 0.f; hi[r] = (i >= j1) ? ct[2 * s + 1][r] * __expf(Gi - sG[j1]) : 0.f; }
                *(GAS bf16x8*)(rec + CH_P + (size_t)((it * 2 + s) * 64 + lane) * 16) = pack8(lo, hi); }
        }
    }
    __syncthreads();
    {
        const int c = lane & 15, q = lane >> 4; const float G63 = sG[63];
#pragma unroll
        for (int f = 0; f < 2; ++f) { const int fi = wave * 2 + f, mt = fi >> 2, s = fi & 3;
            const int i = 16 * mt + c; const float e = seG[i]; const LAS float* p = QS + i * DP_LD + 32 * s + 4 * q;
            const f32x4 lo = *(const LAS f32x4*)p * e, hi = *(const LAS f32x4*)(p + 16) * e;
            *(GAS bf16x8*)(rec + CH_QG + (size_t)(fi * 64 + lane) * 16) = pack8(lo, hi); }
#pragma unroll
        for (int f = 0; f < 2; ++f) { const int fi = wave * 2 + f, mt = fi >> 1, s = fi & 1;
            const int dk = 16 * mt + c; f32x4 lo, hi;
#pragma unroll
            for (int r = 0; r < 4; ++r) { const int p0 = 32 * s + 4 * q + r, p1 = p0 + 16; lo[r] = KS[p0 * DP_LD + dk] * __expf(G63 - sG[p0]); hi[r] = KS[p1 * DP_LD + dk] * __expf(G63 - sG[p1]); }
            *(GAS bf16x8*)(rec + CH_KD + (size_t)(fi * 64 + lane) * 16) = pack8(lo, hi); }
    }
    {
        for (int t = tid; t < 528; t += 512) *(GAS f32x4*)(I.lg + (size_t)chunk * 8448 + (size_t)t * 16) = *(const LAS f32x4*)(LM + 4 * t);
#pragma unroll
        for (int e = 0; e < 4; ++e) { const int gi = tid + 512 * e, i = gi >> 5, c8 = (gi & 31) * 8;
            const bool isk = c8 >= 128; const LAS float* p = (isk ? KS : VS) + i * DP_LD + (c8 & 127);
            const float sc = sb[i] * (isk ? seG[i] : 1.0f);
            const f32x4 a = *(const LAS f32x4*)p * sc, bq = *(const LAS f32x4*)(p + 4) * sc;
            *(GAS bf16x8*)(I.rhs + ((size_t)chunk * 64 + i) * 512 + c8 * 2) = pack8(a, bq); }
        const int c = lane & 15, q = lane >> 4;
#pragma unroll
        for (int f = 0; f < 4; ++f) { const int fi = wave * 4 + f, sl = fi >> 2, mt = fi & 3;
            v2u zo; float zz[4];
#pragma unroll
            for (int r = 0; r < 4; ++r) zz[r] = siluf(bf2f(zraw[f][r]));
            zo.x = cvtpk(zz[0], zz[1]); zo.y = cvtpk(zz[2], zz[3]);
            *(GAS v2u*)(rec + CH_ZG + (size_t)(fi * 64 + lane) * 8) = zo; }
    }
    __syncthreads();
}

__device__ __forceinline__ void dn_solve_item(const unsigned char* lg, const unsigned char* rhs, const DnfMap& dnf, LAS float* Lw, int item, int lane) {
    const int chunk = item >> 2, g = item & 3;
    const unsigned char* lsrc = lg + (size_t)chunk * 8448;
#pragma unroll
    for (int k = 0; k < 9; ++k) { const int t = lane + 64 * k; const int tc = t < 528 ? t : 527; const f32x4 v = *(const GAS f32x4*)(lsrc + (size_t)tc * 16); if (t < 528) *(LAS f32x4*)(Lw + 4 * t) = v; }
    const bf16* rp = (const bf16*)(rhs + (size_t)chunk * 64 * 512) + 64 * g + lane;
    float X[64];
    unsigned short xr[64];
#pragma unroll
    for (int i = 0; i < 64; ++i) xr[i] = rp[i * 256];
    __builtin_amdgcn_sched_barrier(0);
#pragma unroll
    for (int i = 0; i < 64; ++i) X[i] = bf2f(xr[i]);
    asm volatile("s_waitcnt vmcnt(0) lgkmcnt(0)" ::: "memory");
    int vz; asm volatile("v_mov_b32 %0, 0" : "=v"(vz));
    const LAS float* LMv = Lw + vz;
    f32x4 ring[8];
#pragma unroll
    for (int t = 0; t < 8; ++t) ring[t] = *(const LAS f32x4*)(LMv + 4 * t);
    int t = 0;
#pragma unroll
    for (int i = 1; i < 64; ++i) {
        float acc = X[i];
#pragma unroll
        for (int j4 = 0; j4 < (i + 3) / 4; ++j4) { const f32x4 l = ring[t & 7];
            if (t + 8 < 528) ring[t & 7] = *(const LAS f32x4*)(LMv + 4 * (t + 8));
#pragma unroll
            for (int jj = 0; jj < 4; ++jj) { const int j = 4 * j4 + jj; if (j < i) acc -= l[jj] * X[j]; }
            ++t; }
        X[i] = acc; asm volatile("" ::: "memory"); }
    unsigned char* rec = dnf.rec(chunk);
    if (g < 2) {
        const int dv = 64 * g + lane, sl = dv >> 4, c = dv & 15;
        bf16* base = (bf16*)(rec + CH_U) + (size_t)(sl * 4) * 256 + c * 4;
#pragma unroll
        for (int i = 0; i < 64; ++i) base[(i >> 4) * 256 + ((i & 15) >> 2) * 64 + (i & 3)] = (bf16)(cvtpk(X[i], 0.f) & 0xffffu);
    } else {
        const int dk = 64 * (g - 2) + lane, s = dk >> 5, o = dk & 31, qq = (o & 15) >> 2, j = ((o >> 4) << 2) + (o & 3);
        bf16* base = (bf16*)(rec + CH_W) + (size_t)s * 512 + qq * 128 + j;
#pragma unroll
        for (int i = 0; i < 64; ++i) base[(i >> 4) * 2048 + (i & 15) * 8] = (bf16)(cvtpk(-X[i], 0.f) & 0xffffu);
    }
}

constexpr int SC_BUF = 57344, SC_RED = 2 * SC_BUF, SC_RS = SC_RED + 2048;
#define LDS_BAR() do { asm volatile("s_waitcnt lgkmcnt(0)" ::: "memory"); __builtin_amdgcn_s_barrier(); asm volatile("" ::: "memory"); } while (0)
template <int CTRL> __device__ __forceinline__ float dpp_t(float v) { return __builtin_bit_cast(float, __builtin_amdgcn_update_dpp(0, __builtin_bit_cast(int, v), CTRL, 0xf, 0xf, true)); }
#define dpp_f(v, ctrl) dpp_t<ctrl>(v)
__device__ __forceinline__ float row16_sum(float v) { v += dpp_t<0xB1>(v); v += dpp_t<0x4E>(v); v += dpp_t<0x141>(v); v += dpp_t<0x140>(v); return v; }
__device__ __forceinline__ f32x4 row16_sum4(f32x4 v) {
    float a = v[0], b = v[1], c = v[2], d = v[3];
    asm volatile("s_nop 1\n\t"
        "v_add_f32_dpp %0, %0, %0 quad_perm:[1,0,3,2] row_mask:0xf bank_mask:0xf\n\tv_add_f32_dpp %1, %1, %1 quad_perm:[1,0,3,2] row_mask:0xf bank_mask:0xf\n\t"
        "v_add_f32_dpp %2, %2, %2 quad_perm:[1,0,3,2] row_mask:0xf bank_mask:0xf\n\tv_add_f32_dpp %3, %3, %3 quad_perm:[1,0,3,2] row_mask:0xf bank_mask:0xf\n\t"
        "v_add_f32_dpp %0, %0, %0 quad_perm:[2,3,0,1] row_mask:0xf bank_mask:0xf\n\tv_add_f32_dpp %1, %1, %1 quad_perm:[2,3,0,1] row_mask:0xf bank_mask:0xf\n\t"
        "v_add_f32_dpp %2, %2, %2 quad_perm:[2,3,0,1] row_mask:0xf bank_mask:0xf\n\tv_add_f32_dpp %3, %3, %3 quad_perm:[2,3,0,1] row_mask:0xf bank_mask:0xf\n\t"
        "v_add_f32_dpp %0, %0, %0 row_half_mirror row_mask:0xf bank_mask:0xf\n\tv_add_f32_dpp %1, %1, %1 row_half_mirror row_mask:0xf bank_mask:0xf\n\t"
        "v_add_f32_dpp %2, %2, %2 row_half_mirror row_mask:0xf bank_mask:0xf\n\tv_add_f32_dpp %3, %3, %3 row_half_mirror row_mask:0xf bank_mask:0xf\n\t"
        "v_add_f32_dpp %0, %0, %0 row_mirror row_mask:0xf bank_mask:0xf\n\tv_add_f32_dpp %1, %1, %1 row_mirror row_mask:0xf bank_mask:0xf\n\t"
        "v_add_f32_dpp %2, %2, %2 row_mirror row_mask:0xf bank_mask:0xf\n\tv_add_f32_dpp %3, %3, %3 row_mirror row_mask:0xf bank_mask:0xf\n\ts_nop 1"
        : "+v"(a), "+v"(b), "+v"(c), "+v"(d));
    return (f32x4){a, b, c, d};
}
struct ScanIn { DnfMap dnf; const float* gc; const float* onw; bf16* odn; int popt; };
__device__ __forceinline__ void dn_scan(const ScanIn& I, LAS unsigned char* lds, int bh, int tid) {
    const int lane = tid & 63, sl = __builtin_amdgcn_readfirstlane(tid >> 6), c = lane & 15, q = lane >> 4;
    const int b = bh / 6, h = bh % 6;
    const unsigned char* rec0 = I.dnf.rec(bh * 32);
    LAS float* red = (LAS float*)(lds + SC_RED); LAS float* rsv = (LAS float*)(lds + SC_RS);
    const float onw = I.onw[16 * sl + c];
    const float gc_all = I.gc[bh * 32 + (lane & 31)];
    f32x4 S[8];
#pragma unroll
    for (int i = 0; i < 8; ++i) S[i] = (f32x4){0.f, 0.f, 0.f, 0.f};
    v2u Ucur[4], Zcur[4], Unxt[4], Znxt[4];
#pragma unroll
    for (int i = 0; i < 7; ++i) __builtin_amdgcn_global_load_lds((const unsigned*)(rec0 + (size_t)(sl * 7 + i) * 1024 + lane * 16), (LAS unsigned*)(lds + (sl * 7 + i) * 1024), 16, 0, 0);
#pragma unroll
    for (int mt = 0; mt < 4; ++mt) { Unxt[mt] = *(const GAS v2u*)(rec0 + CH_U + (size_t)((sl * 4 + mt) * 64 + lane) * 8); Znxt[mt] = *(const GAS v2u*)(rec0 + CH_ZG + (size_t)((sl * 4 + mt) * 64 + lane) * 8); }
    for (int n = 0; n < 32; ++n) {
        VM_WAIT(); __syncthreads();
#pragma unroll
        for (int mt = 0; mt < 4; ++mt) { Ucur[mt] = Unxt[mt]; Zcur[mt] = Znxt[mt]; }
        const float gcv = __builtin_bit_cast(float, __builtin_amdgcn_readlane(__builtin_bit_cast(int, gc_all), n));
        if (n + 1 < 32) {
            const unsigned char* rec = rec0 + (size_t)(n + 1) * CH_BYTES; LAS unsigned char* dstb = lds + ((n + 1) & 1) * SC_BUF;
#pragma unroll
            for (int i = 0; i < 7; ++i) __builtin_amdgcn_global_load_lds((const unsigned*)(rec + (size_t)(sl * 7 + i) * 1024 + lane * 16), (LAS unsigned*)(dstb + (sl * 7 + i) * 1024), 16, 0, 0);
#pragma unroll
            for (int mt = 0; mt < 4; ++mt) { Unxt[mt] = *(const GAS v2u*)(rec + CH_U + (size_t)((sl * 4 + mt) * 64 + lane) * 8); Znxt[mt] = *(const GAS v2u*)(rec + CH_ZG + (size_t)((sl * 4 + mt) * 64 + lane) * 8); }
        }
        const LAS unsigned char* fb = lds + (n & 1) * SC_BUF + lane * 16;
        bf16x8 Sb[4];
#pragma unroll
        for (int s = 0; s < 4; ++s) Sb[s] = pack8(S[2 * s], S[2 * s + 1]);
        f32x4 d[4], o[4];
#pragma unroll
        for (int mt = 0; mt < 4; ++mt) { d[mt] = (f32x4){bflo(Ucur[mt].x), bfhi(Ucur[mt].x), bflo(Ucur[mt].y), bfhi(Ucur[mt].y)}; o[mt] = (f32x4){0.f, 0.f, 0.f, 0.f}; }
#pragma unroll
        for (int mt = 0; mt < 4; ++mt)
#pragma unroll
            for (int s = 0; s < 4; ++s) {
                d[mt] = __builtin_amdgcn_mfma_f32_16x16x32_bf16(*(const LAS bf16x8*)(fb + CH_W + (mt * 4 + s) * 1024), Sb[s], d[mt], 0, 0, 0);
                o[mt] = __builtin_amdgcn_mfma_f32_16x16x32_bf16(*(const LAS bf16x8*)(fb + CH_QG + (mt * 4 + s) * 1024), Sb[s], o[mt], 0, 0, 0); }
        bf16x8 Db[2];
#pragma unroll
        for (int s = 0; s < 2; ++s) Db[s] = pack8(d[2 * s], d[2 * s + 1]);
#pragma unroll
        for (int mt = 0; mt < 4; ++mt)
#pragma unroll
            for (int s = 0; s < 2; ++s) o[mt] = __builtin_amdgcn_mfma_f32_16x16x32_bf16(*(const LAS bf16x8*)(fb + CH_P + (mt * 2 + s) * 1024), Db[s], o[mt], 0, 0, 0);
#pragma unroll
        for (int mt = 0; mt < 8; ++mt) { S[mt] = S[mt] * gcv;
#pragma unroll
            for (int s = 0; s < 2; ++s) S[mt] = __builtin_amdgcn_mfma_f32_16x16x32_bf16(*(const LAS bf16x8*)(fb + CH_KD + (mt * 2 + s) * 1024), Db[s], S[mt], 0, 0, 0); }
#pragma unroll
        for (int mt = 0; mt < 4; ++mt) { f32x4 ss = o[mt] * o[mt];
            ss = row16_sum4(ss);
            if (c == 0) *(LAS f32x4*)(red + sl * 64 + 16 * mt + 4 * q) = ss; }
        LDS_BAR();
        { const int pos = 8 * sl + (lane >> 3); float v = red[(lane & 7) * 64 + pos]; v += dpp_f(v, 0xB1); v += dpp_f(v, 0x4E); v += dpp_f(v, 0x141);
          if ((lane & 7) == 0) rsv[pos] = 1.0f / sqrtf(v * (1.0f / 128.0f) + EPS); }
        LDS_BAR();
        bf16* orow = I.odn + (size_t)(b * SEQ + 64 * n) * 768 + h * 128 + 16 * sl + c;
#pragma unroll
        for (int mt = 0; mt < 4; ++mt) { const f32x4 r4 = *(const LAS f32x4*)(rsv + 16 * mt + 4 * q);
            const f32x4 z4 = (f32x4){bflo(Zcur[mt].x), bfhi(Zcur[mt].x), bflo(Zcur[mt].y), bfhi(Zcur[mt].y)};
#pragma unroll
            for (int r = 0; r < 4; ++r) { const float v = o[mt][r] * r4[r] * onw * z4[r]; orow[(size_t)(16 * mt + 4 * q + r) * 768] = (bf16)(cvtpk(v, 0.f) & 0xffffu); } }
    }
    VM_WAIT(); __syncthreads();
}

__constant__ unsigned char T5_BUCKET[128] = {0,1,2,3,4,5,6,7,8,9,10,11,12,13,14,15,16,16,16,17,17,18,18,18,19,19,19,20,20,20,20,21,21,21,21,22,22,22,22,22,23,23,23,23,23,23,24,24,24,24,24,24,25,25,25,25,25,25,25,26,26,26,26,26,26,26,26,27,27,27,27,27,27,27,27,27,27,28,28,28,28,28,28,28,28,28,28,29,29,29,29,29,29,29,29,29,29,29,29,30,30,30,30,30,30,30,30,30,30,30,30,30,30,31,31,31,31,31,31,31,31,31,31,31,31,31,31,31};
struct AttnIn { const unsigned char *qf, *kf, *vt, *mqf, *mkf, *mvt; bf16 *oswa, *omem; const float* sinks; };
__device__ __forceinline__ float ex2(float v) { return __builtin_amdgcn_exp2f(v); }

__device__ __forceinline__ void ld8(const unsigned char* p, bf16x8 (&f)[8]) {
#pragma unroll
    for (int s = 0; s < 8; ++s) f[s] = *(const GAS bf16x8*)(p + s * 1024);
}
__device__ __forceinline__ bf16x8 pfrag(const f32x16& S, int s) { return pack8((f32x4){S[8 * s], S[8 * s + 1], S[8 * s + 2], S[8 * s + 3]}, (f32x4){S[8 * s + 4], S[8 * s + 5], S[8 * s + 6], S[8 * s + 7]}); }

__device__ __forceinline__ void swa_item(const AttnIn& I, const LAS float* biasT, int item, int lane) {
    const int qt = item & 63, hq = (item >> 6) % 6, b = item / 384, kvh = hq / 3;
    const int r32 = lane & 31, hh = lane >> 5;
    const unsigned char* kbase = I.kf + ((size_t)((b * 2 + kvh) * 64) * 8) * 1024 + lane * 16;
    const unsigned char* vbase = I.vt + ((size_t)((b * 2 + kvh) * 64) * 8) * 1024 + lane * 16;
#define KT(i) ((qt - 4 + (i)) < 0 ? 0 : (qt - 4 + (i)))
    bf16x8 qfr[8], ka[8], kb[8];
    ld8(I.qf + ((size_t)((b * 6 + hq) * 64 + qt) * 8) * 1024 + lane * 16, qfr);
    ld8(kbase + (size_t)KT(0) * 8192, ka);
    f32x16 S[5];
#pragma unroll
    for (int i = 0; i < 5; ++i) {
#pragma unroll
        for (int r = 0; r < 16; ++r) S[i][r] = 0.f;
        if (i & 1) { if (i + 1 < 5) ld8(kbase + (size_t)KT(i + 1) * 8192, ka); else ld8(vbase + (size_t)KT(0) * 8192, ka);
#pragma unroll
            for (int s = 0; s < 8; ++s) S[i] = __builtin_amdgcn_mfma_f32_32x32x16_bf16(kb[s], qfr[s], S[i], 0, 0, 0);
        } else { if (i + 1 < 5) ld8(kbase + (size_t)KT(i + 1) * 8192, kb); else ld8(vbase + (size_t)KT(0) * 8192, kb);
#pragma unroll
            for (int s = 0; s < 8; ++s) S[i] = __builtin_amdgcn_mfma_f32_32x32x16_bf16(ka[s], qfr[s], S[i], 0, 0, 0);
        }
    }
    const float sink2 = I.sinks[hq] * LOG2E; const LAS float* bt = biasT + hq * 128;
    float m = sink2;
#pragma unroll
    for (int i = 0; i < 5; ++i) {
#pragma unroll
        for (int r = 0; r < 16; ++r) { const int koff = (r & 3) + 8 * (r >> 2) + 4 * hh; const int dist = 32 * (4 - i) + r32 - koff;
            const bool valid = (qt - 4 + i >= 0) && (dist >= 0) && (dist < 128);
            const float v = valid ? S[i][r] + bt[dist & 127] : -INFINITY; S[i][r] = v; m = fmaxf(m, v); } }
    m = fmaxf(m, __shfl_xor(m, 32));
    float l = 0.f;
#pragma unroll
    for (int i = 0; i < 5; ++i)
#pragma unroll
        for (int r = 0; r < 16; ++r) { const float p = ex2(S[i][r] - m); S[i][r] = p; l += p; }
    l += __shfl_xor(l, 32); l += ex2(sink2 - m);
    f32x16 O[4];
#pragma unroll
    for (int dt = 0; dt < 4; ++dt)
#pragma unroll
        for (int r = 0; r < 16; ++r) O[dt][r] = 0.f;
#pragma unroll
    for (int i = 0; i < 5; ++i) {
        if (i + 1 < 5) { if (i & 1) ld8(vbase + (size_t)KT(i + 1) * 8192, kb); else ld8(vbase + (size_t)KT(i + 1) * 8192, ka); }
#pragma unroll
        for (int s = 0; s < 2; ++s) { const bf16x8 pf = pfrag(S[i], s);
#pragma unroll
            for (int dt = 0; dt < 4; ++dt) O[dt] = __builtin_amdgcn_mfma_f32_32x32x16_bf16((i & 1) ? ka[s * 4 + dt] : kb[s * 4 + dt], pf, O[dt], 0, 0, 0); }
    }
#undef KT
    const float inv = 1.0f / l;
    bf16* orow = I.oswa + (size_t)(b * SEQ + 32 * qt + r32) * 768 + hq * 128 + 4 * hh;
#pragma unroll
    for (int dt = 0; dt < 4; ++dt)
#pragma unroll
        for (int g = 0; g < 4; ++g) { v2u w; w.x = cvtpk(O[dt][4 * g] * inv, O[dt][4 * g + 1] * inv); w.y = cvtpk(O[dt][4 * g + 2] * inv, O[dt][4 * g + 3] * inv);
            *(GAS v2u*)(orow + 32 * dt + 8 * g) = w; }
}

__device__ __forceinline__ void mem_item(const AttnIn& I, int item, int lane) {
    const int qt = item & 63, h = (item >> 6) & 3, b = item >> 8;
    const int r32 = lane & 31, hh = lane >> 5;
    const unsigned char* kbase = I.mkf + ((size_t)((b * 4 + h) * 8) * 8) * 1024 + lane * 16;
    const unsigned char* vbase = I.mvt + ((size_t)((b * 4 + h) * 8) * 8) * 1024 + lane * 16;
    bf16x8 qfr[8], ka[8], kb[8];
    ld8(I.mqf + ((size_t)((b * 4 + h) * 64 + qt) * 8) * 1024 + lane * 16, qfr);
    ld8(kbase, ka);
    f32x16 O[4];
#pragma unroll
    for (int dt = 0; dt < 4; ++dt)
#pragma unroll
        for (int r = 0; r < 16; ++r) O[dt][r] = 0.f;
    float m = -INFINITY, l = 0.f;
#pragma unroll 1
    for (int half = 0; half < 2; ++half) {
        f32x16 S[4];
#pragma unroll
        for (int i = 0; i < 4; ++i) { const int kt = half * 4 + i;
#pragma unroll
            for (int r = 0; r < 16; ++r) S[i][r] = 0.f;
            const unsigned char* nxt = (i < 3) ? kbase + (size_t)(kt + 1) * 8192 : vbase + (size_t)(half * 4) * 8192;
            if (i & 1) { ld8(nxt, ka);
#pragma unroll
                for (int s = 0; s < 8; ++s) S[i] = __builtin_amdgcn_mfma_f32_32x32x16_bf16(kb[s], qfr[s], S[i], 0, 0, 0);
            } else { ld8(nxt, kb);
#pragma unroll
                for (int s = 0; s < 8; ++s) S[i] = __builtin_amdgcn_mfma_f32_32x32x16_bf16(ka[s], qfr[s], S[i], 0, 0, 0);
            } }
        float mh = m;
#pragma unroll
        for (int i = 0; i < 4; ++i)
#pragma unroll
            for (int r = 0; r < 16; ++r) mh = fmaxf(mh, S[i][r]);
        mh = fmaxf(mh, __shfl_xor(mh, 32));
        const float alpha = ex2(m - mh); m = mh;
        float ls = 0.f;
#pragma unroll
        for (int i = 0; i < 4; ++i)
#pragma unroll
            for (int r = 0; r < 16; ++r) { const float p = ex2(S[i][r] - m); S[i][r] = p; ls += p; }
        ls += __shfl_xor(ls, 32); l = l * alpha + ls;
#pragma unroll
        for (int dt = 0; dt < 4; ++dt) O[dt] = O[dt] * alpha;
#pragma unroll
        for (int i = 0; i < 4; ++i) { const int kt = half * 4 + i;
            const unsigned char* nxt = (i < 3) ? vbase + (size_t)(kt + 1) * 8192 : kbase + (size_t)(half == 0 ? 4 : 0) * 8192;
            if (i & 1) { ld8(nxt, ka); } else { ld8(nxt, kb); }
#pragma unroll
            for (int s = 0; s < 2; ++s) { const bf16x8 pf = pfrag(S[i], s);
#pragma unroll
                for (int dt = 0; dt < 4; ++dt) O[dt] = __builtin_amdgcn_mfma_f32_32x32x16_bf16((i & 1) ? kb[s * 4 + dt] : ka[s * 4 + dt], pf, O[dt], 0, 0, 0); } }
    }
    const float inv = 1.0f / l;
    bf16* orow = I.omem + (size_t)(b * SEQ + 32 * qt + r32) * 768 + h * 128 + 4 * hh;
#pragma unroll
    for (int dt = 0; dt < 4; ++dt)
#pragma unroll
        for (int g = 0; g < 4; ++g) { v2u w; w.x = cvtpk(O[dt][4 * g] * inv, O[dt][4 * g + 1] * inv); w.y = cvtpk(O[dt][4 * g + 2] * inv, O[dt][4 * g + 3] * inv);
            *(GAS v2u*)(orow + 32 * dt + 8 * g) = w; }
}

#ifndef PH_MASK
#define PH_MASK 0x1ff
#endif
#ifndef WGM_UP
#define WGM_UP 4
#endif
#ifndef WGM_DN
#define WGM_DN 4
#endif
#ifndef SP2_UP
#define SP2_UP true
#endif
#ifndef DUP_PHASE
#define DUP_PHASE -1
#endif
struct Args { const float* in[23]; float* out; unsigned char* ws; int ph_lo, ph_hi, opt, pad; };
__global__ void __launch_bounds__(NWAVES * 64, 2) hyb_fwd(Args args) {
    extern __shared__ __attribute__((aligned(16))) unsigned char lds_raw[];
    LAS unsigned char* lds = (LAS unsigned char*)lds_raw;
    volatile LAS unsigned* MISC = (volatile LAS unsigned*)(lds + MISC_OFF);
    const int tid = threadIdx.x, lane = tid & 63, wave = __builtin_amdgcn_readfirstlane(tid >> 6);
    const int G = gridDim.x, bx = blockIdx.x;
    unsigned char* ws = args.ws;
    const float* x = args.in[0]; const float* mem = args.in[1]; const float* attn_norm_w = args.in[2]; const float* w_in = args.in[3];
    const float* dn_conv_w = args.in[4]; const float* dn_A_log = args.in[5]; const float* dn_dt_bias = args.in[6]; const float* dn_out_norm_w = args.in[7];
    const float* swa_q_norm_w = args.in[8]; const float* swa_k_norm_w = args.in[9]; const float* swa_sinks = args.in[10]; const float* rel_bias = args.in[11];
    const float* mem_norm_w = args.in[12]; const float* w_mem_kv = args.in[13]; const float* xq_norm_w = args.in[14]; const float* xk_norm_w = args.in[15];
    const float* p_dn = args.in[16]; const float* p_swa = args.in[17]; const float* p_mem = args.in[18]; const float* w_out = args.in[19];
    const float* mlp_norm_w = args.in[20]; const float* w_up = args.in[21]; const float* w_down = args.in[22];
    float* out = args.out;
    bf16* WoutT = (bf16*)(ws + WS_WOUT); bf16* PdnT = (bf16*)(ws + WS_PDN); bf16* PswaT = (bf16*)(ws + WS_PSWA); bf16* PmemT = (bf16*)(ws + WS_PMEM);
    bf16* WinT = (bf16*)((unsigned char*)out + DO_WIN); bf16* WmkvT = (bf16*)((unsigned char*)out + DO_WMKV); bf16* memn = (bf16*)((unsigned char*)out + DO_MEMN);
    const DnfMap dnfm{(unsigned char*)out, ws + WS_DNF2};
    bf16* WupT = (bf16*)(ws + WS_WUP); bf16* WdnT = (bf16*)(ws + WS_WDN);
    bf16* xn = (bf16*)(ws + WS_XN); bf16* proj = (bf16*)(ws + WS_PROJ); bf16* gates = (bf16*)(ws + WS_GATES);
    bf16* odn = (bf16*)(ws + WS_ODN); bf16* oswa = (bf16*)(ws + WS_OSWA); bf16* omem = (bf16*)(ws + WS_OMEM); bf16* merged = (bf16*)(ws + WS_MERGED);
    bf16* memk = (bf16*)(ws + WS_MEMK); bf16* Hb = (bf16*)(ws + WS_H);
    float* ssq = (float*)(ws + WS_SSQ); float* gcarr = (float*)(ws + WS_GC);

    for (int u = tid; u < (LDS_BYTES - LDSCTL_OFF) / 4; u += NWAVES * 64) ((LAS unsigned*)(lds + LDSCTL_OFF))[u] = 0u;
    __syncthreads();
    XcdBarrier bar = xcd_barrier_post((unsigned*)(ws + WS_CTL) + CW_BAR, MISC + 8);
    const int lo = args.ph_lo, hi = args.ph_hi;
#define IN(k) (lo <= (k) && (k) < hi && ((PH_MASK >> (k)) & 1))
#ifdef DOUBLE_SEAM
#define SEAM(k) do { if ((k) + 1 < hi) { xcd_barrier(bar); xcd_barrier(bar); } } while (0)
#else
#define SEAM(k) do { if ((k) + 1 < hi) xcd_barrier(bar); } while (0)
#endif
    const int gw = bx * NWAVES + wave, NGW = G * NWAVES;

    if (lo <= 0 && 0 < hi) {
        for (int rep = 0; rep < ((DUP_PHASE == 0) ? 2 : 1); ++rep) if (IN(0)) { if (rep) xcd_barrier(bar);
        transpose_matrix<1>(w_in, DM, NIN, nullptr, WinT, DM, NWIN, gw, NGW, lane);
        transpose_matrix<2>(w_in, DM, NIN, nullptr, (bf16*)(ws + WS_WTAIL), DM, 1280, gw, NGW, lane);
        transpose_matrix<0>(w_mem_kv, DM, 1024, nullptr, WmkvT, DM, 1024, gw, NGW, lane);
        for (int m = gw; m < MT + MMEM; m += 2 * NGW) {
            f32x4 va[8], vb[8]; const int m2 = m + NGW; const bool two = m2 < MT + MMEM;
            rms_load(m < MT ? x + (size_t)m * DM : mem + (size_t)(m - MT) * DM, lane, va);
            if (two) rms_load(m2 < MT ? x + (size_t)m2 * DM : mem + (size_t)(m2 - MT) * DM, lane, vb);
            if (m < MT) rms_finish(attn_norm_w, xn + (size_t)m * DM, lane, va); else rms_finish(mem_norm_w, memn + (size_t)(m - MT) * DM, lane, va);
            if (two) { if (m2 < MT) rms_finish(attn_norm_w, xn + (size_t)m2 * DM, lane, vb); else rms_finish(mem_norm_w, memn + (size_t)(m2 - MT) * DM, lane, vb); }
        }
        }
        SEAM(0);
    }
    if (lo <= 1 && 1 < hi) {
        for (int rep = 0; rep < ((DUP_PHASE == 1) ? 2 : 1); ++rep) if (IN(1)) { if (rep) xcd_barrier(bar);
        { pg8::Gemm g{xn, WinT, MT, NMAIN, DM}; pg8::StaticOrder S; S.init(MT, NMAIN, G, bx); S.cap = P1_CAP; S.wgm = 4;
          pg8::EpiProj E{proj, gates, LDP, LDG};
          pg8::gemm_phase<pg8::EpiProj, pg8::StaticOrder, true, true>(lds + RING_OFF, g, S, E); }
        { pg8::Gemm g{WinT + (size_t)NMAIN * DM, xn, 256, MT, DM}; pg8::StaticOrder S; S.init(256, MT, G, (bx - 208 + G) % G);
          pg8::EpiVt<2, SEQ> E{ws + WS_VT};
          pg8::gemm_phase<pg8::EpiVt<2, SEQ>, pg8::StaticOrder, true, true>(lds + RING_OFF, g, S, E); }
        { pg8::Gemm g{memn, WmkvT, MMEM, 512, DM}; pg8::StaticOrder S; S.init(MMEM, 512, G, (bx - 240 + G) % G);
          pg8::EpiPlain E{memk, 512};
          pg8::gemm_phase<pg8::EpiPlain, pg8::StaticOrder, true, true>(lds + RING_OFF, g, S, E); }
        { pg8::Gemm g{WmkvT + (size_t)512 * DM, memn, 512, MMEM, DM}; pg8::StaticOrder S; S.init(512, MMEM, G, (bx - 248 + G) % G);
          pg8::EpiVt<4, MEML> E{ws + WS_MVT};
          pg8::gemm_phase<pg8::EpiVt<4, MEML>, pg8::StaticOrder, true, true>(lds + RING_OFF, g, S, E); }
        }
        SEAM(1);
    }
    if (lo <= 2 && 2 < hi) {
        for (int rep = 0; rep < ((DUP_PHASE == 2) ? 2 : 1); ++rep) if (IN(2)) { if (rep) xcd_barrier(bar);
        DnIn DI{proj, dn_conv_w, dn_A_log, dn_dt_bias, dnfm, gcarr, ws + WS_LG, ws + WS_RHS};
        { unsigned uraw[35];
          if (bx < NCHUNK) dn_conv_issue(DI, bx, tid, uraw);
          for (int chunk = bx; chunk < NCHUNK; chunk += G) dn_prep_chunk(DI, (LAS float*)(lds + RING_OFF), chunk, chunk + G, tid, uraw); }
        asm volatile("s_waitcnt vmcnt(0)" ::: "memory"); __syncthreads();
        { const int nmine = (NCHUNK - 1 - bx) / G + 1;
          for (int si = wave; si < 4 * nmine; si += NWAVES) dn_solve_item(ws + WS_LG, ws + WS_RHS, dnfm, (LAS float*)(lds + RING_OFF + wave * 8448), (bx + (si >> 2) * G) * 4 + (si & 3), lane); }
        { const int lw = (NWAVES - 1 - wave) * G + bx, nlight = NGW;
          for (int it = lw; it < 3200; it += nlight) {
            if (it < 1536) { const int grp = it >> 6, tile = it & 63, b = grp / 6, hq = grp % 6;
                normfrag_item(proj, LDP, b * SEQ + 32 * tile, PC_SQ + hq * 128, swa_q_norm_w, QSCALE, ws + WS_QF + (size_t)it * 8192, lane); }
            else if (it < 2048) { const int i2 = it - 1536, grp = i2 >> 6, tile = i2 & 63, b = grp >> 1, kvh = grp & 1;
                normfrag_item(proj, LDP, b * SEQ + 32 * tile, PC_SK + kvh * 128, swa_k_norm_w, 1.0f, ws + WS_KF + (size_t)i2 * 8192, lane); }
            else if (it < 3072) { const int i3 = it - 2048, grp = i3 >> 6, tile = i3 & 63, b = grp >> 2, h = grp & 3;
                normfrag_item(proj, LDP, b * SEQ + 32 * tile, PC_MQ + h * 128, xq_norm_w, QSCALE, ws + WS_MQF + (size_t)i3 * 8192, lane); }
            else { const int i4 = it - 3072, grp = i4 >> 3, tile = i4 & 7, b = grp >> 2, h = grp & 3;
                normfrag_item(memk, 512, b * MEML + 32 * tile, h * 128, xk_norm_w, 1.0f, ws + WS_MKF + (size_t)i4 * 8192, lane); }
          }
        }
        }
        SEAM(2);
    }
    if (lo <= 4 && 4 < hi) {
        for (int rep = 0; rep < ((DUP_PHASE == 4) ? 2 : 1); ++rep) if (IN(4)) { if (rep) xcd_barrier(bar);
        if (bx < 24) {
#ifndef NO_SCAN
            if (!(args.opt & 1)) { int tid_s = tid; asm volatile("" : "+v"(tid_s)); ScanIn SI{dnfm, gcarr, dn_out_norm_w, odn, args.opt}; dn_scan(SI, lds + RING_OFF, bx, tid_s); }
#endif
        }
        else if (!(args.opt & 2)) {
            LAS float* biasT = (LAS float*)(lds + RING_OFF);
            for (int e = tid; e < 768; e += NWAVES * 64) { const int hq = e >> 7, dist = e & 127; biasT[e] = rel_bias[T5_BUCKET[dist] * 6 + hq] * LOG2E; }
            __syncthreads();
            int lane_a = lane; asm volatile("" : "+v"(lane_a));
            AttnIn AI{ws + WS_QF, ws + WS_KF, ws + WS_VT, ws + WS_MQF, ws + WS_MKF, ws + WS_MVT, oswa, omem, swa_sinks};
            const int aw = (bx - 24) * NWAVES + wave, NAW = (G - 24) * NWAVES;
#ifndef NO_MEM
            for (int it = aw; it < 1024; it += NAW) mem_item(AI, it, lane_a);
#endif
#ifndef NO_SWA
            for (int it = (aw + NAW - (1024 % NAW)) % NAW; it < 1536; it += NAW) swa_item(AI, biasT, it, lane_a);
#endif
            const int ab = bx - 24, nab = G - 24, ntail = NTAIL < nab ? NTAIL : nab;
            __syncthreads();
            if (!(args.opt & 16)) { pg8::StaticOrder S; S.init(MT, NMAIN, 1 << 20, P1_CAP + ab); S.wgm = 4;
              if (ntail < NTAIL) S.cap = 0;
              const bf16* wt = (const bf16*)(ws + WS_WTAIL) - (size_t)38 * 256 * DM;
              pg8::Gemm g{xn, wt, MT, NMAIN, DM};
              pg8::EpiProj E{proj, gates, LDP, LDG};
              pg8::gemm_phase<pg8::EpiProj, pg8::StaticOrder, false, true>(lds + RING_OFF, g, S, E); }
            if (!(args.opt & 8)) {
            int lane2 = lane; asm volatile("" : "+v"(lane2));
            const int share = ab < ntail ? 1 : 3, Wt = NWAVES * (ntail + 3 * (nab - ntail));
            const int vb = ab < ntail ? (ab * NWAVES + wave) : (ntail * NWAVES + ((ab - ntail) * NWAVES + wave) * 3);
            for (int k = 0; k < share; ++k) {
                transpose_matrix<0>(w_up, DM, DFF, mlp_norm_w, WupT, DM, DFF, vb + k, Wt, lane2);
                transpose_matrix<0>(w_down, DFF, DM, nullptr, WdnT, DFF, DM, vb + k, Wt, lane2);
                transpose_matrix<0>(p_dn, 768, DM, nullptr, PdnT, 768, DM, vb + k, Wt, lane2);
                transpose_matrix<0>(p_swa, 768, DM, nullptr, PswaT, 768, DM, vb + k, Wt, lane2);
                transpose_matrix<0>(p_mem, 512, DM, nullptr, PmemT, 768, DM, vb + k, Wt, lane2);
                transpose_matrix<0>(w_out, DM, DM, nullptr, WoutT, DM, DM, vb + k, Wt, lane2); } }
        }
        }
        SEAM(4);
    }
    if (lo <= 5 && 5 < hi) {
        for (int rep = 0; rep < ((DUP_PHASE == 5) ? 2 : 1); ++rep) if (IN(5)) { if (rep) xcd_barrier(bar);
        if (!(args.opt & 16))
        { pg8::Gemm g{odn, PdnT, 3 * MT, 3 * DM, 768}; pg8::MergeOrder S; S.init(MT, DM, G, bx); S.so.wgm = 4;
          pg8::EpiMergeAll E{gates, merged, LDG, DM};
          pg8::gemm_phase<pg8::EpiMergeAll, pg8::MergeOrder, true, true>(lds + RING_OFF, g, S, E); }
        }
        SEAM(5);
    }
    if (lo <= 6 && 6 < hi) {
        for (int rep = 0; rep < ((DUP_PHASE == 6) ? 2 : 1); ++rep) if (IN(6)) { if (rep) xcd_barrier(bar);
        pg8::Gemm g{merged, WoutT, MT, DM, DM}; pg8::StaticOrder S; S.init(MT, DM, G, bx); S.wgm = 4;
        pg8::EpiOut E{x, (args.opt & 4) ? (float*)(ws + 225 * MiB) : out, xn, ssq, DM, rep ? 0.f : 1.f};
        pg8::gemm_phase<pg8::EpiOut, pg8::StaticOrder, false, true>(lds + RING_OFF, g, S, E);
        }
        SEAM(6);
    }
    if (lo <= 7 && 7 < hi) {
        for (int rep = 0; rep < ((DUP_PHASE == 7) ? 2 : 1); ++rep) if (IN(7)) { if (rep) xcd_barrier(bar);
        pg8::Gemm g{xn, WupT, MT, DFF, DM}; pg8::StaticOrder S; S.init(MT, DFF, G, bx); S.wgm = WGM_UP;
        pg8::EpiUp E{ssq, Hb, DFF, 1.0f / DM, EPS};
        pg8::gemm_phase<pg8::EpiUp, pg8::StaticOrder, true, SP2_UP>(lds + RING_OFF, g, S, E);
        }
        SEAM(7);
    }
    if (lo <= 8 && 8 < hi) {
        for (int rep = 0; rep < ((DUP_PHASE == 8) ? 2 : 1); ++rep) if (IN(8)) { if (rep) xcd_barrier(bar);
        pg8::Gemm g{Hb, WdnT, MT, DM, DFF}; pg8::StaticOrder S; S.init(MT, DM, G, bx); S.wgm = WGM_DN;
        pg8::EpiDown E{xn, out, DM, (rep || (args.opt & 4)) ? 0.f : 1.f};
        pg8::gemm_phase<pg8::EpiDown, pg8::StaticOrder, false, true>(lds + RING_OFF, g, S, E);
        }
    }
#undef IN
#undef SEAM
}

#ifndef N_LAUNCHES
#define N_LAUNCHES 1
#endif
extern "C" void kernel_launch(void* const* d_in, const int* in_sizes, int n_in, void* d_out, int out_size, void* d_ws, size_t ws_size, hipStream_t stream) {
    static int grid = 0;
    if (grid == 0) {
        if (n_in != 23 || out_size != MT * DM || ws_size < WS_END) { fprintf(stderr, "kernel_launch: unexpected shapes (n_in %d, out %d, ws %zu)\n", n_in, out_size, ws_size); grid = -1; return; }
        int dev = 0, cus = 0, per_cu = 0;
        if (hipGetDevice(&dev) != hipSuccess || hipDeviceGetAttribute(&cus, hipDeviceAttributeMultiprocessorCount, dev) != hipSuccess) { grid = -1; return; }
        if (hipFuncSetAttribute((const void*)hyb_fwd, hipFuncAttributeMaxDynamicSharedMemorySize, LDS_BYTES) != hipSuccess) { fprintf(stderr, "kernel_launch: hipFuncSetAttribute failed\n"); grid = -1; return; }
        if (hipOccupancyMaxActiveBlocksPerMultiprocessor(&per_cu, (const void*)hyb_fwd, NWAVES * 64, LDS_BYTES) != hipSuccess || per_cu < 1) { fprintf(stderr, "kernel_launch: occupancy query says %d\n", per_cu); per_cu = 1; }
        (void)hipGetLastError();
        grid = cus;
        if (grid > 256) grid = 256;
    }
    if (grid < 0) return;
    (void)hipMemsetAsync((char*)d_ws + WS_CTL, 0, CTL_ZERO_BYTES, stream);
#ifdef EXTRA_MEMSET
    (void)hipMemsetAsync((char*)d_ws + WS_END, 0, 64, stream);
#endif
    Args a{};
    for (int i = 0; i < 23; ++i) a.in[i] = (const float*)d_in[i];
    a.out = (float*)d_out; a.ws = (unsigned char*)d_ws;
#if N_LAUNCHES == 1
    a.ph_lo = 0; a.ph_hi = 9;
    hipLaunchKernelGGL(hyb_fwd, dim3(grid), dim3(NWAVES * 64), LDS_BYTES, stream, a);
#else
    for (int p = 0; p < 9; ++p) { a.ph_lo = p; a.ph_hi = p + 1; hipLaunchKernelGGL(hyb_fwd, dim3(grid), dim3(NWAVES * 64), LDS_BYTES, stream, a); }
#endif
#ifdef RERUN_PHASE
    a.ph_lo = RERUN_PHASE; a.ph_hi = RERUN_PHASE + 1; a.opt = RERUN_OPT;
    hipLaunchKernelGGL(hyb_fwd, dim3(grid), dim3(NWAVES * 64), LDS_BYTES, stream, a);
#endif
}
```

```cpp
#include <hip/hip_runtime.h>
#include <cstdio>
#include <cstdint>
namespace pg8 {
#define PG8_LAS __attribute__((address_space(3)))
typedef unsigned short bf16_t;
typedef short bf16x8 __attribute__((ext_vector_type(8)));
typedef float f32x4 __attribute__((ext_vector_type(4)));
typedef unsigned u32x4 __attribute__((ext_vector_type(4)));
constexpr int BM = 256, BK = 64, HALF = 128, HTB = HALF * BK * 2  , STAGE_BYTES = 8 * HTB, NXCD = 8, WGM = 8;

__host__ __device__ __forceinline__ int lds_byte(int r, int c) { const int st = (r >> 4) * 2 + (c >> 5), rr = r & 15, cc = c & 31, ob = rr * 64 + cc * 2; return st * 1024 + (ob ^ (((ob >> 9) & 1) << 5)); }
__host__ __device__ __forceinline__ void stage_rc(int b, int& R, int& C) { const int st = b / 1024, sb = b % 1024, swz = sb ^ (((sb >> 9) & 1) << 5); R = (st >> 1) * 16 + swz / 64; C = (st & 1) * 32 + (swz % 64) / 2; }
__host__ __device__ __forceinline__ int perm32(int rho) { const int n = rho >> 4, i = rho & 15; return 8 * (i >> 2) + 4 * n + (i & 3); }

struct Unit { int pm, pn; };
struct Gemm { const bf16_t* A; const bf16_t* Bt; int M, N, K; };

struct StaticOrder {
    static constexpr bool VAR_NT = false;
    int nM, nN, nwg, G, c, cap, wgm;
    __host__ __device__ void init(int M, int N, int G_, int c_) { nM = M / BM; nN = N / BM; nwg = nM * nN; G = G_; c = c_; cap = nwg; wgm = WGM; }
    __host__ __device__ bool next(int i, Unit& u) const {
        const long L = (long)i * G + c; if (L >= cap) return false;
        int wgid = (int)L; { const int q = nwg / NXCD, r = nwg % NXCD, xcd = wgid % NXCD, off = wgid / NXCD; wgid = (xcd < r ? xcd * (q + 1) : r * (q + 1) + (xcd - r) * q) + off; }
        const int nig = wgm * nN, gid = wgid / nig, fm = gid * wgm, gsz = (nM - fm) < wgm ? (nM - fm) : wgm;
        u.pm = fm + ((wgid % nig) % gsz); u.pn = (wgid % nig) / gsz; return true;
    }
    __device__ __forceinline__ void a_ready(const Unit&) const {}
    __device__ __forceinline__ void done(const Unit&) const {}
};

__device__ __forceinline__ unsigned cvt_pk_bf16(float lo, float hi) { unsigned r; asm volatile("v_cvt_pk_bf16_f32 %0, %1, %2" : "=v"(r) : "v"(lo), "v"(hi)); return r; }
typedef float f32x2 __attribute__((ext_vector_type(2)));
__device__ __forceinline__ f32x2 gelu_pk(f32x2 v) {
    const f32x2 av = __builtin_elementwise_abs(v), d = av * 0.2316418882f + 1.0f;
    f32x2 t; t.x = __builtin_amdgcn_rcpf(d.x); t.y = __builtin_amdgcn_rcpf(d.y);
    f32x2 q = t * 0.5307027145f + (-0.7265760135f); q = q * t + 0.7107068705f; q = q * t + (-0.142248368f); q = q * t + 0.127414796f; q = q * t;
    const f32x2 s = (v * v) * (-0.72134752044f);
    f32x2 e; e.x = __builtin_amdgcn_exp2f(s.x); e.y = __builtin_amdgcn_exp2f(s.y);
    const f32x2 m = v * (q * e), r = v - m;
    f32x2 o; o.x = v.x < 0.f ? m.x : r.x; o.y = v.y < 0.f ? m.y : r.y; return o;
}

template <int ACT  > struct EpiBf16 {
    static constexpr bool PERM = true, AFTER_DRAIN = false, INPLACE = false; static_assert(ACT == 0 || ACT == 1, "EpiBf16: ACT is 0 (none) or 1 (gelu_pk)");
    bf16_t* O; int ldc; const float* bias; int split_cols; size_t split_stride; float scale0;
    __device__ __forceinline__ void operator()(const f32x4 (&acc)[2][2][4][2], const Unit& u, int wr, int wc, int fr, int fq) const {
        const int row0 = u.pm * BM + wr * 64 + fr; int colt = u.pn * BM; bf16_t* base = O;
        float sc = 1.f; if (split_cols) { const int t = colt / split_cols; base += (size_t)t * split_stride; colt -= t * split_cols; if (t == 0) sc = scale0; }
        const int col0 = colt + wc * 32 + 8 * fq, bcol0 = u.pn * BM + wc * 32 + 8 * fq;
        f32x4 bv[2][2];
#pragma unroll
        for (int bj = 0; bj < 2; ++bj)
#pragma unroll
            for (int n = 0; n < 2; ++n) bv[bj][n] = bias ? *(const f32x4*)(bias + bcol0 + bj * HALF + 4 * n) : (f32x4){0.f, 0.f, 0.f, 0.f};
#pragma unroll
        for (int ai = 0; ai < 2; ++ai)
#pragma unroll
            for (int m = 0; m < 4; ++m) { bf16_t* rowp = base + (size_t)(row0 + ai * HALF + m * 16) * ldc + col0;
#pragma unroll
                for (int bj = 0; bj < 2; ++bj) { f32x4 v0 = acc[ai][bj][m][0] + bv[bj][0], v1 = acc[ai][bj][m][1] + bv[bj][1];
                    if (ACT == 1) { f32x2 a = gelu_pk((f32x2){v0[0], v0[1]}), b = gelu_pk((f32x2){v0[2], v0[3]}), c = gelu_pk((f32x2){v1[0], v1[1]}), d = gelu_pk((f32x2){v1[2], v1[3]});
                        v0 = (f32x4){a.x, a.y, b.x, b.y}; v1 = (f32x4){c.x, c.y, d.x, d.y}; }
                    v0 = v0 * sc; v1 = v1 * sc; u32x4 w; w.x = cvt_pk_bf16(v0[0], v0[1]); w.y = cvt_pk_bf16(v0[2], v0[3]); w.z = cvt_pk_bf16(v1[0], v1[1]); w.w = cvt_pk_bf16(v1[2], v1[3]);
                    *(u32x4*)(rowp + bj * HALF) = w; } }
    }
};
template <class Epi, class Sched, bool ALIGN_EPI = false, bool SP2 = false>
__device__ __forceinline__ void gemm_phase(PG8_LAS unsigned char* lds, const Gemm g, const Sched& S, const Epi& E) {
    const int tid = threadIdx.x, wid = __builtin_amdgcn_readfirstlane(tid >> 6), lane = tid & 63, wr = wid >> 2, wc = wid & 3, fr = lane & 15, fq = lane >> 4;
    const int K = g.K; int nt = K / BK;
    unsigned voffA[2], voffB[2];
#pragma unroll
    for (int i = 0; i < 2; ++i) { int R, C; stage_rc(tid * 16 + i * 8192, R, C); const int Rb = Epi::PERM ? ((R & ~31) + perm32(R & 31)) : R;
        voffA[i] = (unsigned)(R * K + C) * 2u; voffB[i] = (unsigned)(Rb * K + C) * 2u; }
    const size_t kstep = (size_t)(BK * 2);
    const size_t hstep = (size_t)HALF * K * 2;
    const size_t tstep = 2 * hstep;
    const unsigned ldsw = (unsigned)wid * 1024u;
    const int aoff = lds_byte(wr * 64 + fr, fq * 8), boff = lds_byte(wc * 32 + fr, fq * 8);
#define PG8_SA(b, h) (((b) * 2 + (h)) * HTB)
#define PG8_SB(b, h) ((4 + (b) * 2 + (h)) * HTB)
#define PG8_STAGE(bufoff, gbase, voff) do { _Pragma("unroll") for (int _i = 0; _i < 2; ++_i) \
        __builtin_amdgcn_global_load_lds((const unsigned*)((const char*)(gbase) + (voff)[_i]), (PG8_LAS unsigned*)(lds + (bufoff) + ldsw + _i * 8192), 16, 0, 0); } while (0)
#define PG8_LDA(dst, b, h) do { _Pragma("unroll") for (int m = 0; m < 4; ++m) _Pragma("unroll") for (int k = 0; k < 2; ++k) dst[m][k] = *(const PG8_LAS bf16x8*)(lds + PG8_SA(b, h) + aoff + m * 2048 + k * 1024); } while (0)
#define PG8_LDB(dst, b, h) do { _Pragma("unroll") for (int n = 0; n < 2; ++n) _Pragma("unroll") for (int k = 0; k < 2; ++k) dst[n][k] = *(const PG8_LAS bf16x8*)(lds + PG8_SB(b, h) + boff + n * 2048 + k * 1024); } while (0)
#define PG8_MMA(ai, bj, At, Bt) do { __builtin_amdgcn_s_setprio(1); _Pragma("unroll") for (int m = 0; m < 4; ++m) _Pragma("unroll") for (int n = 0; n < 2; ++n) _Pragma("unroll") for (int k = 0; k < 2; ++k) \
        acc[ai][bj][m][n] = __builtin_amdgcn_mfma_f32_16x16x32_bf16(Bt[n][k], At[m][k], acc[ai][bj][m][n], 0, 0, 0); __builtin_amdgcn_s_setprio(0); } while (0)
#define PG8_WAIT_V(n) asm volatile("s_waitcnt vmcnt(" #n ")" ::: "memory")
#define PG8_WAIT_L(n) asm volatile("s_waitcnt lgkmcnt(" #n ")" ::: "memory")
#define PG8_BAR __builtin_amdgcn_s_barrier()
#define PG8_SCHED __builtin_amdgcn_sched_barrier(0)
    Unit cur, nxt; int ui = 0;
    if (!S.next(0, cur)) return;
    if constexpr (Sched::VAR_NT) nt = S.unit_nt(cur);
    f32x4 acc[2][2][4][2];
#pragma unroll
    for (int a = 0; a < 2; ++a)
#pragma unroll
        for (int b = 0; b < 2; ++b)
#pragma unroll
            for (int m = 0; m < 4; ++m)
#pragma unroll
                for (int n = 0; n < 2; ++n) acc[a][b][m][n] = (f32x4){0.f, 0.f, 0.f, 0.f};
    bf16x8 At[4][2], B0[2][2], B1[2][2];
    const char* cA = (const char*)g.A + (size_t)cur.pm * tstep; const char* cB = (const char*)g.Bt + (size_t)cur.pn * tstep;
    S.a_ready(cur);
    if constexpr (SP2) {
        PG8_STAGE(PG8_SB(0, 0), cB, voffB); PG8_STAGE(PG8_SB(0, 1), cB + hstep, voffB); PG8_STAGE(PG8_SA(0, 0), cA, voffA); PG8_STAGE(PG8_SA(0, 1), cA + hstep, voffA);
        if (wr == 1) PG8_BAR;
        PG8_WAIT_V(2); PG8_BAR;
        PG8_STAGE(PG8_SB(1, 0), cB + kstep, voffB); PG8_STAGE(PG8_SA(1, 0), cA + kstep, voffA); PG8_STAGE(PG8_SB(1, 1), cB + hstep + kstep, voffB);
        PG8_WAIT_V(6); PG8_BAR;
    } else {
        PG8_STAGE(PG8_SB(0, 0), cB, voffB); PG8_STAGE(PG8_SA(0, 0), cA, voffA); PG8_STAGE(PG8_SB(0, 1), cB + hstep, voffB); PG8_STAGE(PG8_SA(0, 1), cA + hstep, voffA);
        if (wr == 1) PG8_BAR;
        PG8_WAIT_V(4); PG8_BAR;
        PG8_STAGE(PG8_SB(1, 0), cB + kstep, voffB); PG8_STAGE(PG8_SA(1, 0), cA + kstep, voffA); PG8_STAGE(PG8_SB(1, 1), cB + hstep + kstep, voffB);
        PG8_WAIT_V(6); PG8_BAR;
    }
    for (;;) {
        const bool has_next = S.next(ui + 1, nxt);
        const char* nA = has_next ? (const char*)g.A + (size_t)nxt.pm * tstep : cA; const char* nB = has_next ? (const char*)g.Bt + (size_t)nxt.pn * tstep : cB;
        for (int t = 0; t < nt; t += 2) {
            const bool last = (t == nt - 2);
            const char* a1 = cA + (size_t)(t + 1) * kstep;
            const char* a2 = last ? nA : cA + (size_t)(t + 2) * kstep; const char* b2 = last ? nB : cB + (size_t)(t + 2) * kstep;
            const char* a3 = a2 + kstep; const char* b3 = b2 + kstep;
            if (last && has_next) S.a_ready(nxt);
            if constexpr (SP2) {
            PG8_LDB(B0, 0, 0); PG8_LDB(B1, 0, 1); PG8_SCHED; PG8_LDA(At, 0, 0); PG8_STAGE(PG8_SA(1, 1), a1 + hstep, voffA);
            PG8_WAIT_V(8); PG8_WAIT_L(0); PG8_BAR; PG8_MMA(0, 0, At, B0); PG8_MMA(0, 1, At, B1); PG8_BAR; PG8_SCHED;
            PG8_LDA(At, 0, 1); PG8_STAGE(PG8_SB(0, 0), b2, voffB); PG8_STAGE(PG8_SB(0, 1), b2 + hstep, voffB); PG8_STAGE(PG8_SA(0, 0), a2, voffA);
            PG8_WAIT_V(8); PG8_WAIT_L(0); PG8_BAR; PG8_MMA(1, 0, At, B0); PG8_MMA(1, 1, At, B1); PG8_BAR; PG8_SCHED;
            PG8_LDB(B0, 1, 0); PG8_LDB(B1, 1, 1); PG8_SCHED; PG8_LDA(At, 1, 0); PG8_STAGE(PG8_SA(0, 1), a2 + hstep, voffA);
            PG8_WAIT_V(8); PG8_WAIT_L(0); PG8_BAR; PG8_MMA(0, 0, At, B0); PG8_MMA(0, 1, At, B1); PG8_BAR; PG8_SCHED;
            PG8_LDA(At, 1, 1); PG8_STAGE(PG8_SB(1, 0), b3, voffB); PG8_STAGE(PG8_SB(1, 1), b3 + hstep, voffB); PG8_STAGE(PG8_SA(1, 0), a3, voffA);
            PG8_WAIT_V(8); PG8_WAIT_L(0); PG8_BAR; PG8_MMA(1, 0, At, B0); PG8_MMA(1, 1, At, B1); PG8_BAR; PG8_SCHED;
            } else {
            PG8_LDB(B0, 0, 0); PG8_SCHED; PG8_LDA(At, 0, 0); PG8_STAGE(PG8_SA(1, 1), a1 + hstep, voffA);
            PG8_WAIT_L(8); PG8_BAR; PG8_WAIT_L(0); PG8_MMA(0, 0, At, B0); PG8_BAR; PG8_SCHED;
            PG8_LDB(B1, 0, 1); PG8_STAGE(PG8_SB(0, 0), b2, voffB);
            PG8_BAR; PG8_WAIT_L(0); PG8_MMA(0, 1, At, B1); PG8_BAR;
            PG8_LDA(At, 0, 1); PG8_STAGE(PG8_SA(0, 0), a2, voffA);
            PG8_BAR; PG8_WAIT_L(0); PG8_MMA(1, 0, At, B0); PG8_BAR; PG8_SCHED;
            PG8_STAGE(PG8_SB(0, 1), b2 + hstep, voffB);
            PG8_WAIT_V(6); PG8_BAR; PG8_MMA(1, 1, At, B1); PG8_BAR;
            PG8_LDB(B0, 1, 0); PG8_SCHED; PG8_LDA(At, 1, 0); PG8_STAGE(PG8_SA(0, 1), a2 + hstep, voffA);
            PG8_WAIT_L(8); PG8_BAR; PG8_WAIT_L(0); PG8_MMA(0, 0, At, B0); PG8_BAR; PG8_SCHED;
            PG8_LDB(B1, 1, 1); PG8_STAGE(PG8_SB(1, 0), b3, voffB);
            PG8_BAR; PG8_WAIT_L(0); PG8_MMA(0, 1, At, B1); PG8_BAR;
            PG8_LDA(At, 1, 1); PG8_STAGE(PG8_SA(1, 0), a3, voffA);
            PG8_BAR; PG8_WAIT_L(0); PG8_MMA(1, 0, At, B0); PG8_BAR; PG8_SCHED;
            PG8_STAGE(PG8_SB(1, 1), b3 + hstep, voffB);
            PG8_WAIT_V(6); PG8_BAR; PG8_MMA(1, 1, At, B1); PG8_BAR;
            }
        }
        if constexpr (ALIGN_EPI) { if (wr == 0) PG8_BAR; }
        bool keep_acc = false;
        if constexpr (Epi::INPLACE) { keep_acc = E.inplace(acc, cur, wr, wc, fr, fq); S.done(cur); }
        else if constexpr (!Epi::AFTER_DRAIN) { E(acc, cur, wr, wc, fr, fq); S.done(cur); }
        if (!has_next) break;
        if (!keep_acc)
#pragma unroll
        for (int a = 0; a < 2; ++a)
#pragma unroll
            for (int b = 0; b < 2; ++b)
#pragma unroll
                for (int m = 0; m < 4; ++m)
#pragma unroll
                    for (int n = 0; n < 2; ++n) acc[a][b][m][n] = (f32x4){0.f, 0.f, 0.f, 0.f};
        cur = nxt; cA = nA; cB = nB; ++ui;
        if constexpr (Sched::VAR_NT) nt = S.unit_nt(cur);
        if constexpr (ALIGN_EPI) { if (wr == 1) PG8_BAR; }
    }
    PG8_WAIT_V(0);
    if constexpr (!ALIGN_EPI) { if (wr == 0) PG8_BAR; }
    PG8_BAR;
    if constexpr (Epi::AFTER_DRAIN) { E.fused(acc, cur, wr, wc, fr, fq, lds, wid, lane); S.done(cur); }
#undef PG8_SA
#undef PG8_SB
#undef PG8_STAGE
#undef PG8_LDA
#undef PG8_LDB
#undef PG8_MMA
#undef PG8_WAIT_V
#undef PG8_WAIT_L
#undef PG8_BAR
#undef PG8_SCHED
}
}

namespace pg8 {
typedef float f32x2e __attribute__((ext_vector_type(2))); typedef __bf16 bf16x2e __attribute__((ext_vector_type(2)));
__device__ __forceinline__ unsigned cvtpk(float lo, float hi) { f32x2e v = {lo, hi}; bf16x2e b = __builtin_convertvector(v, bf16x2e); return __builtin_bit_cast(unsigned, b); }
__device__ __forceinline__ float bflo(unsigned u) { return __builtin_bit_cast(float, u << 16); }
__device__ __forceinline__ float bfhi(unsigned u) { return __builtin_bit_cast(float, u & 0xffff0000u); }
__device__ __forceinline__ void st16_wt(void* p, u32x4 v) { asm volatile("global_store_dwordx4 %0, %1, off sc1\n\ts_nop 1" :: "v"(p), "v"(v) : "memory"); }
__device__ __forceinline__ float sigm(float v) { return __builtin_amdgcn_rcpf(1.0f + __expf(-v)); }

struct EpiProj {
    static constexpr bool PERM = true, AFTER_DRAIN = false, INPLACE = false;
    bf16_t* proj; bf16_t* gates; int ldp, ldg;
    __device__ __forceinline__ void operator()(const f32x4 (&acc)[2][2][4][2], const Unit& u, int wr, int wc, int fr, int fq) const {
        const int row0 = u.pm * BM + wr * 64 + fr; const int pn = u.pn; const bool isg = (pn >= 19);
        bf16_t* base = isg ? gates : proj; const int ld = isg ? ldg : ldp; const int colt = isg ? (pn - 19) * BM : pn * BM;
        const int col0 = colt + wc * 32 + 8 * fq;
#pragma unroll
        for (int ai = 0; ai < 2; ++ai)
#pragma unroll
            for (int m = 0; m < 4; ++m) { bf16_t* rowp = base + (size_t)(row0 + ai * HALF + m * 16) * ld + col0;
#pragma unroll
                for (int bj = 0; bj < 2; ++bj) { f32x4 v0 = acc[ai][bj][m][0], v1 = acc[ai][bj][m][1];
                    if (isg) { v0 = (f32x4){sigm(v0[0]), sigm(v0[1]), sigm(v0[2]), sigm(v0[3])}; v1 = (f32x4){sigm(v1[0]), sigm(v1[1]), sigm(v1[2]), sigm(v1[3])}; }
                    u32x4 w; w.x = cvtpk(v0[0], v0[1]); w.y = cvtpk(v0[2], v0[3]); w.z = cvtpk(v1[0], v1[1]); w.w = cvtpk(v1[2], v1[3]);
                    *(u32x4*)(rowp + bj * HALF) = w; } }
    }
};
struct EpiPlain {
    static constexpr bool PERM = true, AFTER_DRAIN = false, INPLACE = false;
    bf16_t* O; int ldc;
    __device__ __forceinline__ void operator()(const f32x4 (&acc)[2][2][4][2], const Unit& u, int wr, int wc, int fr, int fq) const {
        const int row0 = u.pm * BM + wr * 64 + fr; const int col0 = u.pn * BM + wc * 32 + 8 * fq;
#pragma unroll
        for (int ai = 0; ai < 2; ++ai)
#pragma unroll
            for (int m = 0; m < 4; ++m) { bf16_t* rowp = O + (size_t)(row0 + ai * HALF + m * 16) * ldc + col0;
#pragma unroll
                for (int bj = 0; bj < 2; ++bj) { const f32x4 v0 = acc[ai][bj][m][0], v1 = acc[ai][bj][m][1];
                    u32x4 w; w.x = cvtpk(v0[0], v0[1]); w.y = cvtpk(v0[2], v0[3]); w.z = cvtpk(v1[0], v1[1]); w.w = cvtpk(v1[2], v1[3]);
                    *(u32x4*)(rowp + bj * HALF) = w; } }
    }
};
template <int NH, int SEQL> struct EpiVt {
    static constexpr bool PERM = true, AFTER_DRAIN = false, INPLACE = false;
    unsigned char* vt;
    __device__ __forceinline__ void operator()(const f32x4 (&acc)[2][2][4][2], const Unit& u, int wr, int wc, int fr, int fq) const {
        constexpr int NKT = SEQL / 32;
        const int row0 = u.pm * BM + wr * 64 + fr; const int col0 = u.pn * BM + wc * 32 + 8 * fq;
#pragma unroll
        for (int ai = 0; ai < 2; ++ai)
#pragma unroll
            for (int m = 0; m < 4; ++m) { const int drow = row0 + ai * HALF + m * 16; const int hh = drow >> 7, d = drow & 127, dt = d >> 5, dl = d & 31;
#pragma unroll
                for (int bj = 0; bj < 2; ++bj) { const int t0 = col0 + bj * HALF; const int b = t0 / SEQL, tt = t0 % SEQL, kt = tt >> 5, s = (tt >> 4) & 1, o8 = (tt >> 3) & 1;
                    const size_t blk = ((((size_t)(b * NH + hh) * NKT + kt) * 2 + s) * 4 + dt);
                    unsigned char* p = vt + blk * 1024 + dl * 16 + o8 * 8;
                    const f32x4 v0 = acc[ai][bj][m][0], v1 = acc[ai][bj][m][1];
                    unsigned long long w0 = (unsigned long long)cvtpk(v0[0], v0[1]) | ((unsigned long long)cvtpk(v0[2], v0[3]) << 32);
                    unsigned long long w1 = (unsigned long long)cvtpk(v1[0], v1[1]) | ((unsigned long long)cvtpk(v1[2], v1[3]) << 32);
                    *(unsigned long long*)p = w0; *(unsigned long long*)(p + 512) = w1; } }
    }
};
struct MergeOrder {
    static constexpr bool VAR_NT = true;
    __device__ __forceinline__ int unit_nt(const Unit& u) const { return (u.pm >> 5) == 2 ? 8 : 12; }
    StaticOrder so;
    __device__ void init(int M, int N, int G_, int c_) { so.init(M, N, G_, c_); }
    __device__ bool next(int i, Unit& u) const { const int ib = i / 3, br = i - 3 * ib; if (!so.next(ib, u)) return false; u.pm += 32 * br; u.pn += 8 * br; return true; }
    __device__ __forceinline__ void a_ready(const Unit&) const {}
    __device__ __forceinline__ void done(const Unit&) const {}
};
struct EpiMergeAll {
    static constexpr bool PERM = true, AFTER_DRAIN = false, INPLACE = true;
    const bf16_t* gates; bf16_t* merged; int ldg, ldc;
    __device__ __forceinline__ bool inplace(f32x4 (&acc)[2][2][4][2], const Unit& u, int wr, int wc, int fr, int fq) const {
        const int br = u.pm >> 5, pm = u.pm & 31, pn = u.pn & 7;
        const int row0 = pm * BM + wr * 64 + fr; const int col0 = pn * BM + wc * 32 + 8 * fq;
        const bf16_t* gb = gates + br * 2048; const bf16_t* gd = gates + (br < 2 ? br + 1 : 2) * 2048;
        const f32x4 tiny = (f32x4){1e-20f, 1e-20f, 1e-20f, 1e-20f};
        const bool last = br == 2;
#pragma unroll
        for (int am = 0; am < 4; ++am) { const int ai = am >> 1, m0 = (am & 1) * 2;
            u32x4 g[2][2], gn[2][2];
#pragma unroll
            for (int mm = 0; mm < 2; ++mm)
#pragma unroll
                for (int bj = 0; bj < 2; ++bj) { const size_t off = (size_t)(row0 + ai * HALF + (m0 + mm) * 16) * ldg + col0 + bj * HALF;
                    g[mm][bj] = *(const u32x4*)(gb + off); gn[mm][bj] = *(const u32x4*)(gd + off); }
            __builtin_amdgcn_sched_barrier(0);
#pragma unroll
            for (int mm = 0; mm < 2; ++mm)
#pragma unroll
                for (int bj = 0; bj < 2; ++bj) { const int m = m0 + mm; const u32x4 gg = g[mm][bj], gq = gn[mm][bj];
                    f32x4 s0 = (f32x4){bflo(gg.x), bfhi(gg.x), bflo(gg.y), bfhi(gg.y)}, s1 = (f32x4){bflo(gg.z), bfhi(gg.z), bflo(gg.w), bfhi(gg.w)};
                    f32x4 d0 = (f32x4){bflo(gq.x), bfhi(gq.x), bflo(gq.y), bfhi(gq.y)}, d1 = (f32x4){bflo(gq.z), bfhi(gq.z), bflo(gq.w), bfhi(gq.w)};
                    s0 = __builtin_elementwise_max(s0, tiny); s1 = __builtin_elementwise_max(s1, tiny);
                    d0 = __builtin_elementwise_max(d0, tiny); d1 = __builtin_elementwise_max(d1, tiny);
                    if (last) { d0 = (f32x4){1.f, 1.f, 1.f, 1.f}; d1 = d0; }
                    s0 = s0 * (f32x4){__builtin_amdgcn_rcpf(d0[0]), __builtin_amdgcn_rcpf(d0[1]), __builtin_amdgcn_rcpf(d0[2]), __builtin_amdgcn_rcpf(d0[3])};
                    s1 = s1 * (f32x4){__builtin_amdgcn_rcpf(d1[0]), __builtin_amdgcn_rcpf(d1[1]), __builtin_amdgcn_rcpf(d1[2]), __builtin_amdgcn_rcpf(d1[3])};
                    const f32x4 v0 = acc[ai][bj][m][0] * s0, v1 = acc[ai][bj][m][1] * s1;
                    acc[ai][bj][m][0] = v0; acc[ai][bj][m][1] = v1;
                    if (last) { u32x4 w; w.x = cvtpk(v0[0], v0[1]); w.y = cvtpk(v0[2], v0[3]); w.z = cvtpk(v1[0], v1[1]); w.w = cvtpk(v1[2], v1[3]);
                        *(u32x4*)(merged + (size_t)(row0 + ai * HALF + m * 16) * ldc + col0 + bj * HALF) = w; } }
        }
        return !last;
    }
};
struct EpiOut {
    static constexpr bool PERM = true, AFTER_DRAIN = false, INPLACE = false;
    const float* x; float* out; bf16_t* xn2; float* ssq; int ldc; float sscale;
    __device__ __forceinline__ void operator()(const f32x4 (&acc)[2][2][4][2], const Unit& u, int wr, int wc, int fr, int fq) const {
        const int row0 = u.pm * BM + wr * 64 + fr; const int col0 = u.pn * BM + wc * 32 + 8 * fq;
#pragma unroll
        for (int am = 0; am < 4; ++am) { const int ai = am >> 1, m0 = (am & 1) * 2;
            f32x4 xv[2][2][2];
#pragma unroll
            for (int mm = 0; mm < 2; ++mm)
#pragma unroll
                for (int bj = 0; bj < 2; ++bj) { const size_t off = (size_t)(row0 + ai * HALF + (m0 + mm) * 16) * ldc + col0 + bj * HALF;
                    xv[mm][bj][0] = *(const f32x4*)(x + off); xv[mm][bj][1] = *(const f32x4*)(x + off + 4); }
            __builtin_amdgcn_sched_barrier(0);
#pragma unroll
            for (int mm = 0; mm < 2; ++mm) { const int m = m0 + mm; const size_t r = (size_t)(row0 + ai * HALF + m * 16); float rs = 0.f;
#pragma unroll
                for (int bj = 0; bj < 2; ++bj) { const size_t off = r * ldc + col0 + bj * HALF;
                    const f32x4 v0 = acc[ai][bj][m][0] + xv[mm][bj][0], v1 = acc[ai][bj][m][1] + xv[mm][bj][1];
                    rs += (v0[0] * v0[0] + v0[1] * v0[1]) + (v0[2] * v0[2] + v0[3] * v0[3]) + (v1[0] * v1[0] + v1[1] * v1[1]) + (v1[2] * v1[2] + v1[3] * v1[3]);
                    u32x4 w; w.x = cvtpk(v0[0], v0[1]); w.y = cvtpk(v0[2], v0[3]); w.z = cvtpk(v1[0], v1[1]); w.w = cvtpk(v1[2], v1[3]); *(u32x4*)(xn2 + off) = w; }
                rs += __shfl_xor(rs, 16); rs += __shfl_xor(rs, 32);
                if (fq == 0) atomicAdd(ssq + r, rs * sscale); }
        }
    }
};
struct EpiUp {
    static constexpr bool PERM = true, AFTER_DRAIN = false, INPLACE = false;
    const float* ssq; bf16_t* H; int ldc; float inv_d, eps;
    __device__ __forceinline__ void operator()(const f32x4 (&acc)[2][2][4][2], const Unit& u, int wr, int wc, int fr, int fq) const {
        const int row0 = u.pm * BM + wr * 64 + fr; const int col0 = u.pn * BM + wc * 32 + 8 * fq;
        float sq[2][4];
#pragma unroll
        for (int ai = 0; ai < 2; ++ai)
#pragma unroll
            for (int m = 0; m < 4; ++m) sq[ai][m] = ssq[row0 + ai * HALF + m * 16];
        __builtin_amdgcn_sched_barrier(0);
#pragma unroll
        for (int ai = 0; ai < 2; ++ai)
#pragma unroll
            for (int m = 0; m < 4; ++m) { const size_t r = (size_t)(row0 + ai * HALF + m * 16); const float rstd = 1.0f / sqrtf(sq[ai][m] * inv_d + eps);
#pragma unroll
                for (int bj = 0; bj < 2; ++bj) { const int c = col0 + bj * HALF;
                    f32x4 v0 = acc[ai][bj][m][0] * rstd, v1 = acc[ai][bj][m][1] * rstd;
                    v0 = __builtin_elementwise_max(v0, (f32x4){0.f, 0.f, 0.f, 0.f}); v1 = __builtin_elementwise_max(v1, (f32x4){0.f, 0.f, 0.f, 0.f});
                    v0 = v0 * v0; v1 = v1 * v1;
                    u32x4 w; w.x = cvtpk(v0[0], v0[1]); w.y = cvtpk(v0[2], v0[3]); w.z = cvtpk(v1[0], v1[1]); w.w = cvtpk(v1[2], v1[3]); *(u32x4*)(H + r * ldc + c) = w; } }
    }
};
struct EpiDown {
    static constexpr bool PERM = true, AFTER_DRAIN = false, INPLACE = false;
    const bf16_t* x1; float* out; int ldc; float scale;
    __device__ __forceinline__ void operator()(const f32x4 (&acc)[2][2][4][2], const Unit& u, int wr, int wc, int fr, int fq) const {
        const int row0 = u.pm * BM + wr * 64 + fr; const int col0 = u.pn * BM + wc * 32 + 8 * fq;
#pragma unroll
        for (int ai = 0; ai < 2; ++ai) {
            u32x4 g[4][2];
#pragma unroll
            for (int m = 0; m < 4; ++m)
#pragma unroll
                for (int bj = 0; bj < 2; ++bj) g[m][bj] = *(const u32x4*)(x1 + (size_t)(row0 + ai * HALF + m * 16) * ldc + col0 + bj * HALF);
            __builtin_amdgcn_sched_barrier(0);
#pragma unroll
            for (int m = 0; m < 4; ++m)
#pragma unroll
                for (int bj = 0; bj < 2; ++bj) { const size_t off = (size_t)(row0 + ai * HALF + m * 16) * ldc + col0 + bj * HALF; const u32x4 gg = g[m][bj];
                    const f32x4 v0 = (f32x4){bflo(gg.x), bfhi(gg.x), bflo(gg.y), bfhi(gg.y)} + acc[ai][bj][m][0] * scale, v1 = (f32x4){bflo(gg.z), bfhi(gg.z), bflo(gg.w), bfhi(gg.w)} + acc[ai][bj][m][1] * scale;
                    *(f32x4*)(out + off) = v0; *(f32x4*)(out + off + 4) = v1; }
        }
    }
};
}

constexpr int NWAVES = 8;
constexpr int DM = 2048, NBATCH = 4, SEQ = 2048, MT = NBATCH * SEQ;
constexpr int MEML = 256, MMEM = NBATCH * MEML;
constexpr int NIN = 11020;
constexpr int NMAIN = 11008;
constexpr int NWIN = 11264;
constexpr int LDP = 4864, LDG = 6144, DFF = 8192;
constexpr float EPS = 1e-6f;
constexpr float LOG2E = 1.4426950408889634f;
constexpr float QSCALE = 0.08838834764831845f * 1.4426950408889634f;
constexpr int PC_DNZ = 2304, PC_SQ = 3072, PC_SK = 3840, PC_MQ = 4096, PC_BA = 4608;
constexpr int P1_CAP = 1232, NTAIL = 1376 - 1232;
constexpr int NCHUNK = NBATCH * 6 * 32;
constexpr int CH_W = 0, CH_QG = 16384, CH_KD = 32768, CH_P = 49152, CH_U = 57344, CH_ZG = 73728, CH_BYTES = 90112;

constexpr size_t MiB = 1u << 20;
constexpr size_t WS_CTL = 0, CTL_ZERO_BYTES = 1 * MiB;
constexpr size_t WS_SSQ = 512 * 1024;
constexpr size_t WS_WOUT = 1 * MiB, WS_PDN = 9 * MiB, WS_PSWA = 12 * MiB, WS_PMEM = 15 * MiB;
constexpr size_t WS_WUP = 18 * MiB, WS_WDN = 50 * MiB;
constexpr size_t WS_RHS = 18 * MiB;
constexpr size_t WS_DNF2 = 82 * MiB;
constexpr size_t DO_WIN = 0, DO_WMKV = 44 * MiB, DO_MEMN = 48 * MiB;
constexpr int DNF_SPLIT = 23 * 32;
static_assert((size_t)DNF_SPLIT * CH_BYTES <= (size_t)64 * MiB && WS_DNF2 + (size_t)32 * CH_BYTES <= 85 * MiB && DO_MEMN + 4 * MiB <= 64 * MiB, "d_out scratch map");
constexpr size_t WS_XN = 85 * MiB;
constexpr size_t WS_PROJ = 117 * MiB;
constexpr size_t WS_ODN = 117 * MiB, WS_OSWA = 129 * MiB, WS_OMEM = 141 * MiB, WS_MERGED = 153 * MiB;
constexpr size_t WS_GATES = 193 * MiB;
constexpr size_t WS_VT = 289 * MiB, WS_MVT = 293 * MiB, WS_MEMK = 294 * MiB;
constexpr size_t WS_QF = 295 * MiB, WS_KF = 307 * MiB, WS_MQF = 311 * MiB, WS_MKF = 319 * MiB, WS_GC = 320 * MiB, WS_LG = 321 * MiB, WS_WTAIL = 328 * MiB;
constexpr size_t WS_H = 117 * MiB;
constexpr size_t WS_END = 334 * MiB;
static_assert(WS_PROJ + (size_t)MT * LDP * 2 <= WS_GATES && WS_GATES + (size_t)MT * LDG * 2 <= WS_VT, "ws map");
static_assert(WS_H + (size_t)MT * DFF * 2 <= WS_VT, "ws map 2");
constexpr int CW_BAR = 4096;

constexpr int RING_OFF = 0, RING_BYTES = 131072;
constexpr int LDS_BYTES = 147456;
constexpr int LDSCTL_OFF = LDS_BYTES - 1024, MISC_OFF = LDSCTL_OFF + 320;
#define GAS __attribute__((address_space(1)))
#define LAS __attribute__((address_space(3)))
typedef unsigned short bf16;
typedef unsigned v4u __attribute__((ext_vector_type(4)));
typedef float f32x4 __attribute__((ext_vector_type(4)));
typedef short bf16x8 __attribute__((ext_vector_type(8)));
typedef GAS unsigned gu32;
typedef GAS unsigned long long gu64;
#define RLX_AGENT __ATOMIC_RELAXED, __HIP_MEMORY_SCOPE_AGENT
#define LDS_WAIT() asm volatile("s_waitcnt lgkmcnt(0)" ::: "memory")
#define VM_WAIT() asm volatile("s_waitcnt vmcnt(0)" ::: "memory")
__device__ __forceinline__ unsigned long long rt() { return __builtin_amdgcn_s_memrealtime(); }
__device__ __forceinline__ unsigned f2bf(float f) { unsigned u = __builtin_bit_cast(unsigned, f); return (u + 0x7fffu + ((u >> 16) & 1u)) >> 16; }
__device__ __forceinline__ unsigned pk2(float lo, float hi) { return f2bf(lo) | (f2bf(hi) << 16); }

#define XB_TMO      128
#define XB_XCNT(j)  (256  + 64 * (j))
#define XB_XSUB(j)  (1280 + 64 * (j))
#define XB_XGEN(j)  (2304 + 64 * (j))
#define XB_TOP      3328
#define XB_TOPGEN   3392
#define XCD_BAR_WORDS 3456
#define XB_SPIN_CAP (1u << 18)

__device__ __forceinline__ unsigned xb_ld(unsigned* p)              { return __hip_atomic_load(p, __ATOMIC_RELAXED, __HIP_MEMORY_SCOPE_AGENT); }
__device__ __forceinline__ unsigned xb_add(unsigned* p, unsigned v) { return __hip_atomic_fetch_add(p, v, __ATOMIC_RELAXED, __HIP_MEMORY_SCOPE_AGENT); }
__device__ __forceinline__ unsigned xb_xcc_id() { return (unsigned)__builtin_amdgcn_s_getreg((3 << 11) | 20) & 0xFu; }
#define XB_SPIN(cond, bar) do { unsigned _sp = 0; while (cond) { __builtin_amdgcn_s_sleep(1); \
    if ((++_sp & 255u) == 0u) { if (xb_ld(&(bar)[XB_TMO])) break; if (_sp > XB_SPIN_CAP) { atomicAdd(&(bar)[XB_TMO], 1u); break; } } } } while (0)

struct XcdBarrier {
    unsigned* bar; unsigned x;
    volatile LAS unsigned* st;
};

__device__ __forceinline__ XcdBarrier xcd_barrier_post(unsigned* bar, volatile LAS unsigned* st) {
    XcdBarrier b; b.bar = bar; b.x = xb_xcc_id(); b.st = st;
    if (threadIdx.x == 0) (void)xb_add(&bar[XB_XCNT(b.x)], 1u);
    return b;
}
__device__ __forceinline__ void xcd_barrier_complete(unsigned* bar, unsigned x, unsigned& nloc, unsigned& nx) {
    const unsigned G = gridDim.x * gridDim.y * gridDim.z;
    unsigned sum, cnt, mine, sp = 0u;
    for (;;) {
        sum = 0u; cnt = 0u; mine = 0u;
#pragma unroll
        for (unsigned j = 0; j < 16; ++j) { const unsigned c = xb_ld(&bar[XB_XCNT(j)]); sum += c; cnt += (c > 0u) ? 1u : 0u; mine = (j == x) ? c : mine; }
        if (sum == G) break;
        __builtin_amdgcn_s_sleep(1);
        if ((++sp & 255u) == 0u) { if (xb_ld(&bar[XB_TMO])) break; if (sp > XB_SPIN_CAP) { atomicAdd(&bar[XB_TMO], 1u); break; } }
    }
    nloc = mine > 0u ? mine : 1u; nx = cnt > 0u ? cnt : 1u;
}

__device__ __forceinline__ void xcd_barrier(const XcdBarrier& b) {
    asm volatile("s_waitcnt vmcnt(0)" ::: "memory");
    __syncthreads();
    if (threadIdx.x == 0) {
        unsigned* bar = b.bar;
        __builtin_amdgcn_s_waitcnt(0);
        unsigned nloc = b.st[0], nx = b.st[1];
        if (nloc == 0u) { xcd_barrier_complete(bar, b.x, nloc, nx); b.st[0] = nloc; b.st[1] = nx; }
        const unsigned old = xb_add(&bar[XB_XSUB(b.x)], 1u);
        const unsigned gen = old / nloc;
        if (old + 1u == (gen + 1u) * nloc) {
            __builtin_amdgcn_fence(__ATOMIC_RELEASE, "agent");
            asm volatile("s_waitcnt vmcnt(0)" ::: "memory");
            const unsigned og = xb_add(&bar[XB_TOP], 1u);
            const unsigned tg = og / nx;
            if (og + 1u == (tg + 1u) * nx) xb_add(&bar[XB_TOPGEN], 1u);
            else XB_SPIN(xb_ld(&bar[XB_TOPGEN]) == tg, bar);
            __builtin_amdgcn_fence(__ATOMIC_ACQUIRE, "agent");
            xb_add(&bar[XB_XGEN(b.x)], 1u);
            asm volatile("s_waitcnt vmcnt(0)" ::: "memory");
        } else {
            XB_SPIN(xb_ld(&bar[XB_XGEN(b.x)]) == gen, bar);
            __builtin_amdgcn_fence(__ATOMIC_ACQUIRE, "agent");
            asm volatile("s_waitcnt vmcnt(0)" ::: "memory");
        }
    }
    __syncthreads();
}

typedef unsigned v2u __attribute__((ext_vector_type(2)));
typedef float f32x16 __attribute__((ext_vector_type(16)));
using pg8::cvtpk; using pg8::bflo; using pg8::bfhi;
__device__ __forceinline__ float bf2f(unsigned short b) { return __builtin_bit_cast(float, (unsigned)b << 16); }
__device__ __forceinline__ float wave_sum(float v) {
#pragma unroll
    for (int o = 1; o < 64; o <<= 1) v += __shfl_xor(v, o);
    return v;
}
__device__ __forceinline__ bf16x8 pack8(f32x4 a, f32x4 b) {
    v4u w; w.x = cvtpk(a[0], a[1]); w.y = cvtpk(a[2], a[3]); w.z = cvtpk(b[0], b[1]); w.w = cvtpk(b[2], b[3]);
    return __builtin_bit_cast(bf16x8, w);
}
__device__ __forceinline__ float siluf(float y) { return y * __builtin_amdgcn_rcpf(1.0f + __expf(-y)); }

struct DnfMap { unsigned char* a; unsigned char* b; __device__ __forceinline__ unsigned char* rec(int chunk) const { return chunk < DNF_SPLIT ? a + (size_t)chunk * CH_BYTES : b + (size_t)(chunk - DNF_SPLIT) * CH_BYTES; } };
template <int MODE> __device__ __forceinline__ int colmap(int nr_in) {
    int nr = nr_in;
    if (MODE == 0) return nr;
    if (MODE == 2) nr += 38 * 256;
    if (nr < 3072) return nr;
    if (nr < 4096) return nr + 12;
    if (nr < 4608) return nr + 268;
    if (nr < 4620) return nr - 4608 + 3072;
    if (nr < 4864) return -1;
    if (nr < 11008) return nr + 12;
    return nr - 11008 + 4108;
}
template <int MODE> __device__ __forceinline__ void tr_load(const float* W, int N, int item, int nblk, int lane, f32x4 (&v)[8]) {
    const int kb = item / nblk, nb = item % nblk, n4 = lane & 7, g = lane >> 3;
    const int kk0 = 64 * kb + 8 * g, n = 32 * nb + 4 * n4;
    const int src = colmap<MODE>(n); const int srcc = src < 0 ? 0 : src;
    const GAS f32x4* p = (const GAS f32x4*)(W + (size_t)kk0 * N + srcc);
#pragma unroll
    for (int i = 0; i < 8; ++i) v[i] = __builtin_nontemporal_load(p + (size_t)i * (N / 4));
}
template <int MODE> __device__ __forceinline__ void tr_store(const float* kscale, bf16* WT, int ldt, int item, int nblk, int lane, f32x4 (&v)[8]) {
    const int kb = item / nblk, nb = item % nblk, n4 = lane & 7, g = lane >> 3;
    const int kk0 = 64 * kb + 8 * g, n = 32 * nb + 4 * n4;
    if (colmap<MODE>(n) < 0) {
#pragma unroll
        for (int i = 0; i < 8; ++i) v[i] = (f32x4){0.f, 0.f, 0.f, 0.f}; }
    if (kscale) { const f32x4 s0 = *(const GAS f32x4*)(kscale + kk0), s1 = *(const GAS f32x4*)(kscale + kk0 + 4);
        v[0] = v[0] * s0.x; v[1] = v[1] * s0.y; v[2] = v[2] * s0.z; v[3] = v[3] * s0.w; v[4] = v[4] * s1.x; v[5] = v[5] * s1.y; v[6] = v[6] * s1.z; v[7] = v[7] * s1.w; }
#pragma unroll
    for (int e = 0; e < 4; ++e) { v4u o; o.x = cvtpk(v[0][e], v[1][e]); o.y = cvtpk(v[2][e], v[3][e]); o.z = cvtpk(v[4][e], v[5][e]); o.w = cvtpk(v[6][e], v[7][e]);
        *(GAS v4u*)(WT + (size_t)(n + e) * ldt + kk0) = o; }
}
template <int MODE> __device__ __forceinline__ void transpose_matrix(const float* W, int K, int N, const float* kscale, bf16* WT, int ldt, int nrows, int gw, int NGW, int lane) {
    const int nblk = nrows / 32, nitems = (K / 64) * nblk;
    for (int it = gw; it < nitems; it += 4 * NGW) {
        f32x4 va[8], vb[8], vc[8], vd[8]; const int it2 = it + NGW, it3 = it + 2 * NGW, it4 = it + 3 * NGW;
        tr_load<MODE>(W, N, it, nblk, lane, va);
        if (it2 < nitems) tr_load<MODE>(W, N, it2, nblk, lane, vb);
        if (it3 < nitems) tr_load<MODE>(W, N, it3, nblk, lane, vc);
        if (it4 < nitems) tr_load<MODE>(W, N, it4, nblk, lane, vd);
        tr_store<MODE>(kscale, WT, ldt, it, nblk, lane, va);
        if (it2 < nitems) tr_store<MODE>(kscale, WT, ldt, it2, nblk, lane, vb);
        if (it3 < nitems) tr_store<MODE>(kscale, WT, ldt, it3, nblk, lane, vc);
        if (it4 < nitems) tr_store<MODE>(kscale, WT, ldt, it4, nblk, lane, vd);
    }
}
__device__ __forceinline__ void rms_load(const float* xrow, int lane, f32x4 (&v)[8]) {
    const GAS f32x4* xr = (const GAS f32x4*)xrow + lane;
#pragma unroll
    for (int j = 0; j < 8; ++j) v[j] = xr[64 * j];
}
__device__ __forceinline__ void rms_finish(const float* w, bf16* orow, int lane, f32x4 (&v)[8]) {
    const GAS f32x4* wr = (const GAS f32x4*)w + lane; float s = 0.f;
#pragma unroll
    for (int j = 0; j < 8; ++j) s += (v[j].x * v[j].x + v[j].y * v[j].y) + (v[j].z * v[j].z + v[j].w * v[j].w);
    const float rstd = 1.0f / sqrtf(wave_sum(s) * (1.0f / DM) + EPS);
    GAS v2u* o8 = (GAS v2u*)orow + lane;
#pragma unroll
    for (int j = 0; j < 8; ++j) { const f32x4 ww = wr[64 * j]; v2u o; o.x = cvtpk(v[j].x * rstd * ww.x, v[j].y * rstd * ww.y); o.y = cvtpk(v[j].z * rstd * ww.z, v[j].w * rstd * ww.w); o8[64 * j] = o; }
}

__device__ __forceinline__ void normfrag_item(const bf16* src, int ld, int row0, int col0, const float* wt, float scale, unsigned char* dst, int lane) {
    const int r = lane & 31, h = lane >> 5;
    const bf16* rp = src + (size_t)(row0 + r) * ld + col0 + 8 * h;
    v4u raw[8]; f32x4 w0[8], w1[8]; float ss = 0.f;
#pragma unroll
    for (int s = 0; s < 8; ++s) { raw[s] = *(const GAS v4u*)(rp + 16 * s); w0[s] = *(const GAS f32x4*)(wt + 16 * s + 8 * h); w1[s] = *(const GAS f32x4*)(wt + 16 * s + 8 * h + 4); }
    __builtin_amdgcn_sched_barrier(0);
#pragma unroll
    for (int s = 0; s < 8; ++s) {
        const float a0 = bflo(raw[s].x), a1 = bfhi(raw[s].x), a2 = bflo(raw[s].y), a3 = bfhi(raw[s].y), a4 = bflo(raw[s].z), a5 = bfhi(raw[s].z), a6 = bflo(raw[s].w), a7 = bfhi(raw[s].w);
        ss += (a0 * a0 + a1 * a1) + (a2 * a2 + a3 * a3) + (a4 * a4 + a5 * a5) + (a6 * a6 + a7 * a7); }
    ss += __shfl_xor(ss, 32);
    const float rstd = scale / sqrtf(ss * (1.0f / 128.0f) + EPS);
#pragma unroll
    for (int s = 0; s < 8; ++s) {
        v4u o; o.x = cvtpk(bflo(raw[s].x) * rstd * w0[s].x, bfhi(raw[s].x) * rstd * w0[s].y); o.y = cvtpk(bflo(raw[s].y) * rstd * w0[s].z, bfhi(raw[s].y) * rstd * w0[s].w);
        o.z = cvtpk(bflo(raw[s].z) * rstd * w1[s].x, bfhi(raw[s].z) * rstd * w1[s].y); o.w = cvtpk(bflo(raw[s].w) * rstd * w1[s].z, bfhi(raw[s].w) * rstd * w1[s].w);
        *(GAS v4u*)(dst + (size_t)(s * 64 + lane) * 16) = o; }
}

constexpr int DP_LD = 132, DP_LL = 68;
constexpr int DP_Q = 0, DP_K = 64 * DP_LD, DP_V = 2 * 64 * DP_LD, DP_L = 3 * 64 * DP_LD, DP_S = DP_L + 64 * DP_LL;
struct DnIn { const bf16* proj; const float* convw; const float* alog; const float* dtb; DnfMap dnf; float* gc; unsigned char* lg; unsigned char* rhs; };

__device__ __forceinline__ void dn_conv_issue(const DnIn& I, int chunk, int tid, unsigned (&uraw)[35]) {
    if (tid < 384) {
        const int b = chunk / 192, h = (chunk / 32) % 6, n = chunk & 31;
        const int ch2 = tid % 192, tg = tid / 192, which = ch2 >> 6, cp = ch2 & 63;
        const int gcol = which * 768 + h * 128 + 2 * cp;
        const int p0 = 64 * n + 32 * tg - 3;
        const bf16* src = I.proj + ((long)(b * SEQ + p0) * LDP + gcol);
#pragma unroll
        for (int i = 0; i < 35; ++i) { const int ic = (p0 + i >= 0) ? i : -p0;
            uraw[i] = *(const GAS unsigned*)(src + (long)ic * LDP); }
    }
}
__device__ __forceinline__ void dn_prep_chunk(const DnIn& I, LAS float* L, int chunk, int next_chunk, int tid_in, unsigned (&uraw)[35]) {
    int tz; asm volatile("v_mov_b32 %0, 0" : "=v"(tz));
    const int tid = tid_in + tz;
    const int lane = tid & 63, wave = __builtin_amdgcn_readfirstlane(tid >> 6);
    const int b = chunk / 192, h = (chunk / 32) % 6, n = chunk & 31;
    const int t0 = b * SEQ + 64 * n;
    LAS float* QS = L + DP_Q; LAS float* KS = L + DP_K; LAS float* VS = L + DP_V; LAS float* LM = L + DP_L;
    LAS float* sb = L + DP_S; LAS float* sG = sb + 64; LAS float* seG = sb + 128; LAS float* srq = sb + 192; LAS float* srk = sb + 256;
    unsigned char* rec = I.dnf.rec(chunk);
    unsigned short zraw[4][4];
    { const int c = lane & 15, q = lane >> 4;
#pragma unroll
      for (int f = 0; f < 4; ++f) { const int fi = wave * 4 + f, sl = fi >> 2, mt = fi & 3;
#pragma unroll
          for (int r = 0; r < 4; ++r) zraw[f][r] = I.proj[(size_t)(t0 + 16 * mt + 4 * q + r) * LDP + PC_DNZ + h * 128 + 16 * sl + c]; } }
    if (tid < 384) {
        const int ch2 = tid % 192, tg = tid / 192, which = ch2 >> 6, cp = ch2 & 63;
        const int gcol = which * 768 + h * 128 + 2 * cp;
        float w0[4], w1[4];
#pragma unroll
        for (int k = 0; k < 4; ++k) { w0[k] = I.convw[k * 2304 + gcol]; w1[k] = I.convw[k * 2304 + gcol + 1]; }
        const int p0 = 64 * n + 32 * tg - 3;
        float xa[35], xb[35];
#pragma unroll
        for (int i = 0; i < 35; ++i) { unsigned u = uraw[i]; if (p0 + i < 0) u = 0u; xa[i] = bflo(u); xb[i] = bfhi(u); }
        if (next_chunk < NCHUNK) dn_conv_issue(I, next_chunk, tid, uraw);
        LAS float* dst = L + which * 64 * DP_LD + (32 * tg) * DP_LD + 2 * cp;
#pragma unroll
        for (int j = 0; j < 32; ++j) {
            const float ya = (w0[0] * xa[j] + w0[1] * xa[j + 1]) + (w0[2] * xa[j + 2] + w0[3] * xa[j + 3]);
            const float yb = (w1[0] * xb[j] + w1[1] * xb[j + 1]) + (w1[2] * xb[j + 2] + w1[3] * xb[j + 3]);
            dst[j * DP_LD] = siluf(ya); dst[j * DP_LD + 1] = siluf(yb); if ((j & 7) == 7) asm volatile("" ::: "memory"); }
    } else if (tid >= 448) {
        const int i = lane;
        const bf16* pr = I.proj + (size_t)(t0 + i) * LDP + PC_BA;
        const float bb = bf2f(pr[h]), aa = bf2f(pr[6 + h]);
        const float beta = 1.0f / (1.0f + __expf(-bb));
        const float xx = aa + I.dtb[h];
        const float sp = xx > 20.f ? xx : log1pf(__expf(xx));
        float g = -__expf(I.alog[h]) * sp;
#pragma unroll
        for (int o = 1; o < 64; o <<= 1) { const float t = __shfl_up(g, o); if (lane >= o) g += t; }
        sb[i] = beta; sG[i] = g; seG[i] = __expf(g);
        if (i == 63) I.gc[chunk] = __expf(g);
    }
    __syncthreads();
    {
        const int row = tid >> 2, part = tid & 3, which = row >> 6, i = row & 63;
        const LAS float* p = L + which * 64 * DP_LD + i * DP_LD + 32 * part;
        float ss = 0.f;
#pragma unroll
        for (int k = 0; k < 8; ++k) { const f32x4 v = *(const LAS f32x4*)(p + 4 * k); ss += (v.x * v.x + v.y * v.y) + (v.z * v.z + v.w * v.w); }
        ss += __shfl_xor(ss, 1); ss += __shfl_xor(ss, 2);
        if (part == 0) { if (which == 0) srq[i] = 0.08838834764831845f / sqrtf(ss + EPS); else srk[i] = 1.0f / sqrtf(ss + EPS); }
    }
    __syncthreads();
    for (int e = tid; e < 2 * 64 * 64; e += 512) {
        const int which = e >> 12, i = (e >> 6) & 63, c2 = e & 63;
        LAS float* p = L + which * 64 * DP_LD + i * DP_LD + 2 * c2; const float sc = which ? srk[i] : srq[i];
        p[0] *= sc; p[1] *= sc; }
    __syncthreads();
    {
        const int it = wave & 3, c = lane & 15, q = lane >> 4; const bool isP = wave >= 4;
        const LAS float* X = isP ? QS : KS;
        bf16x8 bfr[4];
#pragma unroll
        for (int s = 0; s < 4; ++s) { const LAS float* p = X + (16 * it + c) * DP_LD + 32 * s + 8 * q; bfr[s] = pack8(*(const LAS f32x4*)p, *(const LAS f32x4*)(p + 4)); }
        f32x4 ct[4];
#pragma unroll
        for (int jt = 0; jt < 4; ++jt) { ct[jt] = (f32x4){0.f, 0.f, 0.f, 0.f};
            if (jt <= it) {
#pragma unroll
                for (int s = 0; s < 4; ++s) { const LAS float* p = KS + (16 * jt + c) * DP_LD + 32 * s + 8 * q; const bf16x8 af = pack8(*(const LAS f32x4*)p, *(const LAS f32x4*)(p + 4));
                    ct[jt] = __builtin_amdgcn_mfma_f32_16x16x32_bf16(af, bfr[s], ct[jt], 0, 0, 0); } } }
        const int i = 16 * it + c; const float Gi = sG[i], bi = sb[i];
        if (!isP) {
#pragma unroll
            for (int jt = 0; jt < 4; ++jt) if (jt <= it) { f32x4 o;
#pragma unroll
                for (int r = 0; r < 4; ++r) { const int j = 16 * jt + 4 * q + r; o[r] = (i > j) ? bi * ct[jt][r] * __expf(Gi - sG[j]) : 0.f; }
                const int j4 = 4 * jt + q, a = (i - 1) >> 2, bb = (i - 1) & 3;
                if (i >= 1 && j4 <= a) *(LAS f32x4*)(LM + 4 * ((a + 1) * (2 * a + bb) + j4)) = o; }
        } else {
#pragma unroll
            for (int s = 0; s < 2; ++s) { f32x4 lo, hi;
#pragma unroll
                for (int r = 0; r < 4; ++r) { const int j0 = 32 * s + 4 * q + r, j1 = j0 + 16;
                    lo[r] = (i >= j0) ? ct[2 * s][r] * __expf(Gi - sG[j0]) : 0.f; hi[r] = (i >= j1) ? ct[2 * s + 1][r] * __expf(Gi - sG[j1]) : 0.f; }
                *(GAS bf16x8*)(rec + CH_P + (size_t)((it * 2 + s) * 64 + lane) * 16) = pack8(lo, hi); }
        }
    }
    __syncthreads();
    {
        const int c = lane & 15, q = lane >> 4; const float G63 = sG[63];
#pragma unroll
        for (int f = 0; f < 2; ++f) { const int fi = wave * 2 + f, mt = fi >> 2, s = fi & 3;
            const int i = 16 * mt + c; const float e = seG[i]; const LAS float* p = QS + i * DP_LD + 32 * s + 4 * q;
            const f32x4 lo = *(const LAS f32x4*)p * e, hi = *(const LAS f32x4*)(p + 16) * e;
            *(GAS bf16x8*)(rec + CH_QG + (size_t)(fi * 64 + lane) * 16) = pack8(lo, hi); }
#pragma unroll
        for (int f = 0; f < 2; ++f) { const int fi = wave * 2 + f, mt = fi >> 1, s = fi & 1;
            const int dk = 16 * mt + c; f32x4 lo, hi;
#pragma unroll
            for (int r = 0; r < 4; ++r) { const int p0 = 32 * s + 4 * q + r, p1 = p0 + 16; lo[r] = KS[p0 * DP_LD + dk] * __expf(G63 - sG[p0]); hi[r] = KS[p1 * DP_LD + dk] * __expf(G63 - sG[p1]); }
            *(GAS bf16x8*)(rec + CH_KD + (size_t)(fi * 64 + lane) * 16) = pack8(lo, hi); }
    }
    {
        for (int t = tid; t < 528; t += 512) *(GAS f32x4*)(I.lg + (size_t)chunk * 8448 + (size_t)t * 16) = *(const LAS f32x4*)(LM + 4 * t);
#pragma unroll
        for (int e = 0; e < 4; ++e) { const int gi = tid + 512 * e, i = gi >> 5, c8 = (gi & 31) * 8;
            const bool isk = c8 >= 128; const LAS float* p = (isk ? KS : VS) + i * DP_LD + (c8 & 127);
            const float sc = sb[i] * (isk ? seG[i] : 1.0f);
            const f32x4 a = *(const LAS f32x4*)p * sc, bq = *(const LAS f32x4*)(p + 4) * sc;
            *(GAS bf16x8*)(I.rhs + ((size_t)chunk * 64 + i) * 512 + c8 * 2) = pack8(a, bq); }
        const int c = lane & 15, q = lane >> 4;
#pragma unroll
        for (int f = 0; f < 4; ++f) { const int fi = wave * 4 + f, sl = fi >> 2, mt = fi & 3;
            v2u zo; float zz[4];
#pragma unroll
            for (int r = 0; r < 4; ++r) zz[r] = siluf(bf2f(zraw[f][r]));
            zo.x = cvtpk(zz[0], zz[1]); zo.y = cvtpk(zz[2], zz[3]);
            *(GAS v2u*)(rec + CH_ZG + (size_t)(fi * 64 + lane) * 8) = zo; }
    }
    __syncthreads();
}

__device__ __forceinline__ void dn_solve_item(const unsigned char* lg, const unsigned char* rhs, const DnfMap& dnf, LAS float* Lw, int item, int lane) {
    const int chunk = item >> 2, g = item & 3;
    const unsigned char* lsrc = lg + (size_t)chunk * 8448;
#pragma unroll
    for (int k = 0; k < 9; ++k) { const int t = lane + 64 * k; const int tc = t < 528 ? t : 527; const f32x4 v = *(const GAS f32x4*)(lsrc + (size_t)tc * 16); if (t < 528) *(LAS f32x4*)(Lw + 4 * t) = v; }
    const bf16* rp = (const bf16*)(rhs + (size_t)chunk * 64 * 512) + 64 * g + lane;
    float X[64];
    unsigned short xr[64];
#pragma unroll
    for (int i = 0; i < 64; ++i) xr[i] = rp[i * 256];
    __builtin_amdgcn_sched_barrier(0);
#pragma unroll
    for (int i = 0; i < 64; ++i) X[i] = bf2f(xr[i]);
    asm volatile("s_waitcnt vmcnt(0) lgkmcnt(0)" ::: "memory");
    int vz; asm volatile("v_mov_b32 %0, 0" : "=v"(vz));
    const LAS float* LMv = Lw + vz;
    f32x4 ring[8];
#pragma unroll
    for (int t = 0; t < 8; ++t) ring[t] = *(const LAS f32x4*)(LMv + 4 * t);
    int t = 0;
#pragma unroll
    for (int i = 1; i < 64; ++i) {
        float acc = X[i];
#pragma unroll
        for (int j4 = 0; j4 < (i + 3) / 4; ++j4) { const f32x4 l = ring[t & 7];
            if (t + 8 < 528) ring[t & 7] = *(const LAS f32x4*)(LMv + 4 * (t + 8));
#pragma unroll
            for (int jj = 0; jj < 4; ++jj) { const int j = 4 * j4 + jj; if (j < i) acc -= l[jj] * X[j]; }
            ++t; }
        X[i] = acc; asm volatile("" ::: "memory"); }
    unsigned char* rec = dnf.rec(chunk);
    if (g < 2) {
        const int dv = 64 * g + lane, sl = dv >> 4, c = dv & 15;
        bf16* base = (bf16*)(rec + CH_U) + (size_t)(sl * 4) * 256 + c * 4;
#pragma unroll
        for (int i = 0; i < 64; ++i) base[(i >> 4) * 256 + ((i & 15) >> 2) * 64 + (i & 3)] = (bf16)(cvtpk(X[i], 0.f) & 0xffffu);
    } else {
        const int dk = 64 * (g - 2) + lane, s = dk >> 5, o = dk & 31, qq = (o & 15) >> 2, j = ((o >> 4) << 2) + (o & 3);
        bf16* base = (bf16*)(rec + CH_W) + (size_t)s * 512 + qq * 128 + j;
#pragma unroll
        for (int i = 0; i < 64; ++i) base[(i >> 4) * 2048 + (i & 15) * 8] = (bf16)(cvtpk(-X[i], 0.f) & 0xffffu);
    }
}

constexpr int SC_BUF = 57344, SC_RED = 2 * SC_BUF, SC_RS = SC_RED + 2048;
#define LDS_BAR() do { asm volatile("s_waitcnt lgkmcnt(0)" ::: "memory"); __builtin_amdgcn_s_barrier(); asm volatile("" ::: "memory"); } while (0)
template <int CTRL> __device__ __forceinline__ float dpp_t(float v) { return __builtin_bit_cast(float, __builtin_amdgcn_update_dpp(0, __builtin_bit_cast(int, v), CTRL, 0xf, 0xf, true)); }
#define dpp_f(v, ctrl) dpp_t<ctrl>(v)
__device__ __forceinline__ float row16_sum(float v) { v += dpp_t<0xB1>(v); v += dpp_t<0x4E>(v); v += dpp_t<0x141>(v); v += dpp_t<0x140>(v); return v; }
__device__ __forceinline__ f32x4 row16_sum4(f32x4 v) {
    float a = v[0], b = v[1], c = v[2], d = v[3];
    asm volatile("s_nop 1\n\t"
        "v_add_f32_dpp %0, %0, %0 quad_perm:[1,0,3,2] row_mask:0xf bank_mask:0xf\n\tv_add_f32_dpp %1, %1, %1 quad_perm:[1,0,3,2] row_mask:0xf bank_mask:0xf\n\t"
        "v_add_f32_dpp %2, %2, %2 quad_perm:[1,0,3,2] row_mask:0xf bank_mask:0xf\n\tv_add_f32_dpp %3, %3, %3 quad_perm:[1,0,3,2] row_mask:0xf bank_mask:0xf\n\t"
        "v_add_f32_dpp %0, %0, %0 quad_perm:[2,3,0,1] row_mask:0xf bank_mask:0xf\n\tv_add_f32_dpp %1, %1, %1 quad_perm:[2,3,0,1] row_mask:0xf bank_mask:0xf\n\t"
        "v_add_f32_dpp %2, %2, %2 quad_perm:[2,3,0,1] row_mask:0xf bank_mask:0xf\n\tv_add_f32_dpp %3, %3, %3 quad_perm:[2,3,0,1] row_mask:0xf bank_mask:0xf\n\t"
        "v_add_f32_dpp %0, %0, %0 row_half_mirror row_mask:0xf bank_mask:0xf\n\tv_add_f32_dpp %1, %1, %1 row_half_mirror row_mask:0xf bank_mask:0xf\n\t"
        "v_add_f32_dpp %2, %2, %2 row_half_mirror row_mask:0xf bank_mask:0xf\n\tv_add_f32_dpp %3, %3, %3 row_half_mirror row_mask:0xf bank_mask:0xf\n\t"
        "v_add_f32_dpp %0, %0, %0 row_mirror row_mask:0xf bank_mask:0xf\n\tv_add_f32_dpp %1, %1, %1 row_mirror row_mask:0xf bank_mask:0xf\n\t"
        "v_add_f32_dpp %2, %2, %2 row_mirror row_mask:0xf bank_mask:0xf\n\tv_add_f32_dpp %3, %3, %3 row_mirror row_mask:0xf bank_mask:0xf\n\ts_nop 1"
        : "+v"(a), "+v"(b), "+v"(c), "+v"(d));
    return (f32x4){a, b, c, d};
}
struct ScanIn { DnfMap dnf; const float* gc; const float* onw; bf16* odn; int popt; };
__device__ __forceinline__ void dn_scan(const ScanIn& I, LAS unsigned char* lds, int bh, int tid) {
    const int lane = tid & 63, sl = __builtin_amdgcn_readfirstlane(tid >> 6), c = lane & 15, q = lane >> 4;
    const int b = bh / 6, h = bh % 6;
    const unsigned char* rec0 = I.dnf.rec(bh * 32);
    LAS float* red = (LAS float*)(lds + SC_RED); LAS float* rsv = (LAS float*)(lds + SC_RS);
    const float onw = I.onw[16 * sl + c];
    const float gc_all = I.gc[bh * 32 + (lane & 31)];
    f32x4 S[8];
#pragma unroll
    for (int i = 0; i < 8; ++i) S[i] = (f32x4){0.f, 0.f, 0.f, 0.f};
    v2u Ucur[4], Zcur[4], Unxt[4], Znxt[4];
#pragma unroll
    for (int i = 0; i < 7; ++i) __builtin_amdgcn_global_load_lds((const unsigned*)(rec0 + (size_t)(sl * 7 + i) * 1024 + lane * 16), (LAS unsigned*)(lds + (sl * 7 + i) * 1024), 16, 0, 0);
#pragma unroll
    for (int mt = 0; mt < 4; ++mt) { Unxt[mt] = *(const GAS v2u*)(rec0 + CH_U + (size_t)((sl * 4 + mt) * 64 + lane) * 8); Znxt[mt] = *(const GAS v2u*)(rec0 + CH_ZG + (size_t)((sl * 4 + mt) * 64 + lane) * 8); }
    for (int n = 0; n < 32; ++n) {
        VM_WAIT(); __syncthreads();
#pragma unroll
        for (int mt = 0; mt < 4; ++mt) { Ucur[mt] = Unxt[mt]; Zcur[mt] = Znxt[mt]; }
        const float gcv = __builtin_bit_cast(float, __builtin_amdgcn_readlane(__builtin_bit_cast(int, gc_all), n));
        if (n + 1 < 32) {
            const unsigned char* rec = rec0 + (size_t)(n + 1) * CH_BYTES; LAS unsigned char* dstb = lds + ((n + 1) & 1) * SC_BUF;
#pragma unroll
            for (int i = 0; i < 7; ++i) __builtin_amdgcn_global_load_lds((const unsigned*)(rec + (size_t)(sl * 7 + i) * 1024 + lane * 16), (LAS unsigned*)(dstb + (sl * 7 + i) * 1024), 16, 0, 0);
#pragma unroll
            for (int mt = 0; mt < 4; ++mt) { Unxt[mt] = *(const GAS v2u*)(rec + CH_U + (size_t)((sl * 4 + mt) * 64 + lane) * 8); Znxt[mt] = *(const GAS v2u*)(rec + CH_ZG + (size_t)((sl * 4 + mt) * 64 + lane) * 8); }
        }
        const LAS unsigned char* fb = lds + (n & 1) * SC_BUF + lane * 16;
        bf16x8 Sb[4];
#pragma unroll
        for (int s = 0; s < 4; ++s) Sb[s] = pack8(S[2 * s], S[2 * s + 1]);
        f32x4 d[4], o[4];
#pragma unroll
        for (int mt = 0; mt < 4; ++mt) { d[mt] = (f32x4){bflo(Ucur[mt].x), bfhi(Ucur[mt].x), bflo(Ucur[mt].y), bfhi(Ucur[mt].y)}; o[mt] = (f32x4){0.f, 0.f, 0.f, 0.f}; }
#pragma unroll
        for (int mt = 0; mt < 4; ++mt)
#pragma unroll
            for (int s = 0; s < 4; ++s) {
                d[mt] = __builtin_amdgcn_mfma_f32_16x16x32_bf16(*(const LAS bf16x8*)(fb + CH_W + (mt * 4 + s) * 1024), Sb[s], d[mt], 0, 0, 0);
                o[mt] = __builtin_amdgcn_mfma_f32_16x16x32_bf16(*(const LAS bf16x8*)(fb + CH_QG + (mt * 4 + s) * 1024), Sb[s], o[mt], 0, 0, 0); }
        bf16x8 Db[2];
#pragma unroll
        for (int s = 0; s < 2; ++s) Db[s] = pack8(d[2 * s], d[2 * s + 1]);
#pragma unroll
        for (int mt = 0; mt < 4; ++mt)
#pragma unroll
            for (int s = 0; s < 2; ++s) o[mt] = __builtin_amdgcn_mfma_f32_16x16x32_bf16(*(const LAS bf16x8*)(fb + CH_P + (mt * 2 + s) * 1024), Db[s], o[mt], 0, 0, 0);
#pragma unroll
        for (int mt = 0; mt < 8; ++mt) { S[mt] = S[mt] * gcv;
#pragma unroll
            for (int s = 0; s < 2; ++s) S[mt] = __builtin_amdgcn_mfma_f32_16x16x32_bf16(*(const LAS bf16x8*)(fb + CH_KD + (mt * 2 + s) * 1024), Db[s], S[mt], 0, 0, 0); }
#pragma unroll
        for (int mt = 0; mt < 4; ++mt) { f32x4 ss = o[mt] * o[mt];
            ss = row16_sum4(ss);
            if (c == 0) *(LAS f32x4*)(red + sl * 64 + 16 * mt + 4 * q) = ss; }
        LDS_BAR();
        { const int pos = 8 * sl + (lane >> 3); float v = red[(lane & 7) * 64 + pos]; v += dpp_f(v, 0xB1); v += dpp_f(v, 0x4E); v += dpp_f(v, 0x141);
          if ((lane & 7) == 0) rsv[pos] = 1.0f / sqrtf(v * (1.0f / 128.0f) + EPS); }
        LDS_BAR();
        bf16* orow = I.odn + (size_t)(b * SEQ + 64 * n) * 768 + h * 128 + 16 * sl + c;
#pragma unroll
        for (int mt = 0; mt < 4; ++mt) { const f32x4 r4 = *(const LAS f32x4*)(rsv + 16 * mt + 4 * q);
            const f32x4 z4 = (f32x4){bflo(Zcur[mt].x), bfhi(Zcur[mt].x), bflo(Zcur[mt].y), bfhi(Zcur[mt].y)};
#pragma unroll
            for (int r = 0; r < 4; ++r) { const float v = o[mt][r] * r4[r] * onw * z4[r]; orow[(size_t)(16 * mt + 4 * q + r) * 768] = (bf16)(cvtpk(v, 0.f) & 0xffffu); } }
    }
    VM_WAIT(); __syncthreads();
}

__constant__ unsigned char T5_BUCKET[128] = {0,1,2,3,4,5,6,7,8,9,10,11,12,13,14,15,16,16,16,17,17,18,18,18,19,19,19,20,20,20,20,21,21,21,21,22,22,22,22,22,23,23,23,23,23,23,24,24,24,24,24,24,25,25,25,25,25,25,25,26,26,26,26,26,26,26,26,27,27,27,27,27,27,27,27,27,27,28,28,28,28,28,28,28,28,28,28,29,29,29,29,29,29,29,29,29,29,29,29,30,30,30,30,30,30,30,30,30,30,30,30,30,30,31,31,31,31,31,31,31,31,31,31,31,31,31,31,31};
struct AttnIn { const unsigned char *qf, *kf, *vt, *mqf, *mkf, *mvt; bf16 *oswa, *omem; const float* sinks; };
__device__ __forceinline__ float ex2(float v) { return __builtin_amdgcn_exp2f(v); }

__device__ __forceinline__ void ld8(const unsigned char* p, bf16x8 (&f)[8]) {
#pragma unroll
    for (int s = 0; s < 8; ++s) f[s] = *(const GAS bf16x8*)(p + s * 1024);
}
__device__ __forceinline__ bf16x8 pfrag(const f32x16& S, int s) { return pack8((f32x4){S[8 * s], S[8 * s + 1], S[8 * s + 2], S[8 * s + 3]}, (f32x4){S[8 * s + 4], S[8 * s + 5], S[8 * s + 6], S[8 * s + 7]}); }

__device__ __forceinline__ void swa_item(const AttnIn& I, const LAS float* biasT, int item, int lane) {
    const int qt = item & 63, hq = (item >> 6) % 6, b = item / 384, kvh = hq / 3;
    const int r32 = lane & 31, hh = lane >> 5;
    const unsigned char* kbase = I.kf + ((size_t)((b * 2 + kvh) * 64) * 8) * 1024 + lane * 16;
    const unsigned char* vbase = I.vt + ((size_t)((b * 2 + kvh) * 64) * 8) * 1024 + lane * 16;
#define KT(i) ((qt - 4 + (i)) < 0 ? 0 : (qt - 4 + (i)))
    bf16x8 qfr[8], ka[8], kb[8];
    ld8(I.qf + ((size_t)((b * 6 + hq) * 64 + qt) * 8) * 1024 + lane * 16, qfr);
    ld8(kbase + (size_t)KT(0) * 8192, ka);
    f32x16 S[5];
#pragma unroll
    for (int i = 0; i < 5; ++i) {
#pragma unroll
        for (int r = 0; r < 16; ++r) S[i][r] = 0.f;
        if (i & 1) { if (i + 1 < 5) ld8(kbase + (size_t)KT(i + 1) * 8192, ka); else ld8(vbase + (size_t)KT(0) * 8192, ka);
#pragma unroll
            for (int s = 0; s < 8; ++s) S[i] = __builtin_amdgcn_mfma_f32_32x32x16_bf16(kb[s], qfr[s], S[i], 0, 0, 0);
        } else { if (i + 1 < 5) ld8(kbase + (size_t)KT(i + 1) * 8192, kb); else ld8(vbase + (size_t)KT(0) * 8192, kb);
#pragma unroll
            for (int s = 0; s < 8; ++s) S[i] = __builtin_amdgcn_mfma_f32_32x32x16_bf16(ka[s], qfr[s], S[i], 0, 0, 0);
        }
    }
    const float sink2 = I.sinks[hq] * LOG2E; const LAS float* bt = biasT + hq * 128;
    float m = sink2;
#pragma unroll
    for (int i = 0; i < 5; ++i) {
#pragma unroll
        for (int r = 0; r < 16; ++r) { const int koff = (r & 3) + 8 * (r >> 2) + 4 * hh; const int dist = 32 * (4 - i) + r32 - koff;
            const bool valid = (qt - 4 + i >= 0) && (dist >= 0) && (dist < 128);
            const float v = valid ? S[i][r] + bt[dist & 127] : -INFINITY; S[i][r] = v; m = fmaxf(m, v); } }
    m = fmaxf(m, __shfl_xor(m, 32));
    float l = 0.f;
#pragma unroll
    for (int i = 0; i < 5; ++i)
#pragma unroll
        for (int r = 0; r < 16; ++r) { const float p = ex2(S[i][r] - m); S[i][r] = p; l += p; }
    l += __shfl_xor(l, 32); l += ex2(sink2 - m);
    f32x16 O[4];
#pragma unroll
    for (int dt = 0; dt < 4; ++dt)
#pragma unroll
        for (int r = 0; r < 16; ++r) O[dt][r] = 0.f;
#pragma unroll
    for (int i = 0; i < 5; ++i) {
        if (i + 1 < 5) { if (i & 1) ld8(vbase + (size_t)KT(i + 1) * 8192, kb); else ld8(vbase + (size_t)KT(i + 1) * 8192, ka); }
#pragma unroll
        for (int s = 0; s < 2; ++s) { const bf16x8 pf = pfrag(S[i], s);
#pragma unroll
            for (int dt = 0; dt < 4; ++dt) O[dt] = __builtin_amdgcn_mfma_f32_32x32x16_bf16((i & 1) ? ka[s * 4 + dt] : kb[s * 4 + dt], pf, O[dt], 0, 0, 0); }
    }
#undef KT
    const float inv = 1.0f / l;
    bf16* orow = I.oswa + (size_t)(b * SEQ + 32 * qt + r32) * 768 + hq * 128 + 4 * hh;
#pragma unroll
    for (int dt = 0; dt < 4; ++dt)
#pragma unroll
        for (int g = 0; g < 4; ++g) { v2u w; w.x = cvtpk(O[dt][4 * g] * inv, O[dt][4 * g + 1] * inv); w.y = cvtpk(O[dt][4 * g + 2] * inv, O[dt][4 * g + 3] * inv);
            *(GAS v2u*)(orow + 32 * dt + 8 * g) = w; }
}

__device__ __forceinline__ void mem_item(const AttnIn& I, int item, int lane) {
    const int qt = item & 63, h = (item >> 6) & 3, b = item >> 8;
    const int r32 = lane & 31, hh = lane >> 5;
    const unsigned char* kbase = I.mkf + ((size_t)((b * 4 + h) * 8) * 8) * 1024 + lane * 16;
    const unsigned char* vbase = I.mvt + ((size_t)((b * 4 + h) * 8) * 8) * 1024 + lane * 16;
    bf16x8 qfr[8], ka[8], kb[8];
    ld8(I.mqf + ((size_t)((b * 4 + h) * 64 + qt) * 8) * 1024 + lane * 16, qfr);
    ld8(kbase, ka);
    f32x16 O[4];
#pragma unroll
    for (int dt = 0; dt < 4; ++dt)
#pragma unroll
        for (int r = 0; r < 16; ++r) O[dt][r] = 0.f;
    float m = -INFINITY, l = 0.f;
#pragma unroll 1
    for (int half = 0; half < 2; ++half) {
        f32x16 S[4];
#pragma unroll
        for (int i = 0; i < 4; ++i) { const int kt = half * 4 + i;
#pragma unroll
            for (int r = 0; r < 16; ++r) S[i][r] = 0.f;
            const unsigned char* nxt = (i < 3) ? kbase + (size_t)(kt + 1) * 8192 : vbase + (size_t)(half * 4) * 8192;
            if (i & 1) { ld8(nxt, ka);
#pragma unroll
                for (int s = 0; s < 8; ++s) S[i] = __builtin_amdgcn_mfma_f32_32x32x16_bf16(kb[s], qfr[s], S[i], 0, 0, 0);
            } else { ld8(nxt, kb);
#pragma unroll
                for (int s = 0; s < 8; ++s) S[i] = __builtin_amdgcn_mfma_f32_32x32x16_bf16(ka[s], qfr[s], S[i], 0, 0, 0);
            } }
        float mh = m;
#pragma unroll
        for (int i = 0; i < 4; ++i)
#pragma unroll
            for (int r = 0; r < 16; ++r) mh = fmaxf(mh, S[i][r]);
        mh = fmaxf(mh, __shfl_xor(mh, 32));
        const float alpha = ex2(m - mh); m = mh;
        float ls = 0.f;
#pragma unroll
        for (int i = 0; i < 4; ++i)
#pragma unroll
            for (int r = 0; r < 16; ++r) { const float p = ex2(S[i][r] - m); S[i][r] = p; ls += p; }
        ls += __shfl_xor(ls, 32); l = l * alpha + ls;
#pragma unroll
        for (int dt = 0; dt < 4; ++dt) O[dt] = O[dt] * alpha;
#pragma unroll
        for (int i = 0; i < 4; ++i) { const int kt = half * 4 + i;
            const unsigned char* nxt = (i < 3) ? vbase + (size_t)(kt + 1) * 8192 : kbase + (size_t)(half == 0 ? 4 : 0) * 8192;
            if (i & 1) { ld8(nxt, ka); } else { ld8(nxt, kb); }
#pragma unroll
            for (int s = 0; s < 2; ++s) { const bf16x8 pf = pfrag(S[i], s);
#pragma unroll
                for (int dt = 0; dt < 4; ++dt) O[dt] = __builtin_amdgcn_mfma_f32_32x32x16_bf16((i & 1) ? kb[s * 4 + dt] : ka[s * 4 + dt], pf, O[dt], 0, 0, 0); } }
    }
    const float inv = 1.0f / l;
    bf16* orow = I.omem + (size_t)(b * SEQ + 32 * qt + r32) * 768 + h * 128 + 4 * hh;
#pragma unroll
    for (int dt = 0; dt < 4; ++dt)
#pragma unroll
        for (int g = 0; g < 4; ++g) { v2u w; w.x = cvtpk(O[dt][4 * g] * inv, O[dt][4 * g + 1] * inv); w.y = cvtpk(O[dt][4 * g + 2] * inv, O[dt][4 * g + 3] * inv);
            *(GAS v2u*)(orow + 32 * dt + 8 * g) = w; }
}

#ifndef PH_MASK
#define PH_MASK 0x1ff
#endif
#ifndef WGM_UP
#define WGM_UP 4
#endif
#ifndef WGM_DN
#define WGM_DN 4
#endif
#ifndef SP2_UP
#define SP2_UP true
#endif
#ifndef DUP_PHASE
#define DUP_PHASE -1
#endif
struct Args { const float* in[23]; float* out; unsigned char* ws; int ph_lo, ph_hi, opt, pad; };
__global__ void __launch_bounds__(NWAVES * 64, 2) hyb_fwd(Args args) {
    extern __shared__ __attribute__((aligned(16))) unsigned char lds_raw[];
    LAS unsigned char* lds = (LAS unsigned char*)lds_raw;
    volatile LAS unsigned* MISC = (volatile LAS unsigned*)(lds + MISC_OFF);
    const int tid = threadIdx.x, lane = tid & 63, wave = __builtin_amdgcn_readfirstlane(tid >> 6);
    const int G = gridDim.x, bx = blockIdx.x;
    unsigned char* ws = args.ws;
    const float* x = args.in[0]; const float* mem = args.in[1]; const float* attn_norm_w = args.in[2]; const float* w_in = args.in[3];
    const float* dn_conv_w = args.in[4]; const float* dn_A_log = args.in[5]; const float* dn_dt_bias = args.in[6]; const float* dn_out_norm_w = args.in[7];
    const float* swa_q_norm_w = args.in[8]; const float* swa_k_norm_w = args.in[9]; const float* swa_sinks = args.in[10]; const float* rel_bias = args.in[11];
    const float* mem_norm_w = args.in[12]; const float* w_mem_kv = args.in[13]; const float* xq_norm_w = args.in[14]; const float* xk_norm_w = args.in[15];
    const float* p_dn = args.in[16]; const float* p_swa = args.in[17]; const float* p_mem = args.in[18]; const float* w_out = args.in[19];
    const float* mlp_norm_w = args.in[20]; const float* w_up = args.in[21]; const float* w_down = args.in[22];
    float* out = args.out;
    bf16* WoutT = (bf16*)(ws + WS_WOUT); bf16* PdnT = (bf16*)(ws + WS_PDN); bf16* PswaT = (bf16*)(ws + WS_PSWA); bf16* PmemT = (bf16*)(ws + WS_PMEM);
    bf16* WinT = (bf16*)((unsigned char*)out + DO_WIN); bf16* WmkvT = (bf16*)((unsigned char*)out + DO_WMKV); bf16* memn = (bf16*)((unsigned char*)out + DO_MEMN);
    const DnfMap dnfm{(unsigned char*)out, ws + WS_DNF2};
    bf16* WupT = (bf16*)(ws + WS_WUP); bf16* WdnT = (bf16*)(ws + WS_WDN);
    bf16* xn = (bf16*)(ws + WS_XN); bf16* proj = (bf16*)(ws + WS_PROJ); bf16* gates = (bf16*)(ws + WS_GATES);
    bf16* odn = (bf16*)(ws + WS_ODN); bf16* oswa = (bf16*)(ws + WS_OSWA); bf16* omem = (bf16*)(ws + WS_OMEM); bf16* merged = (bf16*)(ws + WS_MERGED);
    bf16* memk = (bf16*)(ws + WS_MEMK); bf16* Hb = (bf16*)(ws + WS_H);
    float* ssq = (float*)(ws + WS_SSQ); float* gcarr = (float*)(ws + WS_GC);

    for (int u = tid; u < (LDS_BYTES - LDSCTL_OFF) / 4; u += NWAVES * 64) ((LAS unsigned*)(lds + LDSCTL_OFF))[u] = 0u;
    __syncthreads();
    XcdBarrier bar = xcd_barrier_post((unsigned*)(ws + WS_CTL) + CW_BAR, MISC + 8);
    const int lo = args.ph_lo, hi = args.ph_hi;
#define IN(k) (lo <= (k) && (k) < hi && ((PH_MASK >> (k)) & 1))
#ifdef DOUBLE_SEAM
#define SEAM(k) do { if ((k) + 1 < hi) { xcd_barrier(bar); xcd_barrier(bar); } } while (0)
#else
#define SEAM(k) do { if ((k) + 1 < hi) xcd_barrier(bar); } while (0)
#endif
    const int gw = bx * NWAVES + wave, NGW = G * NWAVES;

    if (lo <= 0 && 0 < hi) {
        for (int rep = 0; rep < ((DUP_PHASE == 0) ? 2 : 1); ++rep) if (IN(0)) { if (rep) xcd_barrier(bar);
        transpose_matrix<1>(w_in, DM, NIN, nullptr, WinT, DM, NWIN, gw, NGW, lane);
        transpose_matrix<2>(w_in, DM, NIN, nullptr, (bf16*)(ws + WS_WTAIL), DM, 1280, gw, NGW, lane);
        transpose_matrix<0>(w_mem_kv, DM, 1024, nullptr, WmkvT, DM, 1024, gw, NGW, lane);
        for (int m = gw; m < MT + MMEM; m += 2 * NGW) {
            f32x4 va[8], vb[8]; const int m2 = m + NGW; const bool two = m2 < MT + MMEM;
            rms_load(m < MT ? x + (size_t)m * DM : mem + (size_t)(m - MT) * DM, lane, va);
            if (two) rms_load(m2 < MT ? x + (size_t)m2 * DM : mem + (size_t)(m2 - MT) * DM, lane, vb);
            if (m < MT) rms_finish(attn_norm_w, xn + (size_t)m * DM, lane, va); else rms_finish(mem_norm_w, memn + (size_t)(m - MT) * DM, lane, va);
            if (two) { if (m2 < MT) rms_finish(attn_norm_w, xn + (size_t)m2 * DM, lane, vb); else rms_finish(mem_norm_w, memn + (size_t)(m2 - MT) * DM, lane, vb); }
        }
        }
        SEAM(0);
    }
    if (lo <= 1 && 1 < hi) {
        for (int rep = 0; rep < ((DUP_PHASE == 1) ? 2 : 1); ++rep) if (IN(1)) { if (rep) xcd_barrier(bar);
        { pg8::Gemm g{xn, WinT, MT, NMAIN, DM}; pg8::StaticOrder S; S.init(MT, NMAIN, G, bx); S.cap = P1_CAP; S.wgm = 4;
          pg8::EpiProj E{proj, gates, LDP, LDG};
          pg8::gemm_phase<pg8::EpiProj, pg8::StaticOrder, true, true>(lds + RING_OFF, g, S, E); }
        { pg8::Gemm g{WinT + (size_t)NMAIN * DM, xn, 256, MT, DM}; pg8::StaticOrder S; S.init(256, MT, G, (bx - 208 + G) % G);
          pg8::EpiVt<2, SEQ> E{ws + WS_VT};
          pg8::gemm_phase<pg8::EpiVt<2, SEQ>, pg8::StaticOrder, true, true>(lds + RING_OFF, g, S, E); }
        { pg8::Gemm g{memn, WmkvT, MMEM, 512, DM}; pg8::StaticOrder S; S.init(MMEM, 512, G, (bx - 240 + G) % G);
          pg8::EpiPlain E{memk, 512};
          pg8::gemm_phase<pg8::EpiPlain, pg8::StaticOrder, true, true>(lds + RING_OFF, g, S, E); }
        { pg8::Gemm g{WmkvT + (size_t)512 * DM, memn, 512, MMEM, DM}; pg8::StaticOrder S; S.init(512, MMEM, G, (bx - 248 + G) % G);
          pg8::EpiVt<4, MEML> E{ws + WS_MVT};
          pg8::gemm_phase<pg8::EpiVt<4, MEML>, pg8::StaticOrder, true, true>(lds + RING_OFF, g, S, E); }
        }
        SEAM(1);
    }
    if (lo <= 2 && 2 < hi) {
        for (int rep = 0; rep < ((DUP_PHASE == 2) ? 2 : 1); ++rep) if (IN(2)) { if (rep) xcd_barrier(bar);
        DnIn DI{proj, dn_conv_w, dn_A_log, dn_dt_bias, dnfm, gcarr, ws + WS_LG, ws + WS_RHS};
        { unsigned uraw[35];
          if (bx < NCHUNK) dn_conv_issue(DI, bx, tid, uraw);
          for (int chunk = bx; chunk < NCHUNK; chunk += G) dn_prep_chunk(DI, (LAS float*)(lds + RING_OFF), chunk, chunk + G, tid, uraw); }
        asm volatile("s_waitcnt vmcnt(0)" ::: "memory"); __syncthreads();
        { const int nmine = (NCHUNK - 1 - bx) / G + 1;
          for (int si = wave; si < 4 * nmine; si += NWAVES) dn_solve_item(ws + WS_LG, ws + WS_RHS, dnfm, (LAS float*)(lds + RING_OFF + wave * 8448), (bx + (si >> 2) * G) * 4 + (si & 3), lane); }
        { const int lw = (NWAVES - 1 - wave) * G + bx, nlight = NGW;
          for (int it = lw; it < 3200; it += nlight) {
            if (it < 1536) { const int grp = it >> 6, tile = it & 63, b = grp / 6, hq = grp % 6;
                normfrag_item(proj, LDP, b * SEQ + 32 * tile, PC_SQ + hq * 128, swa_q_norm_w, QSCALE, ws + WS_QF + (size_t)it * 8192, lane); }
            else if (it < 2048) { const int i2 = it - 1536, grp = i2 >> 6, tile = i2 & 63, b = grp >> 1, kvh = grp & 1;
                normfrag_item(proj, LDP, b * SEQ + 32 * tile, PC_SK + kvh * 128, swa_k_norm_w, 1.0f, ws + WS_KF + (size_t)i2 * 8192, lane); }
            else if (it < 3072) { const int i3 = it - 2048, grp = i3 >> 6, tile = i3 & 63, b = grp >> 2, h = grp & 3;
                normfrag_item(proj, LDP, b * SEQ + 32 * tile, PC_MQ + h * 128, xq_norm_w, QSCALE, ws + WS_MQF + (size_t)i3 * 8192, lane); }
            else { const int i4 = it - 3072, grp = i4 >> 3, tile = i4 & 7, b = grp >> 2, h = grp & 3;
                normfrag_item(memk, 512, b * MEML + 32 * tile, h * 128, xk_norm_w, 1.0f, ws + WS_MKF + (size_t)i4 * 8192, lane); }
          }
        }
        }
        SEAM(2);
    }
    if (lo <= 4 && 4 < hi) {
        for (int rep = 0; rep < ((DUP_PHASE == 4) ? 2 : 1); ++rep) if (IN(4)) { if (rep) xcd_barrier(bar);
        if (bx < 24) {
#ifndef NO_SCAN
            if (!(args.opt & 1)) { int tid_s = tid; asm volatile("" : "+v"(tid_s)); ScanIn SI{dnfm, gcarr, dn_out_norm_w, odn, args.opt}; dn_scan(SI, lds + RING_OFF, bx, tid_s); }
#endif
        }
        else if (!(args.opt & 2)) {
            LAS float* biasT = (LAS float*)(lds + RING_OFF);
            for (int e = tid; e < 768; e += NWAVES * 64) { const int hq = e >> 7, dist = e & 127; biasT[e] = rel_bias[T5_BUCKET[dist] * 6 + hq] * LOG2E; }
            __syncthreads();
            int lane_a = lane; asm volatile("" : "+v"(lane_a));
            AttnIn AI{ws + WS_QF, ws + WS_KF, ws + WS_VT, ws + WS_MQF, ws + WS_MKF, ws + WS_MVT, oswa, omem, swa_sinks};
            const int aw = (bx - 24) * NWAVES + wave, NAW = (G - 24) * NWAVES;
#ifndef NO_MEM
            for (int it = aw; it < 1024; it += NAW) mem_item(AI, it, lane_a);
#endif
#ifndef NO_SWA
            for (int it = (aw + NAW - (1024 % NAW)) % NAW; it < 1536; it += NAW) swa_item(AI, biasT, it, lane_a);
#endif
            const int ab = bx - 24, nab = G - 24, ntail = NTAIL < nab ? NTAIL : nab;
            __syncthreads();
            if (!(args.opt & 16)) { pg8::StaticOrder S; S.init(MT, NMAIN, 1 << 20, P1_CAP + ab); S.wgm = 4;
              if (ntail < NTAIL) S.cap = 0;
              const bf16* wt = (const bf16*)(ws + WS_WTAIL) - (size_t)38 * 256 * DM;
              pg8::Gemm g{xn, wt, MT, NMAIN, DM};
              pg8::EpiProj E{proj, gates, LDP, LDG};
              pg8::gemm_phase<pg8::EpiProj, pg8::StaticOrder, false, true>(lds + RING_OFF, g, S, E); }
            if (!(args.opt & 8)) {
            int lane2 = lane; asm volatile("" : "+v"(lane2));
            const int share = ab < ntail ? 1 : 3, Wt = NWAVES * (ntail + 3 * (nab - ntail));
            const int vb = ab < ntail ? (ab * NWAVES + wave) : (ntail * NWAVES + ((ab - ntail) * NWAVES + wave) * 3);
            for (int k = 0; k < share; ++k) {
                transpose_matrix<0>(w_up, DM, DFF, mlp_norm_w, WupT, DM, DFF, vb + k, Wt, lane2);
                transpose_matrix<0>(w_down, DFF, DM, nullptr, WdnT, DFF, DM, vb + k, Wt, lane2);
                transpose_matrix<0>(p_dn, 768, DM, nullptr, PdnT, 768, DM, vb + k, Wt, lane2);
                transpose_matrix<0>(p_swa, 768, DM, nullptr, PswaT, 768, DM, vb + k, Wt, lane2);
                transpose_matrix<0>(p_mem, 512, DM, nullptr, PmemT, 768, DM, vb + k, Wt, lane2);
                transpose_matrix<0>(w_out, DM, DM, nullptr, WoutT, DM, DM, vb + k, Wt, lane2); } }
        }
        }
        SEAM(4);
    }
    if (lo <= 5 && 5 < hi) {
        for (int rep = 0; rep < ((DUP_PHASE == 5) ? 2 : 1); ++rep) if (IN(5)) { if (rep) xcd_barrier(bar);
        if (!(args.opt & 16))
        { pg8::Gemm g{odn, PdnT, 3 * MT, 3 * DM, 768}; pg8::MergeOrder S; S.init(MT, DM, G, bx); S.so.wgm = 4;
          pg8::EpiMergeAll E{gates, merged, LDG, DM};
          pg8::gemm_phase<pg8::EpiMergeAll, pg8::MergeOrder, true, true>(lds + RING_OFF, g, S, E); }
        }
        SEAM(5);
    }
    if (lo <= 6 && 6 < hi) {
        for (int rep = 0; rep < ((DUP_PHASE == 6) ? 2 : 1); ++rep) if (IN(6)) { if (rep) xcd_barrier(bar);
        pg8::Gemm g{merged, WoutT, MT, DM, DM}; pg8::StaticOrder S; S.init(MT, DM, G, bx); S.wgm = 4;
        pg8::EpiOut E{x, (args.opt & 4) ? (float*)(ws + 225 * MiB) : out, xn, ssq, DM, rep ? 0.f : 1.f};
        pg8::gemm_phase<pg8::EpiOut, pg8::StaticOrder, false, true>(lds + RING_OFF, g, S, E);
        }
        SEAM(6);
    }
    if (lo <= 7 && 7 < hi) {
        for (int rep = 0; rep < ((DUP_PHASE == 7) ? 2 : 1); ++rep) if (IN(7)) { if (rep) xcd_barrier(bar);
        pg8::Gemm g{xn, WupT, MT, DFF, DM}; pg8::StaticOrder S; S.init(MT, DFF, G, bx); S.wgm = WGM_UP;
        pg8::EpiUp E{ssq, Hb, DFF, 1.0f / DM, EPS};
        pg8::gemm_phase<pg8::EpiUp, pg8::StaticOrder, true, SP2_UP>(lds + RING_OFF, g, S, E);
        }
        SEAM(7);
    }
    if (lo <= 8 && 8 < hi) {
        for (int rep = 0; rep < ((DUP_PHASE == 8) ? 2 : 1); ++rep) if (IN(8)) { if (rep) xcd_barrier(bar);
        pg8::Gemm g{Hb, WdnT, MT, DM, DFF}; pg8::StaticOrder S; S.init(MT, DM, G, bx); S.wgm = WGM_DN;
        pg8::EpiDown E{xn, out, DM, (rep || (args.opt & 4)) ? 0.f : 1.f};
        pg8::gemm_phase<pg8::EpiDown, pg8::StaticOrder, false, true>(lds + RING_OFF, g, S, E);
        }
    }
#undef IN
#undef SEAM
}

#ifndef N_LAUNCHES
#define N_LAUNCHES 1
#endif
extern "C" void kernel_launch(void* const* d_in, const int* in_sizes, int n_in, void* d_out, int out_size, void* d_ws, size_t ws_size, hipStream_t stream) {
    static int grid = 0;
    if (grid == 0) {
        if (n_in != 23 || out_size != MT * DM || ws_size < WS_END) { fprintf(stderr, "kernel_launch: unexpected shapes (n_in %d, out %d, ws %zu)\n", n_in, out_size, ws_size); grid = -1; return; }
        int dev = 0, cus = 0, per_cu = 0;
        if (hipGetDevice(&dev) != hipSuccess || hipDeviceGetAttribute(&cus, hipDeviceAttributeMultiprocessorCount, dev) != hipSuccess) { grid = -1; return; }
        if (hipFuncSetAttribute((const void*)hyb_fwd, hipFuncAttributeMaxDynamicSharedMemorySize, LDS_BYTES) != hipSuccess) { fprintf(stderr, "kernel_launch: hipFuncSetAttribute failed\n"); grid = -1; return; }
        if (hipOccupancyMaxActiveBlocksPerMultiprocessor(&per_cu, (const void*)hyb_fwd, NWAVES * 64, LDS_BYTES) != hipSuccess || per_cu < 1) { fprintf(stderr, "kernel_launch: occupancy query says %d\n", per_cu); per_cu = 1; }
        (void)hipGetLastError();
        grid = cus;
        if (grid > 256) grid = 256;
    }
    if (grid < 0) return;
    (void)hipMemsetAsync((char*)d_ws + WS_CTL, 0, CTL_ZERO_BYTES, stream);
#ifdef EXTRA_MEMSET
    (void)hipMemsetAsync((char*)d_ws + WS_END, 0, 64, stream);
#endif
    Args a{};
    for (int i = 0; i < 23; ++i) a.in[i] = (const float*)d_in[i];
    a.out = (float*)d_out; a.ws = (unsigned char*)d_ws;
#if N_LAUNCHES == 1
    a.ph_lo = 0; a.ph_hi = 9;
    hipLaunchKernelGGL(hyb_fwd, dim3(grid), dim3(NWAVES * 64), LDS_BYTES, stream, a);
#else
    for (int p = 0; p < 9; ++p) { a.ph_lo = p; a.ph_hi = p + 1; hipLaunchKernelGGL(hyb_fwd, dim3(grid), dim3(NWAVES * 64), LDS_BYTES, stream, a); }
#endif
#ifdef RERUN_PHASE
    a.ph_lo = RERUN_PHASE; a.ph_hi = RERUN_PHASE + 1; a.opt = RERUN_OPT;
    hipLaunchKernelGGL(hyb_fwd, dim3(grid), dim3(NWAVES * 64), LDS_BYTES, stream, a);
#endif
}
```

```cpp
#include <hip/hip_runtime.h>
#include <cstdio>
#include <cstdint>
namespace pg8 {
#define PG8_LAS __attribute__((address_space(3)))
typedef unsigned short bf16_t;
typedef short bf16x8 __attribute__((ext_vector_type(8)));
typedef float f32x4 __attribute__((ext_vector_type(4)));
typedef unsigned u32x4 __attribute__((ext_vector_type(4)));
constexpr int BM = 256, BK = 64, HALF = 128, HTB = HALF * BK * 2  , STAGE_BYTES = 8 * HTB, NXCD = 8, WGM = 8;

__host__ __device__ __forceinline__ int lds_byte(int r, int c) { const int st = (r >> 4) * 2 + (c >> 5), rr = r & 15, cc = c & 31, ob = rr * 64 + cc * 2; return st * 1024 + (ob ^ (((ob >> 9) & 1) << 5)); }
__host__ __device__ __forceinline__ void stage_rc(int b, int& R, int& C) { const int st = b / 1024, sb = b % 1024, swz = sb ^ (((sb >> 9) & 1) << 5); R = (st >> 1) * 16 + swz / 64; C = (st & 1) * 32 + (swz % 64) / 2; }
__host__ __device__ __forceinline__ int perm32(int rho) { const int n = rho >> 4, i = rho & 15; return 8 * (i >> 2) + 4 * n + (i & 3); }

struct Unit { int pm, pn; };
struct Gemm { const bf16_t* A; const bf16_t* Bt; int M, N, K; };

struct StaticOrder {
    static constexpr bool VAR_NT = false;
    int nM, nN, nwg, G, c, cap, wgm;
    __host__ __device__ void init(int M, int N, int G_, int c_) { nM = M / BM; nN = N / BM; nwg = nM * nN; G = G_; c = c_; cap = nwg; wgm = WGM; }
    __host__ __device__ bool next(int i, Unit& u) const {
        const long L = (long)i * G + c; if (L >= cap) return false;
        int wgid = (int)L; { const int q = nwg / NXCD, r = nwg % NXCD, xcd = wgid % NXCD, off = wgid / NXCD; wgid = (xcd < r ? xcd * (q + 1) : r * (q + 1) + (xcd - r) * q) + off; }
        const int nig = wgm * nN, gid = wgid / nig, fm = gid * wgm, gsz = (nM - fm) < wgm ? (nM - fm) : wgm;
        u.pm = fm + ((wgid % nig) % gsz); u.pn = (wgid % nig) / gsz; return true;
    }
    __device__ __forceinline__ void a_ready(const Unit&) const {}
    __device__ __forceinline__ void done(const Unit&) const {}
};

__device__ __forceinline__ unsigned cvt_pk_bf16(float lo, float hi) { unsigned r; asm volatile("v_cvt_pk_bf16_f32 %0, %1, %2" : "=v"(r) : "v"(lo), "v"(hi)); return r; }
typedef float f32x2 __attribute__((ext_vector_type(2)));
__device__ __forceinline__ f32x2 gelu_pk(f32x2 v) {
    const f32x2 av = __builtin_elementwise_abs(v), d = av * 0.2316418882f + 1.0f;
    f32x2 t; t.x = __builtin_amdgcn_rcpf(d.x); t.y = __builtin_amdgcn_rcpf(d.y);
    f32x2 q = t * 0.5307027145f + (-0.7265760135f); q = q * t + 0.7107068705f; q = q * t + (-0.142248368f); q = q * t + 0.127414796f; q = q * t;
    const f32x2 s = (v * v) * (-0.72134752044f);
    f32x2 e; e.x = __builtin_amdgcn_exp2f(s.x); e.y = __builtin_amdgcn_exp2f(s.y);
    const f32x2 m = v * (q * e), r = v - m;
    f32x2 o; o.x = v.x < 0.f ? m.x : r.x; o.y = v.y < 0.f ? m.y : r.y; return o;
}

template <int ACT  > struct EpiBf16 {
    static constexpr bool PERM = true, AFTER_DRAIN = false, INPLACE = false; static_assert(ACT == 0 || ACT == 1, "EpiBf16: ACT is 0 (none) or 1 (gelu_pk)");
    bf16_t* O; int ldc; const float* bias; int split_cols; size_t split_stride; float scale0;
    __device__ __forceinline__ void operator()(const f32x4 (&acc)[2][2][4][2], const Unit& u, int wr, int wc, int fr, int fq) const {
        const int row0 = u.pm * BM + wr * 64 + fr; int colt = u.pn * BM; bf16_t* base = O;
        float sc = 1.f; if (split_cols) { const int t = colt / split_cols; base += (size_t)t * split_stride; colt -= t * split_cols; if (t == 0) sc = scale0; }
        const int col0 = colt + wc * 32 + 8 * fq, bcol0 = u.pn * BM + wc * 32 + 8 * fq;
        f32x4 bv[2][2];
#pragma unroll
        for (int bj = 0; bj < 2; ++bj)
#pragma unroll
            for (int n = 0; n < 2; ++n) bv[bj][n] = bias ? *(const f32x4*)(bias + bcol0 + bj * HALF + 4 * n) : (f32x4){0.f, 0.f, 0.f, 0.f};
#pragma unroll
        for (int ai = 0; ai < 2; ++ai)
#pragma unroll
            for (int m = 0; m < 4; ++m) { bf16_t* rowp = base + (size_t)(row0 + ai * HALF + m * 16) * ldc + col0;
#pragma unroll
                for (int bj = 0; bj < 2; ++bj) { f32x4 v0 = acc[ai][bj][m][0] + bv[bj][0], v1 = acc[ai][bj][m][1] + bv[bj][1];
                    if (ACT == 1) { f32x2 a = gelu_pk((f32x2){v0[0], v0[1]}), b = gelu_pk((f32x2){v0[2], v0[3]}), c = gelu_pk((f32x2){v1[0], v1[1]}), d = gelu_pk((f32x2){v1[2], v1[3]});
                        v0 = (f32x4){a.x, a.y, b.x, b.y}; v1 = (f32x4){c.x, c.y, d.x, d.y}; }
                    v0 = v0 * sc; v1 = v1 * sc; u32x4 w; w.x = cvt_pk_bf16(v0[0], v0[1]); w.y = cvt_pk_bf16(v0[2], v0[3]); w.z = cvt_pk_bf16(v1[0], v1[1]); w.w = cvt_pk_bf16(v1[2], v1[3]);
                    *(u32x4*)(rowp + bj * HALF) = w; } }
    }
};
template <class Epi, class Sched, bool ALIGN_EPI = false, bool SP2 = false>
__device__ __forceinline__ void gemm_phase(PG8_LAS unsigned char* lds, const Gemm g, const Sched& S, const Epi& E) {
    const int tid = threadIdx.x, wid = __builtin_amdgcn_readfirstlane(tid >> 6), lane = tid & 63, wr = wid >> 2, wc = wid & 3, fr = lane & 15, fq = lane >> 4;
    const int K = g.K; int nt = K / BK;
    unsigned voffA[2], voffB[2];
#pragma unroll
    for (int i = 0; i < 2; ++i) { int R, C; stage_rc(tid * 16 + i * 8192, R, C); const int Rb = Epi::PERM ? ((R & ~31) + perm32(R & 31)) : R;
        voffA[i] = (unsigned)(R * K + C) * 2u; voffB[i] = (unsigned)(Rb * K + C) * 2u; }
    const size_t kstep = (size_t)(BK * 2);
    const size_t hstep = (size_t)HALF * K * 2;
    const size_t tstep = 2 * hstep;
    const unsigned ldsw = (unsigned)wid * 1024u;
    const int aoff = lds_byte(wr * 64 + fr, fq * 8), boff = lds_byte(wc * 32 + fr, fq * 8);
#define PG8_SA(b, h) (((b) * 2 + (h)) * HTB)
#define PG8_SB(b, h) ((4 + (b) * 2 + (h)) * HTB)
#define PG8_STAGE(bufoff, gbase, voff) do { _Pragma("unroll") for (int _i = 0; _i < 2; ++_i) \
        __builtin_amdgcn_global_load_lds((const unsigned*)((const char*)(gbase) + (voff)[_i]), (PG8_LAS unsigned*)(lds + (bufoff) + ldsw + _i * 8192), 16, 0, 0); } while (0)
#define PG8_LDA(dst, b, h) do { _Pragma("unroll") for (int m = 0; m < 4; ++m) _Pragma("unroll") for (int k = 0; k < 2; ++k) dst[m][k] = *(const PG8_LAS bf16x8*)(lds + PG8_SA(b, h) + aoff + m * 2048 + k * 1024); } while (0)
#define PG8_LDB(dst, b, h) do { _Pragma("unroll") for (int n = 0; n < 2; ++n) _Pragma("unroll") for (int k = 0; k < 2; ++k) dst[n][k] = *(const PG8_LAS bf16x8*)(lds + PG8_SB(b, h) + boff + n * 2048 + k * 1024); } while (0)
#define PG8_MMA(ai, bj, At, Bt) do { __builtin_amdgcn_s_setprio(1); _Pragma("unroll") for (int m = 0; m < 4; ++m) _Pragma("unroll") for (int n = 0; n < 2; ++n) _Pragma("unroll") for (int k = 0; k < 2; ++k) \
        acc[ai][bj][m][n] = __builtin_amdgcn_mfma_f32_16x16x32_bf16(Bt[n][k], At[m][k], acc[ai][bj][m][n], 0, 0, 0); __builtin_amdgcn_s_setprio(0); } while (0)
#define PG8_WAIT_V(n) asm volatile("s_waitcnt vmcnt(" #n ")" ::: "memory")
#define PG8_WAIT_L(n) asm volatile("s_waitcnt lgkmcnt(" #n ")" ::: "memory")
#define PG8_BAR __builtin_amdgcn_s_barrier()
#define PG8_SCHED __builtin_amdgcn_sched_barrier(0)
    Unit cur, nxt; int ui = 0;
    if (!S.next(0, cur)) return;
    if constexpr (Sched::VAR_NT) nt = S.unit_nt(cur);
    f32x4 acc[2][2][4][2];
#pragma unroll
    for (int a = 0; a < 2; ++a)
#pragma unroll
        for (int b = 0; b < 2; ++b)
#pragma unroll
            for (int m = 0; m < 4; ++m)
#pragma unroll
                for (int n = 0; n < 2; ++n) acc[a][b][m][n] = (f32x4){0.f, 0.f, 0.f, 0.f};
    bf16x8 At[4][2], B0[2][2], B1[2][2];
    const char* cA = (const char*)g.A + (size_t)cur.pm * tstep; const char* cB = (const char*)g.Bt + (size_t)cur.pn * tstep;
    S.a_ready(cur);
    if constexpr (SP2) {
        PG8_STAGE(PG8_SB(0, 0), cB, voffB); PG8_STAGE(PG8_SB(0, 1), cB + hstep, voffB); PG8_STAGE(PG8_SA(0, 0), cA, voffA); PG8_STAGE(PG8_SA(0, 1), cA + hstep, voffA);
        if (wr == 1) PG8_BAR;
        PG8_WAIT_V(2); PG8_BAR;
        PG8_STAGE(PG8_SB(1, 0), cB + kstep, voffB); PG8_STAGE(PG8_SA(1, 0), cA + kstep, voffA); PG8_STAGE(PG8_SB(1, 1), cB + hstep + kstep, voffB);
        PG8_WAIT_V(6); PG8_BAR;
    } else {
        PG8_STAGE(PG8_SB(0, 0), cB, voffB); PG8_STAGE(PG8_SA(0, 0), cA, voffA); PG8_STAGE(PG8_SB(0, 1), cB + hstep, voffB); PG8_STAGE(PG8_SA(0, 1), cA + hstep, voffA);
        if (wr == 1) PG8_BAR;
        PG8_WAIT_V(4); PG8_BAR;
        PG8_STAGE(PG8_SB(1, 0), cB + kstep, voffB); PG8_STAGE(PG8_SA(1, 0), cA + kstep, voffA); PG8_STAGE(PG8_SB(1, 1), cB + hstep + kstep, voffB);
        PG8_WAIT_V(6); PG8_BAR;
    }
    for (;;) {
        const bool has_next = S.next(ui + 1, nxt);
        const char* nA = has_next ? (const char*)g.A + (size_t)nxt.pm * tstep : cA; const char* nB = has_next ? (const char*)g.Bt + (size_t)nxt.pn * tstep : cB;
        for (int t = 0; t < nt; t += 2) {
            const bool last = (t == nt - 2);
            const char* a1 = cA + (size_t)(t + 1) * kstep;
            const char* a2 = last ? nA : cA + (size_t)(t + 2) * kstep; const char* b2 = last ? nB : cB + (size_t)(t + 2) * kstep;
            const char* a3 = a2 + kstep; const char* b3 = b2 + kstep;
            if (last && has_next) S.a_ready(nxt);
            if constexpr (SP2) {
            PG8_LDB(B0, 0, 0); PG8_LDB(B1, 0, 1); PG8_SCHED; PG8_LDA(At, 0, 0); PG8_STAGE(PG8_SA(1, 1), a1 + hstep, voffA);
            PG8_WAIT_V(8); PG8_WAIT_L(0); PG8_BAR; PG8_MMA(0, 0, At, B0); PG8_MMA(0, 1, At, B1); PG8_BAR; PG8_SCHED;
            PG8_LDA(At, 0, 1); PG8_STAGE(PG8_SB(0, 0), b2, voffB); PG8_STAGE(PG8_SB(0, 1), b2 + hstep, voffB); PG8_STAGE(PG8_SA(0, 0), a2, voffA);
            PG8_WAIT_V(8); PG8_WAIT_L(0); PG8_BAR; PG8_MMA(1, 0, At, B0); PG8_MMA(1, 1, At, B1); PG8_BAR; PG8_SCHED;
            PG8_LDB(B0, 1, 0); PG8_LDB(B1, 1, 1); PG8_SCHED; PG8_LDA(At, 1, 0); PG8_STAGE(PG8_SA(0, 1), a2 + hstep, voffA);
            PG8_WAIT_V(8); PG8_WAIT_L(0); PG8_BAR; PG8_MMA(0, 0, At, B0); PG8_MMA(0, 1, At, B1); PG8_BAR; PG8_SCHED;
            PG8_LDA(At, 1, 1); PG8_STAGE(PG8_SB(1, 0), b3, voffB); PG8_STAGE(PG8_SB(1, 1), b3 + hstep, voffB); PG8_STAGE(PG8_SA(1, 0), a3, voffA);
            PG8_WAIT_V(8); PG8_WAIT_L(0); PG8_BAR; PG8_MMA(1, 0, At, B0); PG8_MMA(1, 1, At, B1); PG8_BAR; PG8_SCHED;
            } else {
            PG8_LDB(B0, 0, 0); PG8_SCHED; PG8_LDA(At, 0, 0); PG8_STAGE(PG8_SA(1, 1), a1 + hstep, voffA);
            PG8_WAIT_L(8); PG8_BAR; PG8_WAIT_L(0); PG8_MMA(0, 0, At, B0); PG8_BAR; PG8_SCHED;
            PG8_LDB(B1, 0, 1); PG8_STAGE(PG8_SB(0, 0), b2, voffB);
            PG8_BAR; PG8_WAIT_L(0); PG8_MMA(0, 1, At, B1); PG8_BAR;
            PG8_LDA(At, 0, 1); PG8_STAGE(PG8_SA(0, 0), a2, voffA);
            PG8_BAR; PG8_WAIT_L(0); PG8_MMA(1, 0, At, B0); PG8_BAR; PG8_SCHED;
            PG8_STAGE(PG8_SB(0, 1), b2 + hstep, voffB);
            PG8_WAIT_V(6); PG8_BAR; PG8_MMA(1, 1, At, B1); PG8_BAR;
            PG8_LDB(B0, 1, 0); PG8_SCHED; PG8_LDA(At, 1, 0); PG8_STAGE(PG8_SA(0, 1), a2 + hstep, voffA);
            PG8_WAIT_L(8); PG8_BAR; PG8_WAIT_L(0); PG8_MMA(0, 0, At, B0); PG8_BAR; PG8_SCHED;
            PG8_LDB(B1, 1, 1); PG8_STAGE(PG8_SB(1, 0), b3, voffB);
            PG8_BAR; PG8_WAIT_L(0); PG8_MMA(0, 1, At, B1); PG8_BAR;
            PG8_LDA(At, 1, 1); PG8_STAGE(PG8_SA(1, 0), a3, voffA);
            PG8_BAR; PG8_WAIT_L(0); PG8_MMA(1, 0, At, B0); PG8_BAR; PG8_SCHED;
            PG8_STAGE(PG8_SB(1, 1), b3 + hstep, voffB);
            PG8_WAIT_V(6); PG8_BAR; PG8_MMA(1, 1, At, B1); PG8_BAR;
            }
        }
        if constexpr (ALIGN_EPI) { if (wr == 0) PG8_BAR; }
        bool keep_acc = false;
        if constexpr (Epi::INPLACE) { keep_acc = E.inplace(acc, cur, wr, wc, fr, fq); S.done(cur); }
        else if constexpr (!Epi::AFTER_DRAIN) { E(acc, cur, wr, wc, fr, fq); S.done(cur); }
        if (!has_next) break;
        if (!keep_acc)
#pragma unroll
        for (int a = 0; a < 2; ++a)
#pragma unroll
            for (int b = 0; b < 2; ++b)
#pragma unroll
                for (int m = 0; m < 4; ++m)
#pragma unroll
                    for (int n = 0; n < 2; ++n) acc[a][b][m][n] = (f32x4){0.f, 0.f, 0.f, 0.f};
        cur = nxt; cA = nA; cB = nB; ++ui;
        if constexpr (Sched::VAR_NT) nt = S.unit_nt(cur);
        if constexpr (ALIGN_EPI) { if (wr == 1) PG8_BAR; }
    }
    PG8_WAIT_V(0);
    if constexpr (!ALIGN_EPI) { if (wr == 0) PG8_BAR; }
    PG8_BAR;
    if constexpr (Epi::AFTER_DRAIN) { E.fused(acc, cur, wr, wc, fr, fq, lds, wid, lane); S.done(cur); }
#undef PG8_SA
#undef PG8_SB
#undef PG8_STAGE
#undef PG8_LDA
#undef PG8_LDB
#undef PG8_MMA
#undef PG8_WAIT_V
#undef PG8_WAIT_L
#undef PG8_BAR
#undef PG8_SCHED
}
}

namespace pg8 {
typedef float f32x2e __attribute__((ext_vector_type(2))); typedef __bf16 bf16x2e __attribute__((ext_vector_type(2)));
__device__ __forceinline__ unsigned cvtpk(float lo, float hi) { f32x2e v = {lo, hi}; bf16x2e b = __builtin_convertvector(v, bf16x2e); return __builtin_bit_cast(unsigned, b); }
__device__ __forceinline__ float bflo(unsigned u) { return __builtin_bit_cast(float, u << 16); }
__device__ __forceinline__ float bfhi(unsigned u) { return __builtin_bit_cast(float, u & 0xffff0000u); }
__device__ __forceinline__ void st16_wt(void* p, u32x4 v) { asm volatile("global_store_dwordx4 %0, %1, off sc1\n\ts_nop 1" :: "v"(p), "v"(v) : "memory"); }
__device__ __forceinline__ float sigm(float v) { return __builtin_amdgcn_rcpf(1.0f + __expf(-v)); }

struct EpiProj {
    static constexpr bool PERM = true, AFTER_DRAIN = false, INPLACE = false;
    bf16_t* proj; bf16_t* gates; int ldp, ldg;
    __device__ __forceinline__ void operator()(const f32x4 (&acc)[2][2][4][2], const Unit& u, int wr, int wc, int fr, int fq) const {
        const int row0 = u.pm * BM + wr * 64 + fr; const int pn = u.pn; const bool isg = (pn >= 19);
        bf16_t* base = isg ? gates : proj; const int ld = isg ? ldg : ldp; const int colt = isg ? (pn - 19) * BM : pn * BM;
        const int col0 = colt + wc * 32 + 8 * fq;
#pragma unroll
        for (int ai = 0; ai < 2; ++ai)
#pragma unroll
            for (int m = 0; m < 4; ++m) { bf16_t* rowp = base + (size_t)(row0 + ai * HALF + m * 16) * ld + col0;
#pragma unroll
                for (int bj = 0; bj < 2; ++bj) { f32x4 v0 = acc[ai][bj][m][0], v1 = acc[ai][bj][m][1];
                    if (isg) { v0 = (f32x4){sigm(v0[0]), sigm(v0[1]), sigm(v0[2]), sigm(v0[3])}; v1 = (f32x4){sigm(v1[0]), sigm(v1[1]), sigm(v1[2]), sigm(v1[3])}; }
                    u32x4 w; w.x = cvtpk(v0[0], v0[1]); w.y = cvtpk(v0[2], v0[3]); w.z = cvtpk(v1[0], v1[1]); w.w = cvtpk(v1[2], v1[3]);
                    *(u32x4*)(rowp + bj * HALF) = w; } }
    }
};
struct EpiPlain {
    static constexpr bool PERM = true, AFTER_DRAIN = false, INPLACE = false;
    bf16_t* O; int ldc;
    __device__ __forceinline__ void operator()(const f32x4 (&acc)[2][2][4][2], const Unit& u, int wr, int wc, int fr, int fq) const {
        const int row0 = u.pm * BM + wr * 64 + fr; const int col0 = u.pn * BM + wc * 32 + 8 * fq;
#pragma unroll
        for (int ai = 0; ai < 2; ++ai)
#pragma unroll
            for (int m = 0; m < 4; ++m) { bf16_t* rowp = O + (size_t)(row0 + ai * HALF + m * 16) * ldc + col0;
#pragma unroll
                for (int bj = 0; bj < 2; ++bj) { const f32x4 v0 = acc[ai][bj][m][0], v1 = acc[ai][bj][m][1];
                    u32x4 w; w.x = cvtpk(v0[0], v0[1]); w.y = cvtpk(v0[2], v0[3]); w.z = cvtpk(v1[0], v1[1]); w.w = cvtpk(v1[2], v1[3]);
                    *(u32x4*)(rowp + bj * HALF) = w; } }
    }
};
template <int NH, int SEQL> struct EpiVt {
    static constexpr bool PERM = true, AFTER_DRAIN = false, INPLACE = false;
    unsigned char* vt;
    __device__ __forceinline__ void operator()(const f32x4 (&acc)[2][2][4][2], const Unit& u, int wr, int wc, int fr, int fq) const {
        constexpr int NKT = SEQL / 32;
        const int row0 = u.pm * BM + wr * 64 + fr; const int col0 = u.pn * BM + wc * 32 + 8 * fq;
#pragma unroll
        for (int ai = 0; ai < 2; ++ai)
#pragma unroll
            for (int m = 0; m < 4; ++m) { const int drow = row0 + ai * HALF + m * 16; const int hh = drow >> 7, d = drow & 127, dt = d >> 5, dl = d & 31;
#pragma unroll
                for (int bj = 0; bj < 2; ++bj) { const int t0 = col0 + bj * HALF; const int b = t0 / SEQL, tt = t0 % SEQL, kt = tt >> 5, s = (tt >> 4) & 1, o8 = (tt >> 3) & 1;
                    const size_t blk = ((((size_t)(b * NH + hh) * NKT + kt) * 2 + s) * 4 + dt);
                    unsigned char* p = vt + blk * 1024 + dl * 16 + o8 * 8;
                    const f32x4 v0 = acc[ai][bj][m][0], v1 = acc[ai][bj][m][1];
                    unsigned long long w0 = (unsigned long long)cvtpk(v0[0], v0[1]) | ((unsigned long long)cvtpk(v0[2], v0[3]) << 32);
                    unsigned long long w1 = (unsigned long long)cvtpk(v1[0], v1[1]) | ((unsigned long long)cvtpk(v1[2], v1[3]) << 32);
                    *(unsigned long long*)p = w0; *(unsigned long long*)(p + 512) = w1; } }
    }
};
struct MergeOrder {
    static constexpr bool VAR_NT = true;
    __device__ __forceinline__ int unit_nt(const Unit& u) const { return (u.pm >> 5) == 2 ? 8 : 12; }
    StaticOrder so;
    __device__ void init(int M, int N, int G_, int c_) { so.init(M, N, G_, c_); }
    __device__ bool next(int i, Unit& u) const { const int ib = i / 3, br = i - 3 * ib; if (!so.next(ib, u)) return false; u.pm += 32 * br; u.pn += 8 * br; return true; }
    __device__ __forceinline__ void a_ready(const Unit&) const {}
    __device__ __forceinline__ void done(const Unit&) const {}
};
struct EpiMergeAll {
    static constexpr bool PERM = true, AFTER_DRAIN = false, INPLACE = true;
    const bf16_t* gates; bf16_t* merged; int ldg, ldc;
    __device__ __forceinline__ bool inplace(f32x4 (&acc)[2][2][4][2], const Unit& u, int wr, int wc, int fr, int fq) const {
        const int br = u.pm >> 5, pm = u.pm & 31, pn = u.pn & 7;
        const int row0 = pm * BM + wr * 64 + fr; const int col0 = pn * BM + wc * 32 + 8 * fq;
        const bf16_t* gb = gates + br * 2048; const bf16_t* gd = gates + (br < 2 ? br + 1 : 2) * 2048;
        const f32x4 tiny = (f32x4){1e-20f, 1e-20f, 1e-20f, 1e-20f};
        const bool last = br == 2;
#pragma unroll
        for (int am = 0; am < 4; ++am) { const int ai = am >> 1, m0 = (am & 1) * 2;
            u32x4 g[2][2], gn[2][2];
#pragma unroll
            for (int mm = 0; mm < 2; ++mm)
#pragma unroll
                for (int bj = 0; bj < 2; ++bj) { const size_t off = (size_t)(row0 + ai * HALF + (m0 + mm) * 16) * ldg + col0 + bj * HALF;
                    g[mm][bj] = *(const u32x4*)(gb + off); gn[mm][bj] = *(const u32x4*)(gd + off); }
            __builtin_amdgcn_sched_barrier(0);
#pragma unroll
            for (int mm = 0; mm < 2; ++mm)
#pragma unroll
                for (int bj = 0; bj < 2; ++bj) { const int m = m0 + mm; const u32x4 gg = g[mm][bj], gq = gn[mm][bj];
                    f32x4 s0 = (f32x4){bflo(gg.x), bfhi(gg.x), bflo(gg.y), bfhi(gg.y)}, s1 = (f32x4){bflo(gg.z), bfhi(gg.z), bflo(gg.w), bfhi(gg.w)};
                    f32x4 d0 = (f32x4){bflo(gq.x), bfhi(gq.x), bflo(gq.y), bfhi(gq.y)}, d1 = (f32x4){bflo(gq.z), bfhi(gq.z), bflo(gq.w), bfhi(gq.w)};
                    s0 = __builtin_elementwise_max(s0, tiny); s1 = __builtin_elementwise_max(s1, tiny);
                    d0 = __builtin_elementwise_max(d0, tiny); d1 = __builtin_elementwise_max(d1, tiny);
                    if (last) { d0 = (f32x4){1.f, 1.f, 1.f, 1.f}; d1 = d0; }
                    s0 = s0 * (f32x4){__builtin_amdgcn_rcpf(d0[0]), __builtin_amdgcn_rcpf(d0[1]), __builtin_amdgcn_rcpf(d0[2]), __builtin_amdgcn_rcpf(d0[3])};
                    s1 = s1 * (f32x4){__builtin_amdgcn_rcpf(d1[0]), __builtin_amdgcn_rcpf(d1[1]), __builtin_amdgcn_rcpf(d1[2]), __builtin_amdgcn_rcpf(d1[3])};
                    const f32x4 v0 = acc[ai][bj][m][0] * s0, v1 = acc[ai][bj][m][1] * s1;
                    acc[ai][bj][m][0] = v0; acc[ai][bj][m][1] = v1;
                    if (last) { u32x4 w; w.x = cvtpk(v0[0], v0[1]); w.y = cvtpk(v0[2], v0[3]); w.z = cvtpk(v1[0], v1[1]); w.w = cvtpk(v1[2], v1[3]);
                        *(u32x4*)(merged + (size_t)(row0 + ai * HALF + m * 16) * ldc + col0 + bj * HALF) = w; } }
        }
        return !last;
    }
};
struct EpiOut {
    static constexpr bool PERM = true, AFTER_DRAIN = false, INPLACE = false;
    const float* x; float* out; bf16_t* xn2; float* ssq; int ldc; float sscale;
    __device__ __forceinline__ void operator()(const f32x4 (&acc)[2][2][4][2], const Unit& u, int wr, int wc, int fr, int fq) const {
        const int row0 = u.pm * BM + wr * 64 + fr; const int col0 = u.pn * BM + wc * 32 + 8 * fq;
#pragma unroll
        for (int am = 0; am < 4; ++am) { const int ai = am >> 1, m0 = (am & 1) * 2;
            f32x4 xv[2][2][2];
#pragma unroll
            for (int mm = 0; mm < 2; ++mm)
#pragma unroll
                for (int bj = 0; bj < 2; ++bj) { const size_t off = (size_t)(row0 + ai * HALF + (m0 + mm) * 16) * ldc + col0 + bj * HALF;
                    xv[mm][bj][0] = __builtin_nontemporal_load((const f32x4*)(x + off)); xv[mm][bj][1] = __builtin_nontemporal_load((const f32x4*)(x + off + 4)); }
            __builtin_amdgcn_sched_barrier(0);
#pragma unroll
            for (int mm = 0; mm < 2; ++mm) { const int m = m0 + mm; const size_t r = (size_t)(row0 + ai * HALF + m * 16); float rs = 0.f;
#pragma unroll
                for (int bj = 0; bj < 2; ++bj) { const size_t off = r * ldc + col0 + bj * HALF;
                    const f32x4 v0 = acc[ai][bj][m][0] + xv[mm][bj][0], v1 = acc[ai][bj][m][1] + xv[mm][bj][1];
                    rs += (v0[0] * v0[0] + v0[1] * v0[1]) + (v0[2] * v0[2] + v0[3] * v0[3]) + (v1[0] * v1[0] + v1[1] * v1[1]) + (v1[2] * v1[2] + v1[3] * v1[3]);
                    u32x4 w; w.x = cvtpk(v0[0], v0[1]); w.y = cvtpk(v0[2], v0[3]); w.z = cvtpk(v1[0], v1[1]); w.w = cvtpk(v1[2], v1[3]); *(u32x4*)(xn2 + off) = w; }
                rs += __shfl_xor(rs, 16); rs += __shfl_xor(rs, 32);
                if (fq == 0) atomicAdd(ssq + r, rs * sscale); }
        }
    }
};
struct EpiUp {
    static constexpr bool PERM = true, AFTER_DRAIN = false, INPLACE = false;
    const float* ssq; bf16_t* H; int ldc; float inv_d, eps;
    __device__ __forceinline__ void operator()(const f32x4 (&acc)[2][2][4][2], const Unit& u, int wr, int wc, int fr, int fq) const {
        const int row0 = u.pm * BM + wr * 64 + fr; const int col0 = u.pn * BM + wc * 32 + 8 * fq;
        float sq[2][4];
#pragma unroll
        for (int ai = 0; ai < 2; ++ai)
#pragma unroll
            for (int m = 0; m < 4; ++m) sq[ai][m] = ssq[row0 + ai * HALF + m * 16];
        __builtin_amdgcn_sched_barrier(0);
#pragma unroll
        for (int ai = 0; ai < 2; ++ai)
#pragma unroll
            for (int m = 0; m < 4; ++m) { const size_t r = (size_t)(row0 + ai * HALF + m * 16); const float rstd = 1.0f / sqrtf(sq[ai][m] * inv_d + eps);
#pragma unroll
                for (int bj = 0; bj < 2; ++bj) { const int c = col0 + bj * HALF;
                    f32x4 v0 = acc[ai][bj][m][0] * rstd, v1 = acc[ai][bj][m][1] * rstd;
                    v0 = __builtin_elementwise_max(v0, (f32x4){0.f, 0.f, 0.f, 0.f}); v1 = __builtin_elementwise_max(v1, (f32x4){0.f, 0.f, 0.f, 0.f});
                    v0 = v0 * v0; v1 = v1 * v1;
                    u32x4 w; w.x = cvtpk(v0[0], v0[1]); w.y = cvtpk(v0[2], v0[3]); w.z = cvtpk(v1[0], v1[1]); w.w = cvtpk(v1[2], v1[3]); *(u32x4*)(H + r * ldc + c) = w; } }
    }
};
struct EpiDown {
    static constexpr bool PERM = true, AFTER_DRAIN = false, INPLACE = false;
    const bf16_t* x1; float* out; int ldc; float scale;
    __device__ __forceinline__ void operator()(const f32x4 (&acc)[2][2][4][2], const Unit& u, int wr, int wc, int fr, int fq) const {
        const int row0 = u.pm * BM + wr * 64 + fr; const int col0 = u.pn * BM + wc * 32 + 8 * fq;
#pragma unroll
        for (int ai = 0; ai < 2; ++ai) {
            u32x4 g[4][2];
#pragma unroll
            for (int m = 0; m < 4; ++m)
#pragma unroll
                for (int bj = 0; bj < 2; ++bj) g[m][bj] = __builtin_nontemporal_load((const u32x4*)(x1 + (size_t)(row0 + ai * HALF + m * 16) * ldc + col0 + bj * HALF));
            __builtin_amdgcn_sched_barrier(0);
#pragma unroll
            for (int m = 0; m < 4; ++m)
#pragma unroll
                for (int bj = 0; bj < 2; ++bj) { const size_t off = (size_t)(row0 + ai * HALF + m * 16) * ldc + col0 + bj * HALF; const u32x4 gg = g[m][bj];
                    const f32x4 v0 = (f32x4){bflo(gg.x), bfhi(gg.x), bflo(gg.y), bfhi(gg.y)} + acc[ai][bj][m][0] * scale, v1 = (f32x4){bflo(gg.z), bfhi(gg.z), bflo(gg.w), bfhi(gg.w)} + acc[ai][bj][m][1] * scale;
                    __builtin_nontemporal_store(v0, (f32x4*)(out + off)); __builtin_nontemporal_store(v1, (f32x4*)(out + off + 4)); }
        }
    }
};
}

constexpr int NWAVES = 8;
constexpr int DM = 2048, NBATCH = 4, SEQ = 2048, MT = NBATCH * SEQ;
constexpr int MEML = 256, MMEM = NBATCH * MEML;
constexpr int NIN = 11020;
constexpr int NMAIN = 11008;
constexpr int NWIN = 11264;
constexpr int LDP = 4864, LDG = 6144, DFF = 8192;
constexpr float EPS = 1e-6f;
constexpr float LOG2E = 1.4426950408889634f;
constexpr float QSCALE = 0.08838834764831845f * 1.4426950408889634f;
constexpr int PC_DNZ = 2304, PC_SQ = 3072, PC_SK = 3840, PC_MQ = 4096, PC_BA = 4608;
constexpr int P1_CAP = 1232, NTAIL = 1376 - 1232;
constexpr int NCHUNK = NBATCH * 6 * 32;
constexpr int CH_W = 0, CH_QG = 16384, CH_KD = 32768, CH_P = 49152, CH_U = 57344, CH_ZG = 73728, CH_BYTES = 90112;

constexpr size_t MiB = 1u << 20;
constexpr size_t WS_CTL = 0, CTL_ZERO_BYTES = 1 * MiB;
constexpr size_t WS_SSQ = 512 * 1024;
constexpr size_t WS_WOUT = 1 * MiB, WS_PDN = 9 * MiB, WS_PSWA = 12 * MiB, WS_PMEM = 15 * MiB;
constexpr size_t WS_WUP = 18 * MiB, WS_WDN = 50 * MiB;
constexpr size_t WS_RHS = 18 * MiB;
constexpr size_t WS_DNF2 = 82 * MiB;
constexpr size_t DO_WIN = 0, DO_WMKV = 44 * MiB, DO_MEMN = 48 * MiB;
constexpr int DNF_SPLIT = 23 * 32;
static_assert((size_t)DNF_SPLIT * CH_BYTES <= (size_t)64 * MiB && WS_DNF2 + (size_t)32 * CH_BYTES <= 85 * MiB && DO_MEMN + 4 * MiB <= 64 * MiB, "d_out scratch map");
constexpr size_t WS_XN = 85 * MiB;
constexpr size_t WS_PROJ = 117 * MiB;
constexpr size_t WS_ODN = 117 * MiB, WS_OSWA = 129 * MiB, WS_OMEM = 141 * MiB, WS_MERGED = 153 * MiB;
constexpr size_t WS_GATES = 193 * MiB;
constexpr size_t WS_VT = 289 * MiB, WS_MVT = 293 * MiB, WS_MEMK = 294 * MiB;
constexpr size_t WS_QF = 295 * MiB, WS_KF = 307 * MiB, WS_MQF = 311 * MiB, WS_MKF = 319 * MiB, WS_GC = 320 * MiB, WS_LG = 321 * MiB, WS_WTAIL = 328 * MiB;
constexpr size_t WS_H = 117 * MiB;
constexpr size_t WS_END = 334 * MiB;
static_assert(WS_PROJ + (size_t)MT * LDP * 2 <= WS_GATES && WS_GATES + (size_t)MT * LDG * 2 <= WS_VT, "ws map");
static_assert(WS_H + (size_t)MT * DFF * 2 <= WS_VT, "ws map 2");
constexpr int CW_BAR = 4096;

constexpr int RING_OFF = 0, RING_BYTES = 131072;
constexpr int LDS_BYTES = 147456;
constexpr int LDSCTL_OFF = LDS_BYTES - 1024, MISC_OFF = LDSCTL_OFF + 320;
#define GAS __attribute__((address_space(1)))
#define LAS __attribute__((address_space(3)))
typedef unsigned short bf16;
typedef unsigned v4u __attribute__((ext_vector_type(4)));
typedef float f32x4 __attribute__((ext_vector_type(4)));
typedef short bf16x8 __attribute__((ext_vector_type(8)));
typedef GAS unsigned gu32;
typedef GAS unsigned long long gu64;
#define RLX_AGENT __ATOMIC_RELAXED, __HIP_MEMORY_SCOPE_AGENT
#define LDS_WAIT() asm volatile("s_waitcnt lgkmcnt(0)" ::: "memory")
#define VM_WAIT() asm volatile("s_waitcnt vmcnt(0)" ::: "memory")
__device__ __forceinline__ unsigned long long rt() { return __builtin_amdgcn_s_memrealtime(); }
__device__ __forceinline__ unsigned f2bf(float f) { unsigned u = __builtin_bit_cast(unsigned, f); return (u + 0x7fffu + ((u >> 16) & 1u)) >> 16; }
__device__ __forceinline__ unsigned pk2(float lo, float hi) { return f2bf(lo) | (f2bf(hi) << 16); }

#define XB_TMO      128
#define XB_XCNT(j)  (256  + 64 * (j))
#define XB_XSUB(j)  (1280 + 64 * (j))
#define XB_XGEN(j)  (2304 + 64 * (j))
#define XB_TOP      3328
#define XB_TOPGEN   3392
#define XCD_BAR_WORDS 3456
#define XB_SPIN_CAP (1u << 18)

__device__ __forceinline__ unsigned xb_ld(unsigned* p)              { return __hip_atomic_load(p, __ATOMIC_RELAXED, __HIP_MEMORY_SCOPE_AGENT); }
__device__ __forceinline__ unsigned xb_add(unsigned* p, unsigned v) { return __hip_atomic_fetch_add(p, v, __ATOMIC_RELAXED, __HIP_MEMORY_SCOPE_AGENT); }
__device__ __forceinline__ unsigned xb_xcc_id() { return (unsigned)__builtin_amdgcn_s_getreg((3 << 11) | 20) & 0xFu; }
#define XB_SPIN(cond, bar) do { unsigned _sp = 0; while (cond) { __builtin_amdgcn_s_sleep(1); \
    if ((++_sp & 255u) == 0u) { if (xb_ld(&(bar)[XB_TMO])) break; if (_sp > XB_SPIN_CAP) { atomicAdd(&(bar)[XB_TMO], 1u); break; } } } } while (0)

struct XcdBarrier {
    unsigned* bar; unsigned x;
    volatile LAS unsigned* st;
};

__device__ __forceinline__ XcdBarrier xcd_barrier_post(unsigned* bar, volatile LAS unsigned* st) {
    XcdBarrier b; b.bar = bar; b.x = xb_xcc_id(); b.st = st;
    if (threadIdx.x == 0) (void)xb_add(&bar[XB_XCNT(b.x)], 1u);
    return b;
}
__device__ __forceinline__ void xcd_barrier_complete(unsigned* bar, unsigned x, unsigned& nloc, unsigned& nx) {
    const unsigned G = gridDim.x * gridDim.y * gridDim.z;
    unsigned sum, cnt, mine, sp = 0u;
    for (;;) {
        sum = 0u; cnt = 0u; mine = 0u;
#pragma unroll
        for (unsigned j = 0; j < 16; ++j) { const unsigned c = xb_ld(&bar[XB_XCNT(j)]); sum += c; cnt += (c > 0u) ? 1u : 0u; mine = (j == x) ? c : mine; }
        if (sum == G) break;
        __builtin_amdgcn_s_sleep(1);
        if ((++sp & 255u) == 0u) { if (xb_ld(&bar[XB_TMO])) break; if (sp > XB_SPIN_CAP) { atomicAdd(&bar[XB_TMO], 1u); break; } }
    }
    nloc = mine > 0u ? mine : 1u; nx = cnt > 0u ? cnt : 1u;
}

__device__ __forceinline__ void xcd_barrier(const XcdBarrier& b) {
    asm volatile("s_waitcnt vmcnt(0)" ::: "memory");
    __syncthreads();
    if (threadIdx.x == 0) {
        unsigned* bar = b.bar;
        __builtin_amdgcn_s_waitcnt(0);
        unsigned nloc = b.st[0], nx = b.st[1];
        if (nloc == 0u) { xcd_barrier_complete(bar, b.x, nloc, nx); b.st[0] = nloc; b.st[1] = nx; }
        const unsigned old = xb_add(&bar[XB_XSUB(b.x)], 1u);
        const unsigned gen = old / nloc;
        if (old + 1u == (gen + 1u) * nloc) {
            __builtin_amdgcn_fence(__ATOMIC_RELEASE, "agent");
            asm volatile("s_waitcnt vmcnt(0)" ::: "memory");
            const unsigned og = xb_add(&bar[XB_TOP], 1u);
            const unsigned tg = og / nx;
            if (og + 1u == (tg + 1u) * nx) xb_add(&bar[XB_TOPGEN], 1u);
            else XB_SPIN(xb_ld(&bar[XB_TOPGEN]) == tg, bar);
            __builtin_amdgcn_fence(__ATOMIC_ACQUIRE, "agent");
            xb_add(&bar[XB_XGEN(b.x)], 1u);
            asm volatile("s_waitcnt vmcnt(0)" ::: "memory");
        } else {
            XB_SPIN(xb_ld(&bar[XB_XGEN(b.x)]) == gen, bar);
            __builtin_amdgcn_fence(__ATOMIC_ACQUIRE, "agent");
            asm volatile("s_waitcnt vmcnt(0)" ::: "memory");
        }
    }
    __syncthreads();
}

typedef unsigned v2u __attribute__((ext_vector_type(2)));
typedef float f32x16 __attribute__((ext_vector_type(16)));
using pg8::cvtpk; using pg8::bflo; using pg8::bfhi;
__device__ __forceinline__ float bf2f(unsigned short b) { return __builtin_bit_cast(float, (unsigned)b << 16); }
__device__ __forceinline__ float wave_sum(float v) {
#pragma unroll
    for (int o = 1; o < 64; o <<= 1) v += __shfl_xor(v, o);
    return v;
}
__device__ __forceinline__ bf16x8 pack8(f32x4 a, f32x4 b) {
    v4u w; w.x = cvtpk(a[0], a[1]); w.y = cvtpk(a[2], a[3]); w.z = cvtpk(b[0], b[1]); w.w = cvtpk(b[2], b[3]);
    return __builtin_bit_cast(bf16x8, w);
}
__device__ __forceinline__ float siluf(float y) { return y * __builtin_amdgcn_rcpf(1.0f + __expf(-y)); }

struct DnfMap { unsigned char* a; unsigned char* b; __device__ __forceinline__ unsigned char* rec(int chunk) const { return chunk < DNF_SPLIT ? a + (size_t)chunk * CH_BYTES : b + (size_t)(chunk - DNF_SPLIT) * CH_BYTES; } };
template <int MODE> __device__ __forceinline__ int colmap(int nr_in) {
    int nr = nr_in;
    if (MODE == 0) return nr;
    if (MODE == 2) nr += 38 * 256;
    if (nr < 3072) return nr;
    if (nr < 4096) return nr + 12;
    if (nr < 4608) return nr + 268;
    if (nr < 4620) return nr - 4608 + 3072;
    if (nr < 4864) return -1;
    if (nr < 11008) return nr + 12;
    return nr - 11008 + 4108;
}
template <int MODE> __device__ __forceinline__ void tr_load(const float* W, int N, int item, int nblk, int lane, f32x4 (&v)[8]) {
    const int kb = item / nblk, nb = item % nblk, n4 = lane & 7, g = lane >> 3;
    const int kk0 = 64 * kb + 8 * g, n = 32 * nb + 4 * n4;
    const int src = colmap<MODE>(n); const int srcc = src < 0 ? 0 : src;
    const GAS f32x4* p = (const GAS f32x4*)(W + (size_t)kk0 * N + srcc);
#pragma unroll
    for (int i = 0; i < 8; ++i) v[i] = __builtin_nontemporal_load(p + (size_t)i * (N / 4));
}
template <int MODE> __device__ __forceinline__ void tr_store(const float* kscale, bf16* WT, int ldt, int item, int nblk, int lane, f32x4 (&v)[8]) {
    const int kb = item / nblk, nb = item % nblk, n4 = lane & 7, g = lane >> 3;
    const int kk0 = 64 * kb + 8 * g, n = 32 * nb + 4 * n4;
    if (colmap<MODE>(n) < 0) {
#pragma unroll
        for (int i = 0; i < 8; ++i) v[i] = (f32x4){0.f, 0.f, 0.f, 0.f}; }
    if (kscale) { const f32x4 s0 = *(const GAS f32x4*)(kscale + kk0), s1 = *(const GAS f32x4*)(kscale + kk0 + 4);
        v[0] = v[0] * s0.x; v[1] = v[1] * s0.y; v[2] = v[2] * s0.z; v[3] = v[3] * s0.w; v[4] = v[4] * s1.x; v[5] = v[5] * s1.y; v[6] = v[6] * s1.z; v[7] = v[7] * s1.w; }
#pragma unroll
    for (int e = 0; e < 4; ++e) { v4u o; o.x = cvtpk(v[0][e], v[1][e]); o.y = cvtpk(v[2][e], v[3][e]); o.z = cvtpk(v[4][e], v[5][e]); o.w = cvtpk(v[6][e], v[7][e]);
        *(GAS v4u*)(WT + (size_t)(n + e) * ldt + kk0) = o; }
}
template <int MODE> __device__ __forceinline__ void transpose_matrix(const float* W, int K, int N, const float* kscale, bf16* WT, int ldt, int nrows, int gw, int NGW, int lane) {
    const int nblk = nrows / 32, nitems = (K / 64) * nblk;
    for (int it = gw; it < nitems; it += 4 * NGW) {
        f32x4 va[8], vb[8], vc[8], vd[8]; const int it2 = it + NGW, it3 = it + 2 * NGW, it4 = it + 3 * NGW;
        tr_load<MODE>(W, N, it, nblk, lane, va);
        if (it2 < nitems) tr_load<MODE>(W, N, it2, nblk, lane, vb);
        if (it3 < nitems) tr_load<MODE>(W, N, it3, nblk, lane, vc);
        if (it4 < nitems) tr_load<MODE>(W, N, it4, nblk, lane, vd);
        tr_store<MODE>(kscale, WT, ldt, it, nblk, lane, va);
        if (it2 < nitems) tr_store<MODE>(kscale, WT, ldt, it2, nblk, lane, vb);
        if (it3 < nitems) tr_store<MODE>(kscale, WT, ldt, it3, nblk, lane, vc);
        if (it4 < nitems) tr_store<MODE>(kscale, WT, ldt, it4, nblk, lane, vd);
    }
}
__device__ __forceinline__ void rms_load(const float* xrow, int lane, f32x4 (&v)[8]) {
    const GAS f32x4* xr = (const GAS f32x4*)xrow + lane;
#pragma unroll
    for (int j = 0; j < 8; ++j) v[j] = __builtin_nontemporal_load(xr + 64 * j);
}
__device__ __forceinline__ void rms_finish(const float* w, bf16* orow, int lane, f32x4 (&v)[8]) {
    const GAS f32x4* wr = (const GAS f32x4*)w + lane; float s = 0.f;
#pragma unroll
    for (int j = 0; j < 8; ++j) s += (v[j].x * v[j].x + v[j].y * v[j].y) + (v[j].z * v[j].z + v[j].w * v[j].w);
    const float rstd = 1.0f / sqrtf(wave_sum(s) * (1.0f / DM) + EPS);
    GAS v2u* o8 = (GAS v2u*)orow + lane;
#pragma unroll
    for (int j = 0; j < 8; ++j) { const f32x4 ww = wr[64 * j]; v2u o; o.x = cvtpk(v[j].x * rstd * ww.x, v[j].y * rstd * ww.y); o.y = cvtpk(v[j].z * rstd * ww.z, v[j].w * rstd * ww.w); o8[64 * j] = o; }
}

__device__ __forceinline__ void normfrag_item(const bf16* src, int ld, int row0, int col0, const float* wt, float scale, unsigned char* dst, int lane) {
    const int r = lane & 31, h = lane >> 5;
    const bf16* rp = src + (size_t)(row0 + r) * ld + col0 + 8 * h;
    v4u raw[8]; f32x4 w0[8], w1[8]; float ss = 0.f;
#pragma unroll
    for (int s = 0; s < 8; ++s) { raw[s] = *(const GAS v4u*)(rp + 16 * s); w0[s] = *(const GAS f32x4*)(wt + 16 * s + 8 * h); w1[s] = *(const GAS f32x4*)(wt + 16 * s + 8 * h + 4); }
    __builtin_amdgcn_sched_barrier(0);
#pragma unroll
    for (int s = 0; s < 8; ++s) {
        const float a0 = bflo(raw[s].x), a1 = bfhi(raw[s].x), a2 = bflo(raw[s].y), a3 = bfhi(raw[s].y), a4 = bflo(raw[s].z), a5 = bfhi(raw[s].z), a6 = bflo(raw[s].w), a7 = bfhi(raw[s].w);
        ss += (a0 * a0 + a1 * a1) + (a2 * a2 + a3 * a3) + (a4 * a4 + a5 * a5) + (a6 * a6 + a7 * a7); }
    ss += __shfl_xor(ss, 32);
    const float rstd = scale / sqrtf(ss * (1.0f / 128.0f) + EPS);
#pragma unroll
    for (int s = 0; s < 8; ++s) {
        v4u o; o.x = cvtpk(bflo(raw[s].x) * rstd * w0[s].x, bfhi(raw[s].x) * rstd * w0[s].y); o.y = cvtpk(bflo(raw[s].y) * rstd * w0[s].z, bfhi(raw[s].y) * rstd * w0[s].w);
        o.z = cvtpk(bflo(raw[s].z) * rstd * w1[s].x, bfhi(raw[s].z) * rstd * w1[s].y); o.w = cvtpk(bflo(raw[s].w) * rstd * w1[s].z, bfhi(raw[s].w) * rstd * w1[s].w);
        *(GAS v4u*)(dst + (size_t)(s * 64 + lane) * 16) = o; }
}

constexpr int DP_LD = 132, DP_LL = 68;
constexpr int DP_Q = 0, DP_K = 64 * DP_LD, DP_V = 2 * 64 * DP_LD, DP_L = 3 * 64 * DP_LD, DP_S = DP_L + 64 * DP_LL;
struct DnIn { const bf16* proj; const float* convw; const float* alog; const float* dtb; DnfMap dnf; float* gc; unsigned char* lg; unsigned char* rhs; };

__device__ __forceinline__ void dn_conv_issue(const DnIn& I, int chunk, int tid, unsigned (&uraw)[35]) {
    if (tid < 384) {
        const int b = chunk / 192, h = (chunk / 32) % 6, n = chunk & 31;
        const int ch2 = tid % 192, tg = tid / 192, which = ch2 >> 6, cp = ch2 & 63;
        const int gcol = which * 768 + h * 128 + 2 * cp;
        const int p0 = 64 * n + 32 * tg - 3;
        const bf16* src = I.proj + ((long)(b * SEQ + p0) * LDP + gcol);
#pragma unroll
        for (int i = 0; i < 35; ++i) { const int ic = (p0 + i >= 0) ? i : -p0;
            uraw[i] = *(const GAS unsigned*)(src + (long)ic * LDP); }
    }
}
__device__ __forceinline__ void dn_prep_chunk(const DnIn& I, LAS float* L, int chunk, int next_chunk, int tid_in, unsigned (&uraw)[35]) {
    int tz; asm volatile("v_mov_b32 %0, 0" : "=v"(tz));
    const int tid = tid_in + tz;
    const int lane = tid & 63, wave = __builtin_amdgcn_readfirstlane(tid >> 6);
    const int b = chunk / 192, h = (chunk / 32) % 6, n = chunk & 31;
    const int t0 = b * SEQ + 64 * n;
    LAS float* QS = L + DP_Q; LAS float* KS = L + DP_K; LAS float* VS = L + DP_V; LAS float* LM = L + DP_L;
    LAS float* sb = L + DP_S; LAS float* sG = sb + 64; LAS float* seG = sb + 128; LAS float* srq = sb + 192; LAS float* srk = sb + 256;
    unsigned char* rec = I.dnf.rec(chunk);
    unsigned short zraw[4][4];
    { const int c = lane & 15, q = lane >> 4;
#pragma unroll
      for (int f = 0; f < 4; ++f) { const int fi = wave * 4 + f, sl = fi >> 2, mt = fi & 3;
#pragma unroll
          for (int r = 0; r < 4; ++r) zraw[f][r] = I.proj[(size_t)(t0 + 16 * mt + 4 * q + r) * LDP + PC_DNZ + h * 128 + 16 * sl + c]; } }
    if (tid < 384) {
        const int ch2 = tid % 192, tg = tid / 192, which = ch2 >> 6, cp = ch2 & 63;
        const int gcol = which * 768 + h * 128 + 2 * cp;
        float w0[4], w1[4];
#pragma unroll
        for (int k = 0; k < 4; ++k) { w0[k] = I.convw[k * 2304 + gcol]; w1[k] = I.convw[k * 2304 + gcol + 1]; }
        const int p0 = 64 * n + 32 * tg - 3;
        float xa[35], xb[35];
#pragma unroll
        for (int i = 0; i < 35; ++i) { unsigned u = uraw[i]; if (p0 + i < 0) u = 0u; xa[i] = bflo(u); xb[i] = bfhi(u); }
        if (next_chunk < NCHUNK) dn_conv_issue(I, next_chunk, tid, uraw);
        LAS float* dst = L + which * 64 * DP_LD + (32 * tg) * DP_LD + 2 * cp;
#pragma unroll
        for (int j = 0; j < 32; ++j) {
            const float ya = (w0[0] * xa[j] + w0[1] * xa[j + 1]) + (w0[2] * xa[j + 2] + w0[3] * xa[j + 3]);
            const float yb = (w1[0] * xb[j] + w1[1] * xb[j + 1]) + (w1[2] * xb[j + 2] + w1[3] * xb[j + 3]);
            dst[j * DP_LD] = siluf(ya); dst[j * DP_LD + 1] = siluf(yb); if ((j & 7) == 7) asm volatile("" ::: "memory"); }
    } else if (tid >= 448) {
        const int i = lane;
        const bf16* pr = I.proj + (size_t)(t0 + i) * LDP + PC_BA;
        const float bb = bf2f(pr[h]), aa = bf2f(pr[6 + h]);
        const float beta = 1.0f / (1.0f + __expf(-bb));
        const float xx = aa + I.dtb[h];
        const float sp = xx > 20.f ? xx : log1pf(__expf(xx));
        float g = -__expf(I.alog[h]) * sp;
#pragma unroll
        for (int o = 1; o < 64; o <<= 1) { const float t = __shfl_up(g, o); if (lane >= o) g += t; }
        sb[i] = beta; sG[i] = g; seG[i] = __expf(g);
        if (i == 63) I.gc[chunk] = __expf(g);
    }
    __syncthreads();
    {
        const int row = tid >> 2, part = tid & 3, which = row >> 6, i = row & 63;
        const LAS float* p = L + which * 64 * DP_LD + i * DP_LD + 32 * part;
        float ss = 0.f;
#pragma unroll
        for (int k = 0; k < 8; ++k) { const f32x4 v = *(const LAS f32x4*)(p + 4 * k); ss += (v.x * v.x + v.y * v.y) + (v.z * v.z + v.w * v.w); }
        ss += __shfl_xor(ss, 1); ss += __shfl_xor(ss, 2);
        if (part == 0) { if (which == 0) srq[i] = 0.08838834764831845f / sqrtf(ss + EPS); else srk[i] = 1.0f / sqrtf(ss + EPS); }
    }
    __syncthreads();
    for (int e = tid; e < 2 * 64 * 64; e += 512) {
        const int which = e >> 12, i = (e >> 6) & 63, c2 = e & 63;
        LAS float* p = L + which * 64 * DP_LD + i * DP_LD + 2 * c2; const float sc = which ? srk[i] : srq[i];
        p[0] *= sc; p[1] *= sc; }
    __syncthreads();
    {
        const int it = wave & 3, c = lane & 15, q = lane >> 4; const bool isP = wave >= 4;
        const LAS float* X = isP ? QS : KS;
        bf16x8 bfr[4];
#pragma unroll
        for (int s = 0; s < 4; ++s) { const LAS float* p = X + (16 * it + c) * DP_LD + 32 * s + 8 * q; bfr[s] = pack8(*(const LAS f32x4*)p, *(const LAS f32x4*)(p + 4)); }
        f32x4 ct[4];
#pragma unroll
        for (int jt = 0; jt < 4; ++jt) { ct[jt] = (f32x4){0.f, 0.f, 0.f, 0.f};
            if (jt <= it) {
#pragma unroll
                for (int s = 0; s < 4; ++s) { const LAS float* p = KS + (16 * jt + c) * DP_LD + 32 * s + 8 * q; const bf16x8 af = pack8(*(const LAS f32x4*)p, *(const LAS f32x4*)(p + 4));
                    ct[jt] = __builtin_amdgcn_mfma_f32_16x16x32_bf16(af, bfr[s], ct[jt], 0, 0, 0); } } }
        const int i = 16 * it + c; const float Gi = sG[i], bi = sb[i];
        if (!isP) {
#pragma unroll
            for (int jt = 0; jt < 4; ++jt) if (jt <= it) { f32x4 o;
#pragma unroll
                for (int r = 0; r < 4; ++r) { const int j = 16 * jt + 4 * q + r; o[r] = (i > j) ? bi * ct[jt][r] * __expf(Gi - sG[j]) : 0.f; }
                const int j4 = 4 * jt + q, a = (i - 1) >> 2, bb = (i - 1) & 3;
                if (i >= 1 && j4 <= a) *(LAS f32x4*)(LM + 4 * ((a + 1) * (2 * a + bb) + j4)) = o; }
        } else {
#pragma unroll
            for (int s = 0; s < 2; ++s) { f32x4 lo, hi;
#pragma unroll
                for (int r = 0; r < 4; ++r) { const int j0 = 32 * s + 4 * q + r, j1 = j0 + 16;
                    lo[r] = (i >= j0) ? ct[2 * s][r] * __expf(Gi - sG[j0]) : 0.f; hi[r] = (i >= j1) ? ct[2 * s + 1][r] * __expf(Gi - sG[j1]) : 0.f; }
                *(GAS bf16x8*)(rec + CH_P + (size_t)((it * 2 + s) * 64 + lane) * 16) = pack8(lo, hi); }
        }
    }
    __syncthreads();
    {
        const int c = lane & 15, q = lane >> 4; const float G63 = sG[63];
#pragma unroll
        for (int f = 0; f < 2; ++f) { const int fi = wave * 2 + f, mt = fi >> 2, s = fi & 3;
            const int i = 16 * mt + c; const float e = seG[i]; const LAS float* p = QS + i * DP_LD + 32 * s + 4 * q;
            const f32x4 lo = *(const LAS f32x4*)p * e, hi = *(const LAS f32x4*)(p + 16) * e;
            *(GAS bf16x8*)(rec + CH_QG + (size_t)(fi * 64 + lane) * 16) = pack8(lo, hi); }
#pragma unroll
        for (int f = 0; f < 2; ++f) { const int fi = wave * 2 + f, mt = fi >> 1, s = fi & 1;
            const int dk = 16 * mt + c; f32x4 lo, hi;
#pragma unroll
            for (int r = 0; r < 4; ++r) { const int p0 = 32 * s + 4 * q + r, p1 = p0 + 16; lo[r] = KS[p0 * DP_LD + dk] * __expf(G63 - sG[p0]); hi[r] = KS[p1 * DP_LD + dk] * __expf(G63 - sG[p1]); }
            *(GAS bf16x8*)(rec + CH_KD + (size_t)(fi * 64 + lane) * 16) = pack8(lo, hi); }
    }
    {
        for (int t = tid; t < 528; t += 512) *(GAS f32x4*)(I.lg + (size_t)chunk * 8448 + (size_t)t * 16) = *(const LAS f32x4*)(LM + 4 * t);
#pragma unroll
        for (int e = 0; e < 4; ++e) { const int gi = tid + 512 * e, i = gi >> 5, c8 = (gi & 31) * 8;
            const bool isk = c8 >= 128; const LAS float* p = (isk ? KS : VS) + i * DP_LD + (c8 & 127);
            const float sc = sb[i] * (isk ? seG[i] : 1.0f);
            const f32x4 a = *(const LAS f32x4*)p * sc, bq = *(const LAS f32x4*)(p + 4) * sc;
            *(GAS bf16x8*)(I.rhs + ((size_t)chunk * 64 + i) * 512 + c8 * 2) = pack8(a, bq); }
        const int c = lane & 15, q = lane >> 4;
#pragma unroll
        for (int f = 0; f < 4; ++f) { const int fi = wave * 4 + f, sl = fi >> 2, mt = fi & 3;
            v2u zo; float zz[4];
#pragma unroll
            for (int r = 0; r < 4; ++r) zz[r] = siluf(bf2f(zraw[f][r]));
            zo.x = cvtpk(zz[0], zz[1]); zo.y = cvtpk(zz[2], zz[3]);
            *(GAS v2u*)(rec + CH_ZG + (size_t)(fi * 64 + lane) * 8) = zo; }
    }
    __syncthreads();
}

__device__ __forceinline__ void dn_solve_item(const unsigned char* lg, const unsigned char* rhs, const DnfMap& dnf, LAS float* Lw, int item, int lane) {
    const int chunk = item >> 2, g = item & 3;
    const unsigned char* lsrc = lg + (size_t)chunk * 8448;
#pragma unroll
    for (int k = 0; k < 9; ++k) { const int t = lane + 64 * k; const int tc = t < 528 ? t : 527; const f32x4 v = *(const GAS f32x4*)(lsrc + (size_t)tc * 16); if (t < 528) *(LAS f32x4*)(Lw + 4 * t) = v; }
    const bf16* rp = (const bf16*)(rhs + (size_t)chunk * 64 * 512) + 64 * g + lane;
    float X[64];
    unsigned short xr[64];
#pragma unroll
    for (int i = 0; i < 64; ++i) xr[i] = rp[i * 256];
    __builtin_amdgcn_sched_barrier(0);
#pragma unroll
    for (int i = 0; i < 64; ++i) X[i] = bf2f(xr[i]);
    asm volatile("s_waitcnt vmcnt(0) lgkmcnt(0)" ::: "memory");
    int vz; asm volatile("v_mov_b32 %0, 0" : "=v"(vz));
    const LAS float* LMv = Lw + vz;
    f32x4 ring[8];
#pragma unroll
    for (int t = 0; t < 8; ++t) ring[t] = *(const LAS f32x4*)(LMv + 4 * t);
    int t = 0;
#pragma unroll
    for (int i = 1; i < 64; ++i) {
        float acc = X[i];
#pragma unroll
        for (int j4 = 0; j4 < (i + 3) / 4; ++j4) { const f32x4 l = ring[t & 7];
            if (t + 8 < 528) ring[t & 7] = *(const LAS f32x4*)(LMv + 4 * (t + 8));
#pragma unroll
            for (int jj = 0; jj < 4; ++jj) { const int j = 4 * j4 + jj; if (j < i) acc -= l[jj] * X[j]; }
            ++t; }
        X[i] = acc; asm volatile("" ::: "memory"); }
    unsigned char* rec = dnf.rec(chunk);
    if (g < 2) {
        const int dv = 64 * g + lane, sl = dv >> 4, c = dv & 15;
        bf16* base = (bf16*)(rec + CH_U) + (size_t)(sl * 4) * 256 + c * 4;
#pragma unroll
        for (int i = 0; i < 64; ++i) base[(i >> 4) * 256 + ((i & 15) >> 2) * 64 + (i & 3)] = (bf16)(cvtpk(X[i], 0.f) & 0xffffu);
    } else {
        const int dk = 64 * (g - 2) + lane, s = dk >> 5, o = dk & 31, qq = (o & 15) >> 2, j = ((o >> 4) << 2) + (o & 3);
        bf16* base = (bf16*)(rec + CH_W) + (size_t)s * 512 + qq * 128 + j;
#pragma unroll
        for (int i = 0; i < 64; ++i) base[(i >> 4) * 2048 + (i & 15) * 8] = (bf16)(cvtpk(-X[i], 0.f) & 0xffffu);
    }
}

constexpr int SC_BUF = 57344, SC_RED = 2 * SC_BUF, SC_RS = SC_RED + 2048;
#define LDS_BAR() do { asm volatile("s_waitcnt lgkmcnt(0)" ::: "memory"); __builtin_amdgcn_s_barrier(); asm volatile("" ::: "memory"); } while (0)
template <int CTRL> __device__ __forceinline__ float dpp_t(float v) { return __builtin_bit_cast(float, __builtin_amdgcn_update_dpp(0, __builtin_bit_cast(int, v), CTRL, 0xf, 0xf, true)); }
#define dpp_f(v, ctrl) dpp_t<ctrl>(v)
__device__ __forceinline__ float row16_sum(float v) { v += dpp_t<0xB1>(v); v += dpp_t<0x4E>(v); v += dpp_t<0x141>(v); v += dpp_t<0x140>(v); return v; }
__device__ __forceinline__ f32x4 row16_sum4(f32x4 v) {
    float a = v[0], b = v[1], c = v[2], d = v[3];
    asm volatile("s_nop 1\n\t"
        "v_add_f32_dpp %0, %0, %0 quad_perm:[1,0,3,2] row_mask:0xf bank_mask:0xf\n\tv_add_f32_dpp %1, %1, %1 quad_perm:[1,0,3,2] row_mask:0xf bank_mask:0xf\n\t"
        "v_add_f32_dpp %2, %2, %2 quad_perm:[1,0,3,2] row_mask:0xf bank_mask:0xf\n\tv_add_f32_dpp %3, %3, %3 quad_perm:[1,0,3,2] row_mask:0xf bank_mask:0xf\n\t"
        "v_add_f32_dpp %0, %0, %0 quad_perm:[2,3,0,1] row_mask:0xf bank_mask:0xf\n\tv_add_f32_dpp %1, %1, %1 quad_perm:[2,3,0,1] row_mask:0xf bank_mask:0xf\n\t"
        "v_add_f32_dpp %2, %2, %2 quad_perm:[2,3,0,1] row_mask:0xf bank_mask:0xf\n\tv_add_f32_dpp %3, %3, %3 quad_perm:[2,3,0,1] row_mask:0xf bank_mask:0xf\n\t"
        "v_add_f32_dpp %0, %0, %0 row_half_mirror row_mask:0xf bank_mask:0xf\n\tv_add_f32_dpp %1, %1, %1 row_half_mirror row_mask:0xf bank_mask:0xf\n\t"
        "v_add_f32_dpp %2, %2, %2 row_half_mirror row_mask:0xf bank_mask:0xf\n\tv_add_f32_dpp %3, %3, %3 row_half_mirror row_mask:0xf bank_mask:0xf\n\t"
        "v_add_f32_dpp %0, %0, %0 row_mirror row_mask:0xf bank_mask:0xf\n\tv_add_f32_dpp %1, %1, %1 row_mirror row_mask:0xf bank_mask:0xf\n\t"
        "v_add_f32_dpp %2, %2, %2 row_mirror row_mask:0xf bank_mask:0xf\n\tv_add_f32_dpp %3, %3, %3 row_mirror row_mask:0xf bank_mask:0xf\n\ts_nop 1"
        : "+v"(a), "+v"(b), "+v"(c), "+v"(d));
    return (f32x4){a, b, c, d};
}
struct ScanIn { DnfMap dnf; const float* gc; const float* onw; bf16* odn; int popt; };
__device__ __forceinline__ void dn_scan(const ScanIn& I, LAS unsigned char* lds, int bh, int tid) {
    const int lane = tid & 63, sl = __builtin_amdgcn_readfirstlane(tid >> 6), c = lane & 15, q = lane >> 4;
    const int b = bh / 6, h = bh % 6;
    const unsigned char* rec0 = I.dnf.rec(bh * 32);
    LAS float* red = (LAS float*)(lds + SC_RED); LAS float* rsv = (LAS float*)(lds + SC_RS);
    const float onw = I.onw[16 * sl + c];
    const float gc_all = I.gc[bh * 32 + (lane & 31)];
    f32x4 S[8];
#pragma unroll
    for (int i = 0; i < 8; ++i) S[i] = (f32x4){0.f, 0.f, 0.f, 0.f};
    v2u Ucur[4], Zcur[4], Unxt[4], Znxt[4];
#pragma unroll
    for (int i = 0; i < 7; ++i) __builtin_amdgcn_global_load_lds((const unsigned*)(rec0 + (size_t)(sl * 7 + i) * 1024 + lane * 16), (LAS unsigned*)(lds + (sl * 7 + i) * 1024), 16, 0, 0);
#pragma unroll
    for (int mt = 0; mt < 4; ++mt) { Unxt[mt] = *(const GAS v2u*)(rec0 + CH_U + (size_t)((sl * 4 + mt) * 64 + lane) * 8); Znxt[mt] = *(const GAS v2u*)(rec0 + CH_ZG + (size_t)((sl * 4 + mt) * 64 + lane) * 8); }
    for (int n = 0; n < 32; ++n) {
        VM_WAIT(); __syncthreads();
#pragma unroll
        for (int mt = 0; mt < 4; ++mt) { Ucur[mt] = Unxt[mt]; Zcur[mt] = Znxt[mt]; }
        const float gcv = __builtin_bit_cast(float, __builtin_amdgcn_readlane(__builtin_bit_cast(int, gc_all), n));
        if (n + 1 < 32) {
            const unsigned char* rec = rec0 + (size_t)(n + 1) * CH_BYTES; LAS unsigned char* dstb = lds + ((n + 1) & 1) * SC_BUF;
#pragma unroll
            for (int i = 0; i < 7; ++i) __builtin_amdgcn_global_load_lds((const unsigned*)(rec + (size_t)(sl * 7 + i) * 1024 + lane * 16), (LAS unsigned*)(dstb + (sl * 7 + i) * 1024), 16, 0, 0);
#pragma unroll
            for (int mt = 0; mt < 4; ++mt) { Unxt[mt] = *(const GAS v2u*)(rec + CH_U + (size_t)((sl * 4 + mt) * 64 + lane) * 8); Znxt[mt] = *(const GAS v2u*)(rec + CH_ZG + (size_t)((sl * 4 + mt) * 64 + lane) * 8); }
        }
        const LAS unsigned char* fb = lds + (n & 1) * SC_BUF + lane * 16;
        bf16x8 Sb[4];
#pragma unroll
        for (int s = 0; s < 4; ++s) Sb[s] = pack8(S[2 * s], S[2 * s + 1]);
        f32x4 d[4], o[4];
#pragma unroll
        for (int mt = 0; mt < 4; ++mt) { d[mt] = (f32x4){bflo(Ucur[mt].x), bfhi(Ucur[mt].x), bflo(Ucur[mt].y), bfhi(Ucur[mt].y)}; o[mt] = (f32x4){0.f, 0.f, 0.f, 0.f}; }
#pragma unroll
        for (int mt = 0; mt < 4; ++mt)
#pragma unroll
            for (int s = 0; s < 4; ++s) {
                d[mt] = __builtin_amdgcn_mfma_f32_16x16x32_bf16(*(const LAS bf16x8*)(fb + CH_W + (mt * 4 + s) * 1024), Sb[s], d[mt], 0, 0, 0);
                o[mt] = __builtin_amdgcn_mfma_f32_16x16x32_bf16(*(const LAS bf16x8*)(fb + CH_QG + (mt * 4 + s) * 1024), Sb[s], o[mt], 0, 0, 0); }
        bf16x8 Db[2];
#pragma unroll
        for (int s = 0; s < 2; ++s) Db[s] = pack8(d[2 * s], d[2 * s + 1]);
#pragma unroll
        for (int mt = 0; mt < 4; ++mt)
#pragma unroll
            for (int s = 0; s < 2; ++s) o[mt] = __builtin_amdgcn_mfma_f32_16x16x32_bf16(*(const LAS bf16x8*)(fb + CH_P + (mt * 2 + s) * 1024), Db[s], o[mt], 0, 0, 0);
#pragma unroll
        for (int mt = 0; mt < 8; ++mt) { S[mt] = S[mt] * gcv;
#pragma unroll
            for (int s = 0; s < 2; ++s) S[mt] = __builtin_amdgcn_mfma_f32_16x16x32_bf16(*(const LAS bf16x8*)(fb + CH_KD + (mt * 2 + s) * 1024), Db[s], S[mt], 0, 0, 0); }
#pragma unroll
        for (int mt = 0; mt < 4; ++mt) { f32x4 ss = o[mt] * o[mt];
            ss = row16_sum4(ss);
            if (c == 0) *(LAS f32x4*)(red + sl * 64 + 16 * mt + 4 * q) = ss; }
        LDS_BAR();
        { const int pos = 8 * sl + (lane >> 3); float v = red[(lane & 7) * 64 + pos]; v += dpp_f(v, 0xB1); v += dpp_f(v, 0x4E); v += dpp_f(v, 0x141);
          if ((lane & 7) == 0) rsv[pos] = 1.0f / sqrtf(v * (1.0f / 128.0f) + EPS); }
        LDS_BAR();
        bf16* orow = I.odn + (size_t)(b * SEQ + 64 * n) * 768 + h * 128 + 16 * sl + c;
#pragma unroll
        for (int mt = 0; mt < 4; ++mt) { const f32x4 r4 = *(const LAS f32x4*)(rsv + 16 * mt + 4 * q);
            const f32x4 z4 = (f32x4){bflo(Zcur[mt].x), bfhi(Zcur[mt].x), bflo(Zcur[mt].y), bfhi(Zcur[mt].y)};
#pragma unroll
            for (int r = 0; r < 4; ++r) { const float v = o[mt][r] * r4[r] * onw * z4[r]; orow[(size_t)(16 * mt + 4 * q + r) * 768] = (bf16)(cvtpk(v, 0.f) & 0xffffu); } }
    }
    VM_WAIT(); __syncthreads();
}

__constant__ unsigned char T5_BUCKET[128] = {0,1,2,3,4,5,6,7,8,9,10,11,12,13,14,15,16,16,16,17,17,18,18,18,19,19,19,20,20,20,20,21,21,21,21,22,22,22,22,22,23,23,23,23,23,23,24,24,24,24,24,24,25,25,25,25,25,25,25,26,26,26,26,26,26,26,26,27,27,27,27,27,27,27,27,27,27,28,28,28,28,28,28,28,28,28,28,29,29,29,29,29,29,29,29,29,29,29,29,30,30,30,30,30,30,30,30,30,30,30,30,30,30,31,31,31,31,31,31,31,31,31,31,31,31,31,31,31};
struct AttnIn { const unsigned char *qf, *kf, *vt, *mqf, *mkf, *mvt; bf16 *oswa, *omem; const float* sinks; };
__device__ __forceinline__ float ex2(float v) { return __builtin_amdgcn_exp2f(v); }

__device__ __forceinline__ void ld8(const unsigned char* p, bf16x8 (&f)[8]) {
#pragma unroll
    for (int s = 0; s < 8; ++s) f[s] = *(const GAS bf16x8*)(p + s * 1024);
}
__device__ __forceinline__ bf16x8 pfrag(const f32x16& S, int s) { return pack8((f32x4){S[8 * s], S[8 * s + 1], S[8 * s + 2], S[8 * s + 3]}, (f32x4){S[8 * s + 4], S[8 * s + 5], S[8 * s + 6], S[8 * s + 7]}); }

__device__ __forceinline__ void swa_item(const AttnIn& I, const LAS float* biasT, int item, int lane) {
    const int qt = item & 63, hq = (item >> 6) % 6, b = item / 384, kvh = hq / 3;
    const int r32 = lane & 31, hh = lane >> 5;
    const unsigned char* kbase = I.kf + ((size_t)((b * 2 + kvh) * 64) * 8) * 1024 + lane * 16;
    const unsigned char* vbase = I.vt + ((size_t)((b * 2 + kvh) * 64) * 8) * 1024 + lane * 16;
#define KT(i) ((qt - 4 + (i)) < 0 ? 0 : (qt - 4 + (i)))
    bf16x8 qfr[8], ka[8], kb[8];
    ld8(I.qf + ((size_t)((b * 6 + hq) * 64 + qt) * 8) * 1024 + lane * 16, qfr);
    ld8(kbase + (size_t)KT(0) * 8192, ka);
    f32x16 S[5];
#pragma unroll
    for (int i = 0; i < 5; ++i) {
#pragma unroll
        for (int r = 0; r < 16; ++r) S[i][r] = 0.f;
        if (i & 1) { if (i + 1 < 5) ld8(kbase + (size_t)KT(i + 1) * 8192, ka); else ld8(vbase + (size_t)KT(0) * 8192, ka);
#pragma unroll
            for (int s = 0; s < 8; ++s) S[i] = __builtin_amdgcn_mfma_f32_32x32x16_bf16(kb[s], qfr[s], S[i], 0, 0, 0);
        } else { if (i + 1 < 5) ld8(kbase + (size_t)KT(i + 1) * 8192, kb); else ld8(vbase + (size_t)KT(0) * 8192, kb);
#pragma unroll
            for (int s = 0; s < 8; ++s) S[i] = __builtin_amdgcn_mfma_f32_32x32x16_bf16(ka[s], qfr[s], S[i], 0, 0, 0);
        }
    }
    const float sink2 = I.sinks[hq] * LOG2E; const LAS float* bt = biasT + hq * 128;
    float m = sink2;
#pragma unroll
    for (int i = 0; i < 5; ++i) {
#pragma unroll
        for (int r = 0; r < 16; ++r) { const int koff = (r & 3) + 8 * (r >> 2) + 4 * hh; const int dist = 32 * (4 - i) + r32 - koff;
            const bool valid = (qt - 4 + i >= 0) && (dist >= 0) && (dist < 128);
            const float v = valid ? S[i][r] + bt[dist & 127] : -INFINITY; S[i][r] = v; m = fmaxf(m, v); } }
    m = fmaxf(m, __shfl_xor(m, 32));
    float l = 0.f;
#pragma unroll
    for (int i = 0; i < 5; ++i)
#pragma unroll
        for (int r = 0; r < 16; ++r) { const float p = ex2(S[i][r] - m); S[i][r] = p; l += p; }
    l += __shfl_xor(l, 32); l += ex2(sink2 - m);
    f32x16 O[4];
#pragma unroll
    for (int dt = 0; dt < 4; ++dt)
#pragma unroll
        for (int r = 0; r < 16; ++r) O[dt][r] = 0.f;
#pragma unroll
    for (int i = 0; i < 5; ++i) {
        if (i + 1 < 5) { if (i & 1) ld8(vbase + (size_t)KT(i + 1) * 8192, kb); else ld8(vbase + (size_t)KT(i + 1) * 8192, ka); }
#pragma unroll
        for (int s = 0; s < 2; ++s) { const bf16x8 pf = pfrag(S[i], s);
#pragma unroll
            for (int dt = 0; dt < 4; ++dt) O[dt] = __builtin_amdgcn_mfma_f32_32x32x16_bf16((i & 1) ? ka[s * 4 + dt] : kb[s * 4 + dt], pf, O[dt], 0, 0, 0); }
    }
#undef KT
    const float inv = 1.0f / l;
    bf16* orow = I.oswa + (size_t)(b * SEQ + 32 * qt + r32) * 768 + hq * 128 + 4 * hh;
#pragma unroll
    for (int dt = 0; dt < 4; ++dt)
#pragma unroll
        for (int g = 0; g < 4; ++g) { v2u w; w.x = cvtpk(O[dt][4 * g] * inv, O[dt][4 * g + 1] * inv); w.y = cvtpk(O[dt][4 * g + 2] * inv, O[dt][4 * g + 3] * inv);
            *(GAS v2u*)(orow + 32 * dt + 8 * g) = w; }
}

__device__ __forceinline__ void mem_item(const AttnIn& I, int item, int lane) {
    const int qt = item & 63, h = (item >> 6) & 3, b = item >> 8;
    const int r32 = lane & 31, hh = lane >> 5;
    const unsigned char* kbase = I.mkf + ((size_t)((b * 4 + h) * 8) * 8) * 1024 + lane * 16;
    const unsigned char* vbase = I.mvt + ((size_t)((b * 4 + h) * 8) * 8) * 1024 + lane * 16;
    bf16x8 qfr[8], ka[8], kb[8];
    ld8(I.mqf + ((size_t)((b * 4 + h) * 64 + qt) * 8) * 1024 + lane * 16, qfr);
    ld8(kbase, ka);
    f32x16 O[4];
#pragma unroll
    for (int dt = 0; dt < 4; ++dt)
#pragma unroll
        for (int r = 0; r < 16; ++r) O[dt][r] = 0.f;
    float m = -INFINITY, l = 0.f;
#pragma unroll 1
    for (int half = 0; half < 2; ++half) {
        f32x16 S[4];
#pragma unroll
        for (int i = 0; i < 4; ++i) { const int kt = half * 4 + i;
#pragma unroll
            for (int r = 0; r < 16; ++r) S[i][r] = 0.f;
            const unsigned char* nxt = (i < 3) ? kbase + (size_t)(kt + 1) * 8192 : vbase + (size_t)(half * 4) * 8192;
            if (i & 1) { ld8(nxt, ka);
#pragma unroll
                for (int s = 0; s < 8; ++s) S[i] = __builtin_amdgcn_mfma_f32_32x32x16_bf16(kb[s], qfr[s], S[i], 0, 0, 0);
            } else { ld8(nxt, kb);
#pragma unroll
                for (int s = 0; s < 8; ++s) S[i] = __builtin_amdgcn_mfma_f32_32x32x16_bf16(ka[s], qfr[s], S[i], 0, 0, 0);
            } }
        float mh = m;
#pragma unroll
        for (int i = 0; i < 4; ++i)
#pragma unroll
            for (int r = 0; r < 16; ++r) mh = fmaxf(mh, S[i][r]);
        mh = fmaxf(mh, __shfl_xor(mh, 32));
        const float alpha = ex2(m - mh); m = mh;
        float ls = 0.f;
#pragma unroll
        for (int i = 0; i < 4; ++i)
#pragma unroll
            for (int r = 0; r < 16; ++r) { const float p = ex2(S[i][r] - m); S[i][r] = p; ls += p; }
        ls += __shfl_xor(ls, 32); l = l * alpha + ls;
#pragma unroll
        for (int dt = 0; dt < 4; ++dt) O[dt] = O[dt] * alpha;
#pragma unroll
        for (int i = 0; i < 4; ++i) { const int kt = half * 4 + i;
            const unsigned char* nxt = (i < 3) ? vbase + (size_t)(kt + 1) * 8192 : kbase + (size_t)(half == 0 ? 4 : 0) * 8192;
            if (i & 1) { ld8(nxt, ka); } else { ld8(nxt, kb); }
#pragma unroll
            for (int s = 0; s < 2; ++s) { const bf16x8 pf = pfrag(S[i], s);
#pragma unroll
                for (int dt = 0; dt < 4; ++dt) O[dt] = __builtin_amdgcn_mfma_f32_32x32x16_bf16((i & 1) ? kb[s * 4 + dt] : ka[s * 4 + dt], pf, O[dt], 0, 0, 0); } }
    }
    const float inv = 1.0f / l;
    bf16* orow = I.omem + (size_t)(b * SEQ + 32 * qt + r32) * 768 + h * 128 + 4 * hh;
#pragma unroll
    for (int dt = 0; dt < 4; ++dt)
#pragma unroll
        for (int g = 0; g < 4; ++g) { v2u w; w.x = cvtpk(O[dt][4 * g] * inv, O[dt][4 * g + 1] * inv); w.y = cvtpk(O[dt][4 * g + 2] * inv, O[dt][4 * g + 3] * inv);
            *(GAS v2u*)(orow + 32 * dt + 8 * g) = w; }
}

#ifndef PH_MASK
#define PH_MASK 0x1ff
#endif
#ifndef WGM_UP
#define WGM_UP 4
#endif
#ifndef WGM_DN
#define WGM_DN 4
#endif
#ifndef SP2_UP
#define SP2_UP true
#endif
#ifndef DUP_PHASE
#define DUP_PHASE -1
#endif
struct Args { const float* in[23]; float* out; unsigned char* ws; int ph_lo, ph_hi, opt, pad; };
__global__ void __launch_bounds__(NWAVES * 64, 2) hyb_fwd(Args args) {
    extern __shared__ __attribute__((aligned(16))) unsigned char lds_raw[];
    LAS unsigned char* lds = (LAS unsigned char*)lds_raw;
    volatile LAS unsigned* MISC = (volatile LAS unsigned*)(lds + MISC_OFF);
    const int tid = threadIdx.x, lane = tid & 63, wave = __builtin_amdgcn_readfirstlane(tid >> 6);
    const int G = gridDim.x, bx = blockIdx.x;
    unsigned char* ws = args.ws;
    const float* x = args.in[0]; const float* mem = args.in[1]; const float* attn_norm_w = args.in[2]; const float* w_in = args.in[3];
    const float* dn_conv_w = args.in[4]; const float* dn_A_log = args.in[5]; const float* dn_dt_bias = args.in[6]; const float* dn_out_norm_w = args.in[7];
    const float* swa_q_norm_w = args.in[8]; const float* swa_k_norm_w = args.in[9]; const float* swa_sinks = args.in[10]; const float* rel_bias = args.in[11];
    const float* mem_norm_w = args.in[12]; const float* w_mem_kv = args.in[13]; const float* xq_norm_w = args.in[14]; const float* xk_norm_w = args.in[15];
    const float* p_dn = args.in[16]; const float* p_swa = args.in[17]; const float* p_mem = args.in[18]; const float* w_out = args.in[19];
    const float* mlp_norm_w = args.in[20]; const float* w_up = args.in[21]; const float* w_down = args.in[22];
    float* out = args.out;
    bf16* WoutT = (bf16*)(ws + WS_WOUT); bf16* PdnT = (bf16*)(ws + WS_PDN); bf16* PswaT = (bf16*)(ws + WS_PSWA); bf16* PmemT = (bf16*)(ws + WS_PMEM);
    bf16* WinT = (bf16*)((unsigned char*)out + DO_WIN); bf16* WmkvT = (bf16*)((unsigned char*)out + DO_WMKV); bf16* memn = (bf16*)((unsigned char*)out + DO_MEMN);
    const DnfMap dnfm{(unsigned char*)out, ws + WS_DNF2};
    bf16* WupT = (bf16*)(ws + WS_WUP); bf16* WdnT = (bf16*)(ws + WS_WDN);
    bf16* xn = (bf16*)(ws + WS_XN); bf16* proj = (bf16*)(ws + WS_PROJ); bf16* gates = (bf16*)(ws + WS_GATES);
    bf16* odn = (bf16*)(ws + WS_ODN); bf16* oswa = (bf16*)(ws + WS_OSWA); bf16* omem = (bf16*)(ws + WS_OMEM); bf16* merged = (bf16*)(ws + WS_MERGED);
    bf16* memk = (bf16*)(ws + WS_MEMK); bf16* Hb = (bf16*)(ws + WS_H);
    float* ssq = (float*)(ws + WS_SSQ); float* gcarr = (float*)(ws + WS_GC);

    for (int u = tid; u < (LDS_BYTES - LDSCTL_OFF) / 4; u += NWAVES * 64) ((LAS unsigned*)(lds + LDSCTL_OFF))[u] = 0u;
    __syncthreads();
    XcdBarrier bar = xcd_barrier_post((unsigned*)(ws + WS_CTL) + CW_BAR, MISC + 8);
    const int lo = args.ph_lo, hi = args.ph_hi;
#define IN(k) (lo <= (k) && (k) < hi && ((PH_MASK >> (k)) & 1))
#ifdef DOUBLE_SEAM
#define SEAM(k) do { if ((k) + 1 < hi) { xcd_barrier(bar); xcd_barrier(bar); } } while (0)
#else
#define SEAM(k) do { if ((k) + 1 < hi) xcd_barrier(bar); } while (0)
#endif
    const int gw = bx * NWAVES + wave, NGW = G * NWAVES;

    if (lo <= 0 && 0 < hi) {
        for (int rep = 0; rep < ((DUP_PHASE == 0) ? 2 : 1); ++rep) if (IN(0)) { if (rep) xcd_barrier(bar);
        transpose_matrix<1>(w_in, DM, NIN, nullptr, WinT, DM, NWIN, gw, NGW, lane);
        transpose_matrix<2>(w_in, DM, NIN, nullptr, (bf16*)(ws + WS_WTAIL), DM, 1280, gw, NGW, lane);
        transpose_matrix<0>(w_mem_kv, DM, 1024, nullptr, WmkvT, DM, 1024, gw, NGW, lane);
        for (int m = gw; m < MT + MMEM; m += 2 * NGW) {
            f32x4 va[8], vb[8]; const int m2 = m + NGW; const bool two = m2 < MT + MMEM;
            rms_load(m < MT ? x + (size_t)m * DM : mem + (size_t)(m - MT) * DM, lane, va);
            if (two) rms_load(m2 < MT ? x + (size_t)m2 * DM : mem + (size_t)(m2 - MT) * DM, lane, vb);
            if (m < MT) rms_finish(attn_norm_w, xn + (size_t)m * DM, lane, va); else rms_finish(mem_norm_w, memn + (size_t)(m - MT) * DM, lane, va);
            if (two) { if (m2 < MT) rms_finish(attn_norm_w, xn + (size_t)m2 * DM, lane, vb); else rms_finish(mem_norm_w, memn + (size_t)(m2 - MT) * DM, lane, vb); }
        }
        }
        SEAM(0);
    }
    if (lo <= 1 && 1 < hi) {
        for (int rep = 0; rep < ((DUP_PHASE == 1) ? 2 : 1); ++rep) if (IN(1)) { if (rep) xcd_barrier(bar);
        { pg8::Gemm g{xn, WinT, MT, NMAIN, DM}; pg8::StaticOrder S; S.init(MT, NMAIN, G, bx); S.cap = P1_CAP; S.wgm = 4;
          pg8::EpiProj E{proj, gates, LDP, LDG};
          pg8::gemm_phase<pg8::EpiProj, pg8::StaticOrder, true, true>(lds + RING_OFF, g, S, E); }
        { pg8::Gemm g{WinT + (size_t)NMAIN * DM, xn, 256, MT, DM}; pg8::StaticOrder S; S.init(256, MT, G, (bx - 208 + G) % G);
          pg8::EpiVt<2, SEQ> E{ws + WS_VT};
          pg8::gemm_phase<pg8::EpiVt<2, SEQ>, pg8::StaticOrder, true, true>(lds + RING_OFF, g, S, E); }
        { pg8::Gemm g{memn, WmkvT, MMEM, 512, DM}; pg8::StaticOrder S; S.init(MMEM, 512, G, (bx - 240 + G) % G);
          pg8::EpiPlain E{memk, 512};
          pg8::gemm_phase<pg8::EpiPlain, pg8::StaticOrder, true, true>(lds + RING_OFF, g, S, E); }
        { pg8::Gemm g{WmkvT + (size_t)512 * DM, memn, 512, MMEM, DM}; pg8::StaticOrder S; S.init(512, MMEM, G, (bx - 248 + G) % G);
          pg8::EpiVt<4, MEML> E{ws + WS_MVT};
          pg8::gemm_phase<pg8::EpiVt<4, MEML>, pg8::StaticOrder, true, true>(lds + RING_OFF, g, S, E); }
        }
        SEAM(1);
    }
    if (lo <= 2 && 2 < hi) {
        for (int rep = 0; rep < ((DUP_PHASE == 2) ? 2 : 1); ++rep) if (IN(2)) { if (rep) xcd_barrier(bar);
        DnIn DI{proj, dn_conv_w, dn_A_log, dn_dt_bias, dnfm, gcarr, ws + WS_LG, ws + WS_RHS};
        { unsigned uraw[35];
          if (bx < NCHUNK) dn_conv_issue(DI, bx, tid, uraw);
          for (int chunk = bx; chunk < NCHUNK; chunk += G) dn_prep_chunk(DI, (LAS float*)(lds + RING_OFF), chunk, chunk + G, tid, uraw); }
        asm volatile("s_waitcnt vmcnt(0)" ::: "memory"); __syncthreads();
        { const int nmine = (NCHUNK - 1 - bx) / G + 1;
          for (int si = wave; si < 4 * nmine; si += NWAVES) dn_solve_item(ws + WS_LG, ws + WS_RHS, dnfm, (LAS float*)(lds + RING_OFF + wave * 8448), (bx + (si >> 2) * G) * 4 + (si & 3), lane); }
        { const int lw = (NWAVES - 1 - wave) * G + bx, nlight = NGW;
          for (int it = lw; it < 3200; it += nlight) {
            if (it < 1536) { const int grp = it >> 6, tile = it & 63, b = grp / 6, hq = grp % 6;
                normfrag_item(proj, LDP, b * SEQ + 32 * tile, PC_SQ + hq * 128, swa_q_norm_w, QSCALE, ws + WS_QF + (size_t)it * 8192, lane); }
            else if (it < 2048) { const int i2 = it - 1536, grp = i2 >> 6, tile = i2 & 63, b = grp >> 1, kvh = grp & 1;
                normfrag_item(proj, LDP, b * SEQ + 32 * tile, PC_SK + kvh * 128, swa_k_norm_w, 1.0f, ws + WS_KF + (size_t)i2 * 8192, lane); }
            else if (it < 3072) { const int i3 = it - 2048, grp = i3 >> 6, tile = i3 & 63, b = grp >> 2, h = grp & 3;
                normfrag_item(proj, LDP, b * SEQ + 32 * tile, PC_MQ + h * 128, xq_norm_w, QSCALE, ws + WS_MQF + (size_t)i3 * 8192, lane); }
            else { const int i4 = it - 3072, grp = i4 >> 3, tile = i4 & 7, b = grp >> 2, h = grp & 3;
                normfrag_item(memk, 512, b * MEML + 32 * tile, h * 128, xk_norm_w, 1.0f, ws + WS_MKF + (size_t)i4 * 8192, lane); }
          }
        }
        }
        SEAM(2);
    }
    if (lo <= 4 && 4 < hi) {
        for (int rep = 0; rep < ((DUP_PHASE == 4) ? 2 : 1); ++rep) if (IN(4)) { if (rep) xcd_barrier(bar);
        if (bx < 24) {
#ifndef NO_SCAN
            if (!(args.opt & 1)) { int tid_s = tid; asm volatile("" : "+v"(tid_s)); ScanIn SI{dnfm, gcarr, dn_out_norm_w, odn, args.opt}; dn_scan(SI, lds + RING_OFF, bx, tid_s); }
#endif
        }
        else if (!(args.opt & 2)) {
            LAS float* biasT = (LAS float*)(lds + RING_OFF);
            for (int e = tid; e < 768; e += NWAVES * 64) { const int hq = e >> 7, dist = e & 127; biasT[e] = rel_bias[T5_BUCKET[dist] * 6 + hq] * LOG2E; }
            __syncthreads();
            int lane_a = lane; asm volatile("" : "+v"(lane_a));
            AttnIn AI{ws + WS_QF, ws + WS_KF, ws + WS_VT, ws + WS_MQF, ws + WS_MKF, ws + WS_MVT, oswa, omem, swa_sinks};
            const int aw = (bx - 24) * NWAVES + wave, NAW = (G - 24) * NWAVES;
#ifndef NO_MEM
            for (int it = aw; it < 1024; it += NAW) mem_item(AI, it, lane_a);
#endif
#ifndef NO_SWA
            for (int it = (aw + NAW - (1024 % NAW)) % NAW; it < 1536; it += NAW) swa_item(AI, biasT, it, lane_a);
#endif
            const int ab = bx - 24, nab = G - 24, ntail = NTAIL < nab ? NTAIL : nab;
            __syncthreads();
            if (!(args.opt & 16)) { pg8::StaticOrder S; S.init(MT, NMAIN, 1 << 20, P1_CAP + ab); S.wgm = 4;
              if (ntail < NTAIL) S.cap = 0;
              const bf16* wt = (const bf16*)(ws + WS_WTAIL) - (size_t)38 * 256 * DM;
              pg8::Gemm g{xn, wt, MT, NMAIN, DM};
              pg8::EpiProj E{proj, gates, LDP, LDG};
              pg8::gemm_phase<pg8::EpiProj, pg8::StaticOrder, false, true>(lds + RING_OFF, g, S, E); }
            if (!(args.opt & 8)) {
            int lane2 = lane; asm volatile("" : "+v"(lane2));
            const int share = ab < ntail ? 1 : 3, Wt = NWAVES * (ntail + 3 * (nab - ntail));
            const int vb = ab < ntail ? (ab * NWAVES + wave) : (ntail * NWAVES + ((ab - ntail) * NWAVES + wave) * 3);
            for (int k = 0; k < share; ++k) {
                transpose_matrix<0>(w_up, DM, DFF, mlp_norm_w, WupT, DM, DFF, vb + k, Wt, lane2);
                transpose_matrix<0>(w_down, DFF, DM, nullptr, WdnT, DFF, DM, vb + k, Wt, lane2);
                transpose_matrix<0>(p_dn, 768, DM, nullptr, PdnT, 768, DM, vb + k, Wt, lane2);
                transpose_matrix<0>(p_swa, 768, DM, nullptr, PswaT, 768, DM, vb + k, Wt, lane2);
                transpose_matrix<0>(p_mem, 512, DM, nullptr, PmemT, 768, DM, vb + k, Wt, lane2);
                transpose_matrix<0>(w_out, DM, DM, nullptr, WoutT, DM, DM, vb + k, Wt, lane2); } }
        }
        }
        SEAM(4);
    }
    if (lo <= 5 && 5 < hi) {
        for (int rep = 0; rep < ((DUP_PHASE == 5) ? 2 : 1); ++rep) if (IN(5)) { if (rep) xcd_barrier(bar);
        if (!(args.opt & 16))
        { pg8::Gemm g{odn, PdnT, 3 * MT, 3 * DM, 768}; pg8::MergeOrder S; S.init(MT, DM, G, bx); S.so.wgm = 4;
          pg8::EpiMergeAll E{gates, merged, LDG, DM};
          pg8::gemm_phase<pg8::EpiMergeAll, pg8::MergeOrder, true, true>(lds + RING_OFF, g, S, E); }
        }
        SEAM(5);
    }
    if (lo <= 6 && 6 < hi) {
        for (int rep = 0; rep < ((DUP_PHASE == 6) ? 2 : 1); ++rep) if (IN(6)) { if (rep) xcd_barrier(bar);
        pg8::Gemm g{merged, WoutT, MT, DM, DM}; pg8::StaticOrder S; S.init(MT, DM, G, bx); S.wgm = 4;
        pg8::EpiOut E{x, (args.opt & 4) ? (float*)(ws + 225 * MiB) : out, xn, ssq, DM, rep ? 0.f : 1.f};
        pg8::gemm_phase<pg8::EpiOut, pg8::StaticOrder, false, true>(lds + RING_OFF, g, S, E);
        }
        SEAM(6);
    }
    if (lo <= 7 && 7 < hi) {
        for (int rep = 0; rep < ((DUP_PHASE == 7) ? 2 : 1); ++rep) if (IN(7)) { if (rep) xcd_barrier(bar);
        pg8::Gemm g{xn, WupT, MT, DFF, DM}; pg8::StaticOrder S; S.init(MT, DFF, G, bx); S.wgm = WGM_UP;
        pg8::EpiUp E{ssq, Hb, DFF, 1.0f / DM, EPS};
        pg8::gemm_phase<pg8::EpiUp, pg8::StaticOrder, true, SP2_UP>(lds + RING_OFF, g, S, E);
        }
        SEAM(7);
    }
    if (lo <= 8 && 8 < hi) {
        for (int rep = 0; rep < ((DUP_PHASE == 8) ? 2 : 1); ++rep) if (IN(8)) { if (rep) xcd_barrier(bar);
        pg8::Gemm g{Hb, WdnT, MT, DM, DFF}; pg8::StaticOrder S; S.init(MT, DM, G, bx); S.wgm = WGM_DN;
        pg8::EpiDown E{xn, out, DM, (rep || (args.opt & 4)) ? 0.f : 1.f};
        pg8::gemm_phase<pg8::EpiDown, pg8::StaticOrder, false, true>(lds + RING_OFF, g, S, E);
        }
    }
#undef IN
#undef SEAM
}

#ifndef N_LAUNCHES
#define N_LAUNCHES 1
#endif
extern "C" void kernel_launch(void* const* d_in, const int* in_sizes, int n_in, void* d_out, int out_size, void* d_ws, size_t ws_size, hipStream_t stream) {
    static int grid = 0;
    if (grid == 0) {
        if (n_in != 23 || out_size != MT * DM || ws_size < WS_END) { fprintf(stderr, "kernel_launch: unexpected shapes (n_in %d, out %d, ws %zu)\n", n_in, out_size, ws_size); grid = -1; return; }
        int dev = 0, cus = 0, per_cu = 0;
        if (hipGetDevice(&dev) != hipSuccess || hipDeviceGetAttribute(&cus, hipDeviceAttributeMultiprocessorCount, dev) != hipSuccess) { grid = -1; return; }
        if (hipFuncSetAttribute((const void*)hyb_fwd, hipFuncAttributeMaxDynamicSharedMemorySize, LDS_BYTES) != hipSuccess) { fprintf(stderr, "kernel_launch: hipFuncSetAttribute failed\n"); grid = -1; return; }
        if (hipOccupancyMaxActiveBlocksPerMultiprocessor(&per_cu, (const void*)hyb_fwd, NWAVES * 64, LDS_BYTES) != hipSuccess || per_cu < 1) { fprintf(stderr, "kernel_launch: occupancy query says %d\n", per_cu); per_cu = 1; }
        (void)hipGetLastError();
        grid = cus;
        if (grid > 256) grid = 256;
    }
    if (grid < 0) return;
    (void)hipMemsetAsync((char*)d_ws + WS_CTL, 0, CTL_ZERO_BYTES, stream);
#ifdef EXTRA_MEMSET
    (void)hipMemsetAsync((char*)d_ws + WS_END, 0, 64, stream);
#endif
    Args a{};
    for (int i = 0; i < 23; ++i) a.in[i] = (const float*)d_in[i];
    a.out = (float*)d_out; a.ws = (unsigned char*)d_ws;
#if N_LAUNCHES == 1
    a.ph_lo = 0; a.ph_hi = 9;
    hipLaunchKernelGGL(hyb_fwd, dim3(grid), dim3(NWAVES * 64), LDS_BYTES, stream, a);
#else
    for (int p = 0; p < 9; ++p) { a.ph_lo = p; a.ph_hi = p + 1; hipLaunchKernelGGL(hyb_fwd, dim3(grid), dim3(NWAVES * 64), LDS_BYTES, stream, a); }
#endif
#ifdef RERUN_PHASE
    a.ph_lo = RERUN_PHASE; a.ph_hi = RERUN_PHASE + 1; a.opt = RERUN_OPT;
    hipLaunchKernelGGL(hyb_fwd, dim3(grid), dim3(NWAVES * 64), LDS_BYTES, stream, a);
#endif
}
```

```cpp
#include <hip/hip_runtime.h>
#include <cstdio>
#include <cstdint>
namespace pg8 {
#define PG8_LAS __attribute__((address_space(3)))
typedef unsigned short bf16_t;
typedef short bf16x8 __attribute__((ext_vector_type(8)));
typedef float f32x4 __attribute__((ext_vector_type(4)));
typedef unsigned u32x4 __attribute__((ext_vector_type(4)));
constexpr int BM = 256, BK = 64, HALF = 128, HTB = HALF * BK * 2  , STAGE_BYTES = 8 * HTB, NXCD = 8, WGM = 8;

__host__ __device__ __forceinline__ int lds_byte(int r, int c) { const int st = (r >> 4) * 2 + (c >> 5), rr = r & 15, cc = c & 31, ob = rr * 64 + cc * 2; return st * 1024 + (ob ^ (((ob >> 9) & 1) << 5)); }
__host__ __device__ __forceinline__ void stage_rc(int b, int& R, int& C) { const int st = b / 1024, sb = b % 1024, swz = sb ^ (((sb >> 9) & 1) << 5); R = (st >> 1) * 16 + swz / 64; C = (st & 1) * 32 + (swz % 64) / 2; }
__host__ __device__ __forceinline__ int perm32(int rho) { const int n = rho >> 4, i = rho & 15; return 8 * (i >> 2) + 4 * n + (i & 3); }

struct Unit { int pm, pn; };
struct Gemm { const bf16_t* A; const bf16_t* Bt; int M, N, K; };

struct StaticOrder {
    static constexpr bool VAR_NT = false;
    int nM, nN, nwg, G, c, cap, wgm;
    __host__ __device__ void init(int M, int N, int G_, int c_) { nM = M / BM; nN = N / BM; nwg = nM * nN; G = G_; c = c_; cap = nwg; wgm = WGM; }
    __host__ __device__ bool next(int i, Unit& u) const {
        const long L = (long)i * G + c; if (L >= cap) return false;
        int wgid = (int)L; { const int q = nwg / NXCD, r = nwg % NXCD, xcd = wgid % NXCD, off = wgid / NXCD; wgid = (xcd < r ? xcd * (q + 1) : r * (q + 1) + (xcd - r) * q) + off; }
        const int nig = wgm * nN, gid = wgid / nig, fm = gid * wgm, gsz = (nM - fm) < wgm ? (nM - fm) : wgm;
        u.pm = fm + ((wgid % nig) % gsz); u.pn = (wgid % nig) / gsz; return true;
    }
    __device__ __forceinline__ void a_ready(const Unit&) const {}
    __device__ __forceinline__ void done(const Unit&) const {}
};

__device__ __forceinline__ unsigned cvt_pk_bf16(float lo, float hi) { unsigned r; asm volatile("v_cvt_pk_bf16_f32 %0, %1, %2" : "=v"(r) : "v"(lo), "v"(hi)); return r; }
typedef float f32x2 __attribute__((ext_vector_type(2)));
__device__ __forceinline__ f32x2 gelu_pk(f32x2 v) {
    const f32x2 av = __builtin_elementwise_abs(v), d = av * 0.2316418882f + 1.0f;
    f32x2 t; t.x = __builtin_amdgcn_rcpf(d.x); t.y = __builtin_amdgcn_rcpf(d.y);
    f32x2 q = t * 0.5307027145f + (-0.7265760135f); q = q * t + 0.7107068705f; q = q * t + (-0.142248368f); q = q * t + 0.127414796f; q = q * t;
    const f32x2 s = (v * v) * (-0.72134752044f);
    f32x2 e; e.x = __builtin_amdgcn_exp2f(s.x); e.y = __builtin_amdgcn_exp2f(s.y);
    const f32x2 m = v * (q * e), r = v - m;
    f32x2 o; o.x = v.x < 0.f ? m.x : r.x; o.y = v.y < 0.f ? m.y : r.y; return o;
}

template <int ACT  > struct EpiBf16 {
    static constexpr bool PERM = true, AFTER_DRAIN = false, INPLACE = false; static_assert(ACT == 0 || ACT == 1, "EpiBf16: ACT is 0 (none) or 1 (gelu_pk)");
    bf16_t* O; int ldc; const float* bias; int split_cols; size_t split_stride; float scale0;
    __device__ __forceinline__ void operator()(const f32x4 (&acc)[2][2][4][2], const Unit& u, int wr, int wc, int fr, int fq) const {
        const int row0 = u.pm * BM + wr * 64 + fr; int colt = u.pn * BM; bf16_t* base = O;
        float sc = 1.f; if (split_cols) { const int t = colt / split_cols; base += (size_t)t * split_stride; colt -= t * split_cols; if (t == 0) sc = scale0; }
        const int col0 = colt + wc * 32 + 8 * fq, bcol0 = u.pn * BM + wc * 32 + 8 * fq;
        f32x4 bv[2][2];
#pragma unroll
        for (int bj = 0; bj < 2; ++bj)
#pragma unroll
            for (int n = 0; n < 2; ++n) bv[bj][n] = bias ? *(const f32x4*)(bias + bcol0 + bj * HALF + 4 * n) : (f32x4){0.f, 0.f, 0.f, 0.f};
#pragma unroll
        for (int ai = 0; ai < 2; ++ai)
#pragma unroll
            for (int m = 0; m < 4; ++m) { bf16_t* rowp = base + (size_t)(row0 + ai * HALF + m * 16) * ldc + col0;
#pragma unroll
                for (int bj = 0; bj < 2; ++bj) { f32x4 v0 = acc[ai][bj][m][0] + bv[bj][0], v1 = acc[ai][bj][m][1] + bv[bj][1];
                    if (ACT == 1) { f32x2 a = gelu_pk((f32x2){v0[0], v0[1]}), b = gelu_pk((f32x2){v0[2], v0[3]}), c = gelu_pk((f32x2){v1[0], v1[1]}), d = gelu_pk((f32x2){v1[2], v1[3]});
                        v0 = (f32x4){a.x, a.y, b.x, b.y}; v1 = (f32x4){c.x, c.y, d.x, d.y}; }
                    v0 = v0 * sc; v1 = v1 * sc; u32x4 w; w.x = cvt_pk_bf16(v0[0], v0[1]); w.y = cvt_pk_bf16(v0[2], v0[3]); w.z = cvt_pk_bf16(v1[0], v1[1]); w.w = cvt_pk_bf16(v1[2], v1[3]);
                    *(u32x4*)(rowp + bj * HALF) = w; } }
    }
};
template <class Epi, class Sched, bool ALIGN_EPI = false, bool SP2 = false>
__device__ __forceinline__ void gemm_phase(PG8_LAS unsigned char* lds, const Gemm g, const Sched& S, const Epi& E) {
    const int tid = threadIdx.x, wid = __builtin_amdgcn_readfirstlane(tid >> 6), lane = tid & 63, wr = wid >> 2, wc = wid & 3, fr = lane & 15, fq = lane >> 4;
    const int K = g.K; int nt = K / BK;
    unsigned voffA[2], voffB[2];
#pragma unroll
    for (int i = 0; i < 2; ++i) { int R, C; stage_rc(tid * 16 + i * 8192, R, C); const int Rb = Epi::PERM ? ((R & ~31) + perm32(R & 31)) : R;
        voffA[i] = (unsigned)(R * K + C) * 2u; voffB[i] = (unsigned)(Rb * K + C) * 2u; }
    const size_t kstep = (size_t)(BK * 2);
    const size_t hstep = (size_t)HALF * K * 2;
    const size_t tstep = 2 * hstep;
    const unsigned ldsw = (unsigned)wid * 1024u;
    const int aoff = lds_byte(wr * 64 + fr, fq * 8), boff = lds_byte(wc * 32 + fr, fq * 8);
#define PG8_SA(b, h) (((b) * 2 + (h)) * HTB)
#define PG8_SB(b, h) ((4 + (b) * 2 + (h)) * HTB)
#define PG8_STAGE(bufoff, gbase, voff) do { _Pragma("unroll") for (int _i = 0; _i < 2; ++_i) \
        __builtin_amdgcn_global_load_lds((const unsigned*)((const char*)(gbase) + (voff)[_i]), (PG8_LAS unsigned*)(lds + (bufoff) + ldsw + _i * 8192), 16, 0, 0); } while (0)
#define PG8_LDA(dst, b, h) do { _Pragma("unroll") for (int m = 0; m < 4; ++m) _Pragma("unroll") for (int k = 0; k < 2; ++k) dst[m][k] = *(const PG8_LAS bf16x8*)(lds + PG8_SA(b, h) + aoff + m * 2048 + k * 1024); } while (0)
#define PG8_LDB(dst, b, h) do { _Pragma("unroll") for (int n = 0; n < 2; ++n) _Pragma("unroll") for (int k = 0; k < 2; ++k) dst[n][k] = *(const PG8_LAS bf16x8*)(lds + PG8_SB(b, h) + boff + n * 2048 + k * 1024); } while (0)
#define PG8_MMA(ai, bj, At, Bt) do { __builtin_amdgcn_s_setprio(1); _Pragma("unroll") for (int m = 0; m < 4; ++m) _Pragma("unroll") for (int n = 0; n < 2; ++n) _Pragma("unroll") for (int k = 0; k < 2; ++k) \
        acc[ai][bj][m][n] = __builtin_amdgcn_mfma_f32_16x16x32_bf16(Bt[n][k], At[m][k], acc[ai][bj][m][n], 0, 0, 0); __builtin_amdgcn_s_setprio(0); } while (0)
#define PG8_WAIT_V(n) asm volatile("s_waitcnt vmcnt(" #n ")" ::: "memory")
#define PG8_WAIT_L(n) asm volatile("s_waitcnt lgkmcnt(" #n ")" ::: "memory")
#define PG8_BAR __builtin_amdgcn_s_barrier()
#define PG8_SCHED __builtin_amdgcn_sched_barrier(0)
    Unit cur, nxt; int ui = 0;
    if (!S.next(0, cur)) return;
    if constexpr (Sched::VAR_NT) nt = S.unit_nt(cur);
    f32x4 acc[2][2][4][2];
#pragma unroll
    for (int a = 0; a < 2; ++a)
#pragma unroll
        for (int b = 0; b < 2; ++b)
#pragma unroll
            for (int m = 0; m < 4; ++m)
#pragma unroll
                for (int n = 0; n < 2; ++n) acc[a][b][m][n] = (f32x4){0.f, 0.f, 0.f, 0.f};
    bf16x8 At[4][2], B0[2][2], B1[2][2];
    const char* cA = (const char*)g.A + (size_t)cur.pm * tstep; const char* cB = (const char*)g.Bt + (size_t)cur.pn * tstep;
    S.a_ready(cur);
    if constexpr (SP2) {
        PG8_STAGE(PG8_SB(0, 0), cB, voffB); PG8_STAGE(PG8_SB(0, 1), cB + hstep, voffB); PG8_STAGE(PG8_SA(0, 0), cA, voffA); PG8_STAGE(PG8_SA(0, 1), cA + hstep, voffA);
        if (wr == 1) PG8_BAR;
        PG8_WAIT_V(2); PG8_BAR;
        PG8_STAGE(PG8_SB(1, 0), cB + kstep, voffB); PG8_STAGE(PG8_SA(1, 0), cA + kstep, voffA); PG8_STAGE(PG8_SB(1, 1), cB + hstep + kstep, voffB);
        PG8_WAIT_V(6); PG8_BAR;
    } else {
        PG8_STAGE(PG8_SB(0, 0), cB, voffB); PG8_STAGE(PG8_SA(0, 0), cA, voffA); PG8_STAGE(PG8_SB(0, 1), cB + hstep, voffB); PG8_STAGE(PG8_SA(0, 1), cA + hstep, voffA);
        if (wr == 1) PG8_BAR;
        PG8_WAIT_V(4); PG8_BAR;
        PG8_STAGE(PG8_SB(1, 0), cB + kstep, voffB); PG8_STAGE(PG8_SA(1, 0), cA + kstep, voffA); PG8_STAGE(PG8_SB(1, 1), cB + hstep + kstep, voffB);
        PG8_WAIT_V(6); PG8_BAR;
    }
    for (;;) {
        const bool has_next = S.next(ui + 1, nxt);
        const char* nA = has_next ? (const char*)g.A + (size_t)nxt.pm * tstep : cA; const char* nB = has_next ? (const char*)g.Bt + (size_t)nxt.pn * tstep : cB;
        for (int t = 0; t < nt; t += 2) {
            const bool last = (t == nt - 2);
            const char* a1 = cA + (size_t)(t + 1) * kstep;
            const char* a2 = last ? nA : cA + (size_t)(t + 2) * kstep; const char* b2 = last ? nB : cB + (size_t)(t + 2) * kstep;
            const char* a3 = a2 + kstep; const char* b3 = b2 + kstep;
            if (last && has_next) S.a_ready(nxt);
            if constexpr (SP2) {
            PG8_LDB(B0, 0, 0); PG8_LDB(B1, 0, 1); PG8_SCHED; PG8_LDA(At, 0, 0); PG8_STAGE(PG8_SA(1, 1), a1 + hstep, voffA);
            PG8_WAIT_V(8); PG8_WAIT_L(0); PG8_BAR; PG8_MMA(0, 0, At, B0); PG8_MMA(0, 1, At, B1); PG8_BAR; PG8_SCHED;
            PG8_LDA(At, 0, 1); PG8_STAGE(PG8_SB(0, 0), b2, voffB); PG8_STAGE(PG8_SB(0, 1), b2 + hstep, voffB); PG8_STAGE(PG8_SA(0, 0), a2, voffA);
            PG8_WAIT_V(8); PG8_WAIT_L(0); PG8_BAR; PG8_MMA(1, 0, At, B0); PG8_MMA(1, 1, At, B1); PG8_BAR; PG8_SCHED;
            PG8_LDB(B0, 1, 0); PG8_LDB(B1, 1, 1); PG8_SCHED; PG8_LDA(At, 1, 0); PG8_STAGE(PG8_SA(0, 1), a2 + hstep, voffA);
            PG8_WAIT_V(8); PG8_WAIT_L(0); PG8_BAR; PG8_MMA(0, 0, At, B0); PG8_MMA(0, 1, At, B1); PG8_BAR; PG8_SCHED;
            PG8_LDA(At, 1, 1); PG8_STAGE(PG8_SB(1, 0), b3, voffB); PG8_STAGE(PG8_SB(1, 1), b3 + hstep, voffB); PG8_STAGE(PG8_SA(1, 0), a3, voffA);
            PG8_WAIT_V(8); PG8_WAIT_L(0); PG8_BAR; PG8_MMA(1, 0, At, B0); PG8_MMA(1, 1, At, B1); PG8_BAR; PG8_SCHED;
            } else {
            PG8_LDB(B0, 0, 0); PG8_SCHED; PG8_LDA(At, 0, 0); PG8_STAGE(PG8_SA(1, 1), a1 + hstep, voffA);
            PG8_WAIT_L(8); PG8_BAR; PG8_WAIT_L(0); PG8_MMA(0, 0, At, B0); PG8_BAR; PG8_SCHED;
            PG8_LDB(B1, 0, 1); PG8_STAGE(PG8_SB(0, 0), b2, voffB);
            PG8_BAR; PG8_WAIT_L(0); PG8_MMA(0, 1, At, B1); PG8_BAR;
            PG8_LDA(At, 0, 1); PG8_STAGE(PG8_SA(0, 0), a2, voffA);
            PG8_BAR; PG8_WAIT_L(0); PG8_MMA(1, 0, At, B0); PG8_BAR; PG8_SCHED;
            PG8_STAGE(PG8_SB(0, 1), b2 + hstep, voffB);
            PG8_WAIT_V(6); PG8_BAR; PG8_MMA(1, 1, At, B1); PG8_BAR;
            PG8_LDB(B0, 1, 0); PG8_SCHED; PG8_LDA(At, 1, 0); PG8_STAGE(PG8_SA(0, 1), a2 + hstep, voffA);
            PG8_WAIT_L(8); PG8_BAR; PG8_WAIT_L(0); PG8_MMA(0, 0, At, B0); PG8_BAR; PG8_SCHED;
            PG8_LDB(B1, 1, 1); PG8_STAGE(PG8_SB(1, 0), b3, voffB);
            PG8_BAR; PG8_WAIT_L(0); PG8_MMA(0, 1, At, B1); PG8_BAR;
            PG8_LDA(At, 1, 1); PG8_STAGE(PG8_SA(1, 0), a3, voffA);
            PG8_BAR; PG8_WAIT_L(0); PG8_MMA(1, 0, At, B0); PG8_BAR; PG8_SCHED;
            PG8_STAGE(PG8_SB(1, 1), b3 + hstep, voffB);
            PG8_WAIT_V(6); PG8_BAR; PG8_MMA(1, 1, At, B1); PG8_BAR;
            }
        }
        if constexpr (ALIGN_EPI) { if (wr == 0) PG8_BAR; }
        bool keep_acc = false;
        if constexpr (Epi::INPLACE) { keep_acc = E.inplace(acc, cur, wr, wc, fr, fq); S.done(cur); }
        else if constexpr (!Epi::AFTER_DRAIN) { E(acc, cur, wr, wc, fr, fq); S.done(cur); }
        if (!has_next) break;
        if (!keep_acc)
#pragma unroll
        for (int a = 0; a < 2; ++a)
#pragma unroll
            for (int b = 0; b < 2; ++b)
#pragma unroll
                for (int m = 0; m < 4; ++m)
#pragma unroll
                    for (int n = 0; n < 2; ++n) acc[a][b][m][n] = (f32x4){0.f, 0.f, 0.f, 0.f};
        cur = nxt; cA = nA; cB = nB; ++ui;
        if constexpr (Sched::VAR_NT) nt = S.unit_nt(cur);
        if constexpr (ALIGN_EPI) { if (wr == 1) PG8_BAR; }
    }
    PG8_WAIT_V(0);
    if constexpr (!ALIGN_EPI) { if (wr == 0) PG8_BAR; }
    PG8_BAR;
    if constexpr (Epi::AFTER_DRAIN) { E.fused(acc, cur, wr, wc, fr, fq, lds, wid, lane); S.done(cur); }
#undef PG8_SA
#undef PG8_SB
#undef PG8_STAGE
#undef PG8_LDA
#undef PG8_LDB
#undef PG8_MMA
#undef PG8_WAIT_V
#undef PG8_WAIT_L
#undef PG8_BAR
#undef PG8_SCHED
}
}

namespace pg8 {
typedef float f32x2e __attribute__((ext_vector_type(2))); typedef __bf16 bf16x2e __attribute__((ext_vector_type(2)));
__device__ __forceinline__ unsigned cvtpk(float lo, float hi) { f32x2e v = {lo, hi}; bf16x2e b = __builtin_convertvector(v, bf16x2e); return __builtin_bit_cast(unsigned, b); }
__device__ __forceinline__ float bflo(unsigned u) { return __builtin_bit_cast(float, u << 16); }
__device__ __forceinline__ float bfhi(unsigned u) { return __builtin_bit_cast(float, u & 0xffff0000u); }
__device__ __forceinline__ void st16_wt(void* p, u32x4 v) { asm volatile("global_store_dwordx4 %0, %1, off sc1\n\ts_nop 1" :: "v"(p), "v"(v) : "memory"); }
__device__ __forceinline__ float sigm(float v) { return __builtin_amdgcn_rcpf(1.0f + __expf(-v)); }

struct EpiProj {
    static constexpr bool PERM = true, AFTER_DRAIN = false, INPLACE = false;
    bf16_t* proj; bf16_t* gates; int ldp, ldg;
    __device__ __forceinline__ void operator()(const f32x4 (&acc)[2][2][4][2], const Unit& u, int wr, int wc, int fr, int fq) const {
        const int row0 = u.pm * BM + wr * 64 + fr; const int pn = u.pn; const bool isg = (pn >= 19);
        bf16_t* base = isg ? gates : proj; const int ld = isg ? ldg : ldp; const int colt = isg ? (pn - 19) * BM : pn * BM;
        const int col0 = colt + wc * 32 + 8 * fq;
#pragma unroll
        for (int ai = 0; ai < 2; ++ai)
#pragma unroll
            for (int m = 0; m < 4; ++m) { bf16_t* rowp = base + (size_t)(row0 + ai * HALF + m * 16) * ld + col0;
#pragma unroll
                for (int bj = 0; bj < 2; ++bj) { f32x4 v0 = acc[ai][bj][m][0], v1 = acc[ai][bj][m][1];
                    if (isg) { v0 = (f32x4){sigm(v0[0]), sigm(v0[1]), sigm(v0[2]), sigm(v0[3])}; v1 = (f32x4){sigm(v1[0]), sigm(v1[1]), sigm(v1[2]), sigm(v1[3])}; }
                    u32x4 w; w.x = cvtpk(v0[0], v0[1]); w.y = cvtpk(v0[2], v0[3]); w.z = cvtpk(v1[0], v1[1]); w.w = cvtpk(v1[2], v1[3]);
                    *(u32x4*)(rowp + bj * HALF) = w; } }
    }
};
struct EpiPlain {
    static constexpr bool PERM = true, AFTER_DRAIN = false, INPLACE = false;
    bf16_t* O; int ldc;
    __device__ __forceinline__ void operator()(const f32x4 (&acc)[2][2][4][2], const Unit& u, int wr, int wc, int fr, int fq) const {
        const int row0 = u.pm * BM + wr * 64 + fr; const int col0 = u.pn * BM + wc * 32 + 8 * fq;
#pragma unroll
        for (int ai = 0; ai < 2; ++ai)
#pragma unroll
            for (int m = 0; m < 4; ++m) { bf16_t* rowp = O + (size_t)(row0 + ai * HALF + m * 16) * ldc + col0;
#pragma unroll
                for (int bj = 0; bj < 2; ++bj) { const f32x4 v0 = acc[ai][bj][m][0], v1 = acc[ai][bj][m][1];
                    u32x4 w; w.x = cvtpk(v0[0], v0[1]); w.y = cvtpk(v0[2], v0[3]); w.z = cvtpk(v1[0], v1[1]); w.w = cvtpk(v1[2], v1[3]);
                    *(u32x4*)(rowp + bj * HALF) = w; } }
    }
};
template <int NH, int SEQL> struct EpiVt {
    static constexpr bool PERM = true, AFTER_DRAIN = false, INPLACE = false;
    unsigned char* vt;
    __device__ __forceinline__ void operator()(const f32x4 (&acc)[2][2][4][2], const Unit& u, int wr, int wc, int fr, int fq) const {
        constexpr int NKT = SEQL / 32;
        const int row0 = u.pm * BM + wr * 64 + fr; const int col0 = u.pn * BM + wc * 32 + 8 * fq;
#pragma unroll
        for (int ai = 0; ai < 2; ++ai)
#pragma unroll
            for (int m = 0; m < 4; ++m) { const int drow = row0 + ai * HALF + m * 16; const int hh = drow >> 7, d = drow & 127, dt = d >> 5, dl = d & 31;
#pragma unroll
                for (int bj = 0; bj < 2; ++bj) { const int t0 = col0 + bj * HALF; const int b = t0 / SEQL, tt = t0 % SEQL, kt = tt >> 5, s = (tt >> 4) & 1, o8 = (tt >> 3) & 1;
                    const size_t blk = ((((size_t)(b * NH + hh) * NKT + kt) * 2 + s) * 4 + dt);
                    unsigned char* p = vt + blk * 1024 + dl * 16 + o8 * 8;
                    const f32x4 v0 = acc[ai][bj][m][0], v1 = acc[ai][bj][m][1];
                    unsigned long long w0 = (unsigned long long)cvtpk(v0[0], v0[1]) | ((unsigned long long)cvtpk(v0[2], v0[3]) << 32);
                    unsigned long long w1 = (unsigned long long)cvtpk(v1[0], v1[1]) | ((unsigned long long)cvtpk(v1[2], v1[3]) << 32);
                    *(unsigned long long*)p = w0; *(unsigned long long*)(p + 512) = w1; } }
    }
};
struct MergeOrder {
    static constexpr bool VAR_NT = true;
    __device__ __forceinline__ int unit_nt(const Unit& u) const { return (u.pm >> 5) == 2 ? 8 : 12; }
    StaticOrder so;
    __device__ void init(int M, int N, int G_, int c_) { so.init(M, N, G_, c_); }
    __device__ bool next(int i, Unit& u) const { const int ib = i / 3, br = i - 3 * ib; if (!so.next(ib, u)) return false; u.pm += 32 * br; u.pn += 8 * br; return true; }
    __device__ __forceinline__ void a_ready(const Unit&) const {}
    __device__ __forceinline__ void done(const Unit&) const {}
};
struct EpiMergeAll {
    static constexpr bool PERM = true, AFTER_DRAIN = false, INPLACE = true;
    const bf16_t* gates; bf16_t* merged; int ldg, ldc;
    __device__ __forceinline__ bool inplace(f32x4 (&acc)[2][2][4][2], const Unit& u, int wr, int wc, int fr, int fq) const {
        const int br = u.pm >> 5, pm = u.pm & 31, pn = u.pn & 7;
        const int row0 = pm * BM + wr * 64 + fr; const int col0 = pn * BM + wc * 32 + 8 * fq;
        const bf16_t* gb = gates + br * 2048; const bf16_t* gd = gates + (br < 2 ? br + 1 : 2) * 2048;
        const f32x4 tiny = (f32x4){1e-20f, 1e-20f, 1e-20f, 1e-20f};
        const bool last = br == 2;
#pragma unroll
        for (int am = 0; am < 4; ++am) { const int ai = am >> 1, m0 = (am & 1) * 2;
            u32x4 g[2][2], gn[2][2];
#pragma unroll
            for (int mm = 0; mm < 2; ++mm)
#pragma unroll
                for (int bj = 0; bj < 2; ++bj) { const size_t off = (size_t)(row0 + ai * HALF + (m0 + mm) * 16) * ldg + col0 + bj * HALF;
                    g[mm][bj] = *(const u32x4*)(gb + off); gn[mm][bj] = *(const u32x4*)(gd + off); }
            __builtin_amdgcn_sched_barrier(0);
#pragma unroll
            for (int mm = 0; mm < 2; ++mm)
#pragma unroll
                for (int bj = 0; bj < 2; ++bj) { const int m = m0 + mm; const u32x4 gg = g[mm][bj], gq = gn[mm][bj];
                    f32x4 s0 = (f32x4){bflo(gg.x), bfhi(gg.x), bflo(gg.y), bfhi(gg.y)}, s1 = (f32x4){bflo(gg.z), bfhi(gg.z), bflo(gg.w), bfhi(gg.w)};
                    f32x4 d0 = (f32x4){bflo(gq.x), bfhi(gq.x), bflo(gq.y), bfhi(gq.y)}, d1 = (f32x4){bflo(gq.z), bfhi(gq.z), bflo(gq.w), bfhi(gq.w)};
                    s0 = __builtin_elementwise_max(s0, tiny); s1 = __builtin_elementwise_max(s1, tiny);
                    d0 = __builtin_elementwise_max(d0, tiny); d1 = __builtin_elementwise_max(d1, tiny);
                    if (last) { d0 = (f32x4){1.f, 1.f, 1.f, 1.f}; d1 = d0; }
                    s0 = s0 * (f32x4){__builtin_amdgcn_rcpf(d0[0]), __builtin_amdgcn_rcpf(d0[1]), __builtin_amdgcn_rcpf(d0[2]), __builtin_amdgcn_rcpf(d0[3])};
                    s1 = s1 * (f32x4){__builtin_amdgcn_rcpf(d1[0]), __builtin_amdgcn_rcpf(d1[1]), __builtin_amdgcn_rcpf(d1[2]), __builtin_amdgcn_rcpf(d1[3])};
                    const f32x4 v0 = acc[ai][bj][m][0] * s0, v1 = acc[ai][bj][m][1] * s1;
                    acc[ai][bj][m][0] = v0; acc[ai][bj][m][1] = v1;
                    if (last) { u32x4 w; w.x = cvtpk(v0[0], v0[1]); w.y = cvtpk(v0[2], v0[3]); w.z = cvtpk(v1[0], v1[1]); w.w = cvtpk(v1[2], v1[3]);
                        *(u32x4*)(merged + (size_t)(row0 + ai * HALF + m * 16) * ldc + col0 + bj * HALF) = w; } }
        }
        return !last;
    }
};
struct EpiOut {
    static constexpr bool PERM = true, AFTER_DRAIN = false, INPLACE = false;
    const float* x; float* out; bf16_t* xn2; float* ssq; int ldc; float sscale;
    __device__ __forceinline__ void operator()(const f32x4 (&acc)[2][2][4][2], const Unit& u, int wr, int wc, int fr, int fq) const {
        const int row0 = u.pm * BM + wr * 64 + fr; const int col0 = u.pn * BM + wc * 32 + 8 * fq;
#pragma unroll
        for (int am = 0; am < 4; ++am) { const int ai = am >> 1, m0 = (am & 1) * 2;
            f32x4 xv[2][2][2];
#pragma unroll
            for (int mm = 0; mm < 2; ++mm)
#pragma unroll
                for (int bj = 0; bj < 2; ++bj) { const size_t off = (size_t)(row0 + ai * HALF + (m0 + mm) * 16) * ldc + col0 + bj * HALF;
                    xv[mm][bj][0] = __builtin_nontemporal_load((const f32x4*)(x + off)); xv[mm][bj][1] = __builtin_nontemporal_load((const f32x4*)(x + off + 4)); }
            __builtin_amdgcn_sched_barrier(0);
#pragma unroll
            for (int mm = 0; mm < 2; ++mm) { const int m = m0 + mm; const size_t r = (size_t)(row0 + ai * HALF + m * 16); float rs = 0.f;
#pragma unroll
                for (int bj = 0; bj < 2; ++bj) { const size_t off = r * ldc + col0 + bj * HALF;
                    const f32x4 v0 = acc[ai][bj][m][0] + xv[mm][bj][0], v1 = acc[ai][bj][m][1] + xv[mm][bj][1];
                    rs += (v0[0] * v0[0] + v0[1] * v0[1]) + (v0[2] * v0[2] + v0[3] * v0[3]) + (v1[0] * v1[0] + v1[1] * v1[1]) + (v1[2] * v1[2] + v1[3] * v1[3]);
                    u32x4 w; w.x = cvtpk(v0[0], v0[1]); w.y = cvtpk(v0[2], v0[3]); w.z = cvtpk(v1[0], v1[1]); w.w = cvtpk(v1[2], v1[3]); *(u32x4*)(xn2 + off) = w; }
                rs += __shfl_xor(rs, 16); rs += __shfl_xor(rs, 32);
                if (fq == 0) atomicAdd(ssq + r, rs * sscale); }
        }
    }
};
struct EpiUp {
    static constexpr bool PERM = true, AFTER_DRAIN = false, INPLACE = false;
    const float* ssq; bf16_t* H; int ldc; float inv_d, eps;
    __device__ __forceinline__ void operator()(const f32x4 (&acc)[2][2][4][2], const Unit& u, int wr, int wc, int fr, int fq) const {
        const int row0 = u.pm * BM + wr * 64 + fr; const int col0 = u.pn * BM + wc * 32 + 8 * fq;
        float sq[2][4];
#pragma unroll
        for (int ai = 0; ai < 2; ++ai)
#pragma unroll
            for (int m = 0; m < 4; ++m) sq[ai][m] = ssq[row0 + ai * HALF + m * 16];
        __builtin_amdgcn_sched_barrier(0);
#pragma unroll
        for (int ai = 0; ai < 2; ++ai)
#pragma unroll
            for (int m = 0; m < 4; ++m) { const size_t r = (size_t)(row0 + ai * HALF + m * 16); const float rstd = 1.0f / sqrtf(sq[ai][m] * inv_d + eps);
#pragma unroll
                for (int bj = 0; bj < 2; ++bj) { const int c = col0 + bj * HALF;
                    f32x4 v0 = acc[ai][bj][m][0] * rstd, v1 = acc[ai][bj][m][1] * rstd;
                    v0 = __builtin_elementwise_max(v0, (f32x4){0.f, 0.f, 0.f, 0.f}); v1 = __builtin_elementwise_max(v1, (f32x4){0.f, 0.f, 0.f, 0.f});
                    v0 = v0 * v0; v1 = v1 * v1;
                    u32x4 w; w.x = cvtpk(v0[0], v0[1]); w.y = cvtpk(v0[2], v0[3]); w.z = cvtpk(v1[0], v1[1]); w.w = cvtpk(v1[2], v1[3]); *(u32x4*)(H + r * ldc + c) = w; } }
    }
};
struct EpiDown {
    static constexpr bool PERM = true, AFTER_DRAIN = false, INPLACE = false;
    const bf16_t* x1; float* out; int ldc; float scale;
    __device__ __forceinline__ void operator()(const f32x4 (&acc)[2][2][4][2], const Unit& u, int wr, int wc, int fr, int fq) const {
        const int row0 = u.pm * BM + wr * 64 + fr; const int col0 = u.pn * BM + wc * 32 + 8 * fq;
#pragma unroll
        for (int ai = 0; ai < 2; ++ai) {
            u32x4 g[4][2];
#pragma unroll
            for (int m = 0; m < 4; ++m)
#pragma unroll
                for (int bj = 0; bj < 2; ++bj) g[m][bj] = __builtin_nontemporal_load((const u32x4*)(x1 + (size_t)(row0 + ai * HALF + m * 16) * ldc + col0 + bj * HALF));
            __builtin_amdgcn_sched_barrier(0);
#pragma unroll
            for (int m = 0; m < 4; ++m)
#pragma unroll
                for (int bj = 0; bj < 2; ++bj) { const size_t off = (size_t)(row0 + ai * HALF + m * 16) * ldc + col0 + bj * HALF; const u32x4 gg = g[m][bj];
                    const f32x4 v0 = (f32x4){bflo(gg.x), bfhi(gg.x), bflo(gg.y), bfhi(gg.y)} + acc[ai][bj][m][0] * scale, v1 = (f32x4){bflo(gg.z), bfhi(gg.z), bflo(gg.w), bfhi(gg.w)} + acc[ai][bj][m][1] * scale;
                    __builtin_nontemporal_store(v0, (f32x4*)(out + off)); __builtin_nontemporal_store(v1, (f32x4*)(out + off + 4)); }
        }
    }
};
}

constexpr int NWAVES = 8;
constexpr int DM = 2048, NBATCH = 4, SEQ = 2048, MT = NBATCH * SEQ;
constexpr int MEML = 256, MMEM = NBATCH * MEML;
constexpr int NIN = 11020;
constexpr int NMAIN = 11008;
constexpr int NWIN = 11264;
constexpr int LDP = 4864, LDG = 6144, DFF = 8192;
constexpr float EPS = 1e-6f;
constexpr float LOG2E = 1.4426950408889634f;
constexpr float QSCALE = 0.08838834764831845f * 1.4426950408889634f;
constexpr int PC_DNZ = 2304, PC_SQ = 3072, PC_SK = 3840, PC_MQ = 4096, PC_BA = 4608;
constexpr int P1_CAP = 1232, NTAIL = 1376 - 1232;
constexpr int NCHUNK = NBATCH * 6 * 32;
constexpr int CH_W = 0, CH_QG = 16384, CH_KD = 32768, CH_P = 49152, CH_U = 57344, CH_ZG = 73728, CH_BYTES = 90112;

constexpr size_t MiB = 1u << 20;
constexpr size_t WS_CTL = 0, CTL_ZERO_BYTES = 1 * MiB;
constexpr size_t WS_SSQ = 512 * 1024;
constexpr size_t WS_WOUT = 1 * MiB, WS_PDN = 9 * MiB, WS_PSWA = 12 * MiB, WS_PMEM = 15 * MiB;
constexpr size_t WS_WUP = 18 * MiB, WS_WDN = 50 * MiB;
constexpr size_t WS_RHS = 18 * MiB;
constexpr size_t WS_DNF2 = 82 * MiB;
constexpr size_t DO_WIN = 0, DO_WMKV = 44 * MiB, DO_MEMN = 48 * MiB;
constexpr int DNF_SPLIT = 23 * 32;
static_assert((size_t)DNF_SPLIT * CH_BYTES <= (size_t)64 * MiB && WS_DNF2 + (size_t)32 * CH_BYTES <= 85 * MiB && DO_MEMN + 4 * MiB <= 64 * MiB, "d_out scratch map");
constexpr size_t WS_XN = 85 * MiB;
constexpr size_t WS_PROJ = 117 * MiB;
constexpr size_t WS_ODN = 117 * MiB, WS_OSWA = 129 * MiB, WS_OMEM = 141 * MiB, WS_MERGED = 153 * MiB;
constexpr size_t WS_GATES = 193 * MiB;
constexpr size_t WS_VT = 289 * MiB, WS_MVT = 293 * MiB, WS_MEMK = 294 * MiB;
constexpr size_t WS_QF = 295 * MiB, WS_KF = 307 * MiB, WS_MQF = 311 * MiB, WS_MKF = 319 * MiB, WS_GC = 320 * MiB, WS_LG = 321 * MiB, WS_WTAIL = 328 * MiB;
constexpr size_t WS_H = 117 * MiB;
constexpr size_t WS_END = 334 * MiB;
static_assert(WS_PROJ + (size_t)MT * LDP * 2 <= WS_GATES && WS_GATES + (size_t)MT * LDG * 2 <= WS_VT, "ws map");
static_assert(WS_H + (size_t)MT * DFF * 2 <= WS_VT, "ws map 2");
constexpr int CW_BAR = 4096;

constexpr int RING_OFF = 0, RING_BYTES = 131072;
constexpr int LDS_BYTES = 147456;
constexpr int LDSCTL_OFF = LDS_BYTES - 1024, MISC_OFF = LDSCTL_OFF + 320;
#define GAS __attribute__((address_space(1)))
#define LAS __attribute__((address_space(3)))
typedef unsigned short bf16;
typedef unsigned v4u __attribute__((ext_vector_type(4)));
typedef float f32x4 __attribute__((ext_vector_type(4)));
typedef short bf16x8 __attribute__((ext_vector_type(8)));
typedef GAS unsigned gu32;
typedef GAS unsigned long long gu64;
#define RLX_AGENT __ATOMIC_RELAXED, __HIP_MEMORY_SCOPE_AGENT
#define LDS_WAIT() asm volatile("s_waitcnt lgkmcnt(0)" ::: "memory")
#define VM_WAIT() asm volatile("s_waitcnt vmcnt(0)" ::: "memory")
__device__ __forceinline__ unsigned long long rt() { return __builtin_amdgcn_s_memrealtime(); }
__device__ __forceinline__ unsigned f2bf(float f) { unsigned u = __builtin_bit_cast(unsigned, f); return (u + 0x7fffu + ((u >> 16) & 1u)) >> 16; }
__device__ __forceinline__ unsigned pk2(float lo, float hi) { return f2bf(lo) | (f2bf(hi) << 16); }

#define XB_TMO      128
#define XB_XCNT(j)  (256  + 64 * (j))
#define XB_XSUB(j)  (1280 + 64 * (j))
#define XB_XGEN(j)  (2304 + 64 * (j))
#define XB_TOP      3328
#define XB_TOPGEN   3392
#define XCD_BAR_WORDS 3456
#define XB_SPIN_CAP (1u << 18)

__device__ __forceinline__ unsigned xb_ld(unsigned* p)              { return __hip_atomic_load(p, __ATOMIC_RELAXED, __HIP_MEMORY_SCOPE_AGENT); }
__device__ __forceinline__ unsigned xb_add(unsigned* p, unsigned v) { return __hip_atomic_fetch_add(p, v, __ATOMIC_RELAXED, __HIP_MEMORY_SCOPE_AGENT); }
__device__ __forceinline__ unsigned xb_xcc_id() { return (unsigned)__builtin_amdgcn_s_getreg((3 << 11) | 20) & 0xFu; }
#define XB_SPIN(cond, bar) do { unsigned _sp = 0; while (cond) { __builtin_amdgcn_s_sleep(1); \
    if ((++_sp & 255u) == 0u) { if (xb_ld(&(bar)[XB_TMO])) break; if (_sp > XB_SPIN_CAP) { atomicAdd(&(bar)[XB_TMO], 1u); break; } } } } while (0)

struct XcdBarrier {
    unsigned* bar; unsigned x;
    volatile LAS unsigned* st;
};

__device__ __forceinline__ XcdBarrier xcd_barrier_post(unsigned* bar, volatile LAS unsigned* st) {
    XcdBarrier b; b.bar = bar; b.x = xb_xcc_id(); b.st = st;
    if (threadIdx.x == 0) (void)xb_add(&bar[XB_XCNT(b.x)], 1u);
    return b;
}
__device__ __forceinline__ void xcd_barrier_complete(unsigned* bar, unsigned x, unsigned& nloc, unsigned& nx) {
    const unsigned G = gridDim.x * gridDim.y * gridDim.z;
    unsigned sum, cnt, mine, sp = 0u;
    for (;;) {
        sum = 0u; cnt = 0u; mine = 0u;
#pragma unroll
        for (unsigned j = 0; j < 16; ++j) { const unsigned c = xb_ld(&bar[XB_XCNT(j)]); sum += c; cnt += (c > 0u) ? 1u : 0u; mine = (j == x) ? c : mine; }
        if (sum == G) break;
        __builtin_amdgcn_s_sleep(1);
        if ((++sp & 255u) == 0u) { if (xb_ld(&bar[XB_TMO])) break; if (sp > XB_SPIN_CAP) { atomicAdd(&bar[XB_TMO], 1u); break; } }
    }
    nloc = mine > 0u ? mine : 1u; nx = cnt > 0u ? cnt : 1u;
}

__device__ __forceinline__ void xcd_barrier(const XcdBarrier& b) {
    asm volatile("s_waitcnt vmcnt(0)" ::: "memory");
    __syncthreads();
    if (threadIdx.x == 0) {
        unsigned* bar = b.bar;
        __builtin_amdgcn_s_waitcnt(0);
        unsigned nloc = b.st[0], nx = b.st[1];
        if (nloc == 0u) { xcd_barrier_complete(bar, b.x, nloc, nx); b.st[0] = nloc; b.st[1] = nx; }
        const unsigned old = xb_add(&bar[XB_XSUB(b.x)], 1u);
        const unsigned gen = old / nloc;
        if (old + 1u == (gen + 1u) * nloc) {
            __builtin_amdgcn_fence(__ATOMIC_RELEASE, "agent");
            asm volatile("s_waitcnt vmcnt(0)" ::: "memory");
            const unsigned og = xb_add(&bar[XB_TOP], 1u);
            const unsigned tg = og / nx;
            if (og + 1u == (tg + 1u) * nx) xb_add(&bar[XB_TOPGEN], 1u);
            else XB_SPIN(xb_ld(&bar[XB_TOPGEN]) == tg, bar);
            __builtin_amdgcn_fence(__ATOMIC_ACQUIRE, "agent");
            xb_add(&bar[XB_XGEN(b.x)], 1u);
            asm volatile("s_waitcnt vmcnt(0)" ::: "memory");
        } else {
            XB_SPIN(xb_ld(&bar[XB_XGEN(b.x)]) == gen, bar);
            __builtin_amdgcn_fence(__ATOMIC_ACQUIRE, "agent");
            asm volatile("s_waitcnt vmcnt(0)" ::: "memory");
        }
    }
    __syncthreads();
}

typedef unsigned v2u __attribute__((ext_vector_type(2)));
typedef float f32x16 __attribute__((ext_vector_type(16)));
using pg8::cvtpk; using pg8::bflo; using pg8::bfhi;
__device__ __forceinline__ float bf2f(unsigned short b) { return __builtin_bit_cast(float, (unsigned)b << 16); }
__device__ __forceinline__ float wave_sum(float v) {
#pragma unroll
    for (int o = 1; o < 64; o <<= 1) v += __shfl_xor(v, o);
    return v;
}
__device__ __forceinline__ bf16x8 pack8(f32x4 a, f32x4 b) {
    v4u w; w.x = cvtpk(a[0], a[1]); w.y = cvtpk(a[2], a[3]); w.z = cvtpk(b[0], b[1]); w.w = cvtpk(b[2], b[3]);
    return __builtin_bit_cast(bf16x8, w);
}
__device__ __forceinline__ float siluf(float y) { return y * __builtin_amdgcn_rcpf(1.0f + __expf(-y)); }

struct DnfMap { unsigned char* a; unsigned char* b; __device__ __forceinline__ unsigned char* rec(int chunk) const { return chunk < DNF_SPLIT ? a + (size_t)chunk * CH_BYTES : b + (size_t)(chunk - DNF_SPLIT) * CH_BYTES; } };
template <int MODE> __device__ __forceinline__ int colmap(int nr_in) {
    int nr = nr_in;
    if (MODE == 0) return nr;
    if (MODE == 2) nr += 38 * 256;
    if (nr < 3072) return nr;
    if (nr < 4096) return nr + 12;
    if (nr < 4608) return nr + 268;
    if (nr < 4620) return nr - 4608 + 3072;
    if (nr < 4864) return -1;
    if (nr < 11008) return nr + 12;
    return nr - 11008 + 4108;
}
template <int MODE> __device__ __forceinline__ void tr_load(const float* W, int N, int item, int nblk, int lane, f32x4 (&v)[8]) {
    const int kb = item / nblk, nb = item % nblk, n4 = lane & 7, g = lane >> 3;
    const int kk0 = 64 * kb + 8 * g, n = 32 * nb + 4 * n4;
    const int src = colmap<MODE>(n); const int srcc = src < 0 ? 0 : src;
    const GAS f32x4* p = (const GAS f32x4*)(W + (size_t)kk0 * N + srcc);
#pragma unroll
    for (int i = 0; i < 8; ++i) v[i] = __builtin_nontemporal_load(p + (size_t)i * (N / 4));
}
template <int MODE> __device__ __forceinline__ void tr_store(const float* kscale, bf16* WT, int ldt, int item, int nblk, int lane, f32x4 (&v)[8]) {
    const int kb = item / nblk, nb = item % nblk, n4 = lane & 7, g = lane >> 3;
    const int kk0 = 64 * kb + 8 * g, n = 32 * nb + 4 * n4;
    if (colmap<MODE>(n) < 0) {
#pragma unroll
        for (int i = 0; i < 8; ++i) v[i] = (f32x4){0.f, 0.f, 0.f, 0.f}; }
    if (kscale) { const f32x4 s0 = *(const GAS f32x4*)(kscale + kk0), s1 = *(const GAS f32x4*)(kscale + kk0 + 4);
        v[0] = v[0] * s0.x; v[1] = v[1] * s0.y; v[2] = v[2] * s0.z; v[3] = v[3] * s0.w; v[4] = v[4] * s1.x; v[5] = v[5] * s1.y; v[6] = v[6] * s1.z; v[7] = v[7] * s1.w; }
#pragma unroll
    for (int e = 0; e < 4; ++e) { v4u o; o.x = cvtpk(v[0][e], v[1][e]); o.y = cvtpk(v[2][e], v[3][e]); o.z = cvtpk(v[4][e], v[5][e]); o.w = cvtpk(v[6][e], v[7][e]);
        *(GAS v4u*)(WT + (size_t)(n + e) * ldt + kk0) = o; }
}
template <int MODE> __device__ __forceinline__ void transpose_matrix(const float* W, int K, int N, const float* kscale, bf16* WT, int ldt, int nrows, int gw, int NGW, int lane) {
    const int nblk = nrows / 32, nitems = (K / 64) * nblk;
    for (int it = gw; it < nitems; it += 4 * NGW) {
        f32x4 va[8], vb[8], vc[8], vd[8]; const int it2 = it + NGW, it3 = it + 2 * NGW, it4 = it + 3 * NGW;
        tr_load<MODE>(W, N, it, nblk, lane, va);
        if (it2 < nitems) tr_load<MODE>(W, N, it2, nblk, lane, vb);
        if (it3 < nitems) tr_load<MODE>(W, N, it3, nblk, lane, vc);
        if (it4 < nitems) tr_load<MODE>(W, N, it4, nblk, lane, vd);
        tr_store<MODE>(kscale, WT, ldt, it, nblk, lane, va);
        if (it2 < nitems) tr_store<MODE>(kscale, WT, ldt, it2, nblk, lane, vb);
        if (it3 < nitems) tr_store<MODE>(kscale, WT, ldt, it3, nblk, lane, vc);
        if (it4 < nitems) tr_store<MODE>(kscale, WT, ldt, it4, nblk, lane, vd);
    }
}
__device__ __forceinline__ void rms_load(const float* xrow, int lane, f32x4 (&v)[8]) {
    const GAS f32x4* xr = (const GAS f32x4*)xrow + lane;
#pragma unroll
    for (int j = 0; j < 8; ++j) v[j] = __builtin_nontemporal_load(xr + 64 * j);
}
__device__ __forceinline__ void rms_finish(const float* w, bf16* orow, int lane, f32x4 (&v)[8]) {
    const GAS f32x4* wr = (const GAS f32x4*)w + lane; float s = 0.f;
#pragma unroll
    for (int j = 0; j < 8; ++j) s += (v[j].x * v[j].x + v[j].y * v[j].y) + (v[j].z * v[j].z + v[j].w * v[j].w);
    const float rstd = 1.0f / sqrtf(wave_sum(s) * (1.0f / DM) + EPS);
    GAS v2u* o8 = (GAS v2u*)orow + lane;
#pragma unroll
    for (int j = 0; j < 8; ++j) { const f32x4 ww = wr[64 * j]; v2u o; o.x = cvtpk(v[j].x * rstd * ww.x, v[j].y * rstd * ww.y); o.y = cvtpk(v[j].z * rstd * ww.z, v[j].w * rstd * ww.w); o8[64 * j] = o; }
}

__device__ __forceinline__ void normfrag_item(const bf16* src, int ld, int row0, int col0, const float* wt, float scale, unsigned char* dst, int lane) {
    const int r = lane & 31, h = lane >> 5;
    const bf16* rp = src + (size_t)(row0 + r) * ld + col0 + 8 * h;
    v4u raw[8]; f32x4 w0[8], w1[8]; float ss = 0.f;
#pragma unroll
    for (int s = 0; s < 8; ++s) { raw[s] = *(const GAS v4u*)(rp + 16 * s); w0[s] = *(const GAS f32x4*)(wt + 16 * s + 8 * h); w1[s] = *(const GAS f32x4*)(wt + 16 * s + 8 * h + 4); }
    __builtin_amdgcn_sched_barrier(0);
#pragma unroll
    for (int s = 0; s < 8; ++s) {
        const float a0 = bflo(raw[s].x), a1 = bfhi(raw[s].x), a2 = bflo(raw[s].y), a3 = bfhi(raw[s].y), a4 = bflo(raw[s].z), a5 = bfhi(raw[s].z), a6 = bflo(raw[s].w), a7 = bfhi(raw[s].w);
        ss += (a0 * a0 + a1 * a1) + (a2 * a2 + a3 * a3) + (a4 * a4 + a5 * a5) + (a6 * a6 + a7 * a7); }
    ss += __shfl_xor(ss, 32);
    const float rstd = scale / sqrtf(ss * (1.0f / 128.0f) + EPS);
#pragma unroll
    for (int s = 0; s < 8; ++s) {
        v4u o; o.x = cvtpk(bflo(raw[s].x) * rstd * w0[s].x, bfhi(raw[s].x) * rstd * w0[s].y); o.y = cvtpk(bflo(raw[s].y) * rstd * w0[s].z, bfhi(raw[s].y) * rstd * w0[s].w);
        o.z = cvtpk(bflo(raw[s].z) * rstd * w1[s].x, bfhi(raw[s].z) * rstd * w1[s].y); o.w = cvtpk(bflo(raw[s].w) * rstd * w1[s].z, bfhi(raw[s].w) * rstd * w1[s].w);
        *(GAS v4u*)(dst + (size_t)(s * 64 + lane) * 16) = o; }
}

constexpr int DP_LD = 132, DP_LL = 68;
constexpr int DP_Q = 0, DP_K = 64 * DP_LD, DP_V = 2 * 64 * DP_LD, DP_L = 3 * 64 * DP_LD, DP_S = DP_L + 64 * DP_LL;
struct DnIn { const bf16* proj; const float* convw; const float* alog; const float* dtb; DnfMap dnf; float* gc; unsigned char* lg; unsigned char* rhs; };

__device__ __forceinline__ void dn_conv_issue(const DnIn& I, int chunk, int tid, unsigned (&uraw)[35]) {
    if (tid < 384) {
        const int b = chunk / 192, h = (chunk / 32) % 6, n = chunk & 31;
        const int ch2 = tid % 192, tg = tid / 192, which = ch2 >> 6, cp = ch2 & 63;
        const int gcol = which * 768 + h * 128 + 2 * cp;
        const int p0 = 64 * n + 32 * tg - 3;
        const bf16* src = I.proj + ((long)(b * SEQ + p0) * LDP + gcol);
#pragma unroll
        for (int i = 0; i < 35; ++i) { const int ic = (p0 + i >= 0) ? i : -p0;
            uraw[i] = *(const GAS unsigned*)(src + (long)ic * LDP); }
    }
}
__device__ __forceinline__ void dn_prep_chunk(const DnIn& I, LAS float* L, int chunk, int next_chunk, int tid_in, unsigned (&uraw)[35]) {
    int tz; asm volatile("v_mov_b32 %0, 0" : "=v"(tz));
    const int tid = tid_in + tz;
    const int lane = tid & 63, wave = __builtin_amdgcn_readfirstlane(tid >> 6);
    const int b = chunk / 192, h = (chunk / 32) % 6, n = chunk & 31;
    const int t0 = b * SEQ + 64 * n;
    LAS float* QS = L + DP_Q; LAS float* KS = L + DP_K; LAS float* VS = L + DP_V; LAS float* LM = L + DP_L;
    LAS float* sb = L + DP_S; LAS float* sG = sb + 64; LAS float* seG = sb + 128; LAS float* srq = sb + 192; LAS float* srk = sb + 256;
    unsigned char* rec = I.dnf.rec(chunk);
    unsigned short zraw[4][4];
    { const int c = lane & 15, q = lane >> 4;
#pragma unroll
      for (int f = 0; f < 4; ++f) { const int fi = wave * 4 + f, sl = fi >> 2, mt = fi & 3;
#pragma unroll
          for (int r = 0; r < 4; ++r) zraw[f][r] = I.proj[(size_t)(t0 + 16 * mt + 4 * q + r) * LDP + PC_DNZ + h * 128 + 16 * sl + c]; } }
    if (tid < 384) {
        const int ch2 = tid % 192, tg = tid / 192, which = ch2 >> 6, cp = ch2 & 63;
        const int gcol = which * 768 + h * 128 + 2 * cp;
        float w0[4], w1[4];
#pragma unroll
        for (int k = 0; k < 4; ++k) { w0[k] = I.convw[k * 2304 + gcol]; w1[k] = I.convw[k * 2304 + gcol + 1]; }
        const int p0 = 64 * n + 32 * tg - 3;
        float xa[35], xb[35];
#pragma unroll
        for (int i = 0; i < 35; ++i) { unsigned u = uraw[i]; if (p0 + i < 0) u = 0u; xa[i] = bflo(u); xb[i] = bfhi(u); }
        if (next_chunk < NCHUNK) dn_conv_issue(I, next_chunk, tid, uraw);
        LAS float* dst = L + which * 64 * DP_LD + (32 * tg) * DP_LD + 2 * cp;
#pragma unroll
        for (int j = 0; j < 32; ++j) {
            const float ya = (w0[0] * xa[j] + w0[1] * xa[j + 1]) + (w0[2] * xa[j + 2] + w0[3] * xa[j + 3]);
            const float yb = (w1[0] * xb[j] + w1[1] * xb[j + 1]) + (w1[2] * xb[j + 2] + w1[3] * xb[j + 3]);
            dst[j * DP_LD] = siluf(ya); dst[j * DP_LD + 1] = siluf(yb); if ((j & 7) == 7) asm volatile("" ::: "memory"); }
    } else if (tid >= 448) {
        const int i = lane;
        const bf16* pr = I.proj + (size_t)(t0 + i) * LDP + PC_BA;
        const float bb = bf2f(pr[h]), aa = bf2f(pr[6 + h]);
        const float beta = 1.0f / (1.0f + __expf(-bb));
        const float xx = aa + I.dtb[h];
        const float sp = xx > 20.f ? xx : log1pf(__expf(xx));
        float g = -__expf(I.alog[h]) * sp;
#pragma unroll
        for (int o = 1; o < 64; o <<= 1) { const float t = __shfl_up(g, o); if (lane >= o) g += t; }
        sb[i] = beta; sG[i] = g; seG[i] = __expf(g);
        if (i == 63) I.gc[chunk] = __expf(g);
    }
    __syncthreads();
    {
        const int row = tid >> 2, part = tid & 3, which = row >> 6, i = row & 63;
        const LAS float* p = L + which * 64 * DP_LD + i * DP_LD + 32 * part;
        float ss = 0.f;
#pragma unroll
        for (int k = 0; k < 8; ++k) { const f32x4 v = *(const LAS f32x4*)(p + 4 * k); ss += (v.x * v.x + v.y * v.y) + (v.z * v.z + v.w * v.w); }
        ss += __shfl_xor(ss, 1); ss += __shfl_xor(ss, 2);
        if (part == 0) { if (which == 0) srq[i] = 0.08838834764831845f / sqrtf(ss + EPS); else srk[i] = 1.0f / sqrtf(ss + EPS); }
    }
    __syncthreads();
    for (int e = tid; e < 2 * 64 * 64; e += 512) {
        const int which = e >> 12, i = (e >> 6) & 63, c2 = e & 63;
        LAS float* p = L + which * 64 * DP_LD + i * DP_LD + 2 * c2; const float sc = which ? srk[i] : srq[i];
        p[0] *= sc; p[1] *= sc; }
    __syncthreads();
    {
        const int it = wave & 3, c = lane & 15, q = lane >> 4; const bool isP = wave >= 4;
        const LAS float* X = isP ? QS : KS;
        bf16x8 bfr[4];
#pragma unroll
        for (int s = 0; s < 4; ++s) { const LAS float* p = X + (16 * it + c) * DP_LD + 32 * s + 8 * q; bfr[s] = pack8(*(const LAS f32x4*)p, *(const LAS f32x4*)(p + 4)); }
        f32x4 ct[4];
#pragma unroll
        for (int jt = 0; jt < 4; ++jt) { ct[jt] = (f32x4){0.f, 0.f, 0.f, 0.f};
            if (jt <= it) {
#pragma unroll
                for (int s = 0; s < 4; ++s) { const LAS float* p = KS + (16 * jt + c) * DP_LD + 32 * s + 8 * q; const bf16x8 af = pack8(*(const LAS f32x4*)p, *(const LAS f32x4*)(p + 4));
                    ct[jt] = __builtin_amdgcn_mfma_f32_16x16x32_bf16(af, bfr[s], ct[jt], 0, 0, 0); } } }
        const int i = 16 * it + c; const float Gi = sG[i], bi = sb[i];
        if (!isP) {
#pragma unroll
            for (int jt = 0; jt < 4; ++jt) if (jt <= it) { f32x4 o;
#pragma unroll
                for (int r = 0; r < 4; ++r) { const int j = 16 * jt + 4 * q + r; o[r] = (i > j) ? bi * ct[jt][r] * __expf(Gi - sG[j]) : 0.f; }
                const int j4 = 4 * jt + q, a = (i - 1) >> 2, bb = (i - 1) & 3;
                if (i >= 1 && j4 <= a) *(LAS f32x4*)(LM + 4 * ((a + 1) * (2 * a + bb) + j4)) = o; }
        } else {
#pragma unroll
            for (int s = 0; s < 2; ++s) { f32x4 lo, hi;
#pragma unroll
                for (int r = 0; r < 4; ++r) { const int j0 = 32 * s + 4 * q + r, j1 = j0 + 16;
                    lo[r] = (i >= j0) ? ct[2 * s][r] * __expf(Gi - sG[j0]) : 0.f; hi[r] = (i >= j1) ? ct[2 * s + 1][r] * __expf(Gi - sG[j1]) : 0.f; }
                *(GAS bf16x8*)(rec + CH_P + (size_t)((it * 2 + s) * 64 + lane) * 16) = pack8(lo, hi); }
        }
    }
    __syncthreads();
    {
        const int c = lane & 15, q = lane >> 4; const float G63 = sG[63];
#pragma unroll
        for (int f = 0; f < 2; ++f) { const int fi = wave * 2 + f, mt = fi >> 2, s = fi & 3;
            const int i = 16 * mt + c; const float e = seG[i]; const LAS float* p = QS + i * DP_LD + 32 * s + 4 * q;
            const f32x4 lo = *(const LAS f32x4*)p * e, hi = *(const LAS f32x4*)(p + 16) * e;
            *(GAS bf16x8*)(rec + CH_QG + (size_t)(fi * 64 + lane) * 16) = pack8(lo, hi); }
#pragma unroll
        for (int f = 0; f < 2; ++f) { const int fi = wave * 2 + f, mt = fi >> 1, s = fi & 1;
            const int dk = 16 * mt + c; f32x4 lo, hi;
#pragma unroll
            for (int r = 0; r < 4; ++r) { const int p0 = 32 * s + 4 * q + r, p1 = p0 + 16; lo[r] = KS[p0 * DP_LD + dk] * __expf(G63 - sG[p0]); hi[r] = KS[p1 * DP_LD + dk] * __expf(G63 - sG[p1]); }
            *(GAS bf16x8*)(rec + CH_KD + (size_t)(fi * 64 + lane) * 16) = pack8(lo, hi); }
    }
    {
        for (int t = tid; t < 528; t += 512) *(GAS f32x4*)(I.lg + (size_t)chunk * 8448 + (size_t)t * 16) = *(const LAS f32x4*)(LM + 4 * t);
#pragma unroll
        for (int e = 0; e < 4; ++e) { const int gi = tid + 512 * e, i = gi >> 5, c8 = (gi & 31) * 8;
            const bool isk = c8 >= 128; const LAS float* p = (isk ? KS : VS) + i * DP_LD + (c8 & 127);
            const float sc = sb[i] * (isk ? seG[i] : 1.0f);
            const f32x4 a = *(const LAS f32x4*)p * sc, bq = *(const LAS f32x4*)(p + 4) * sc;
            *(GAS bf16x8*)(I.rhs + ((size_t)chunk * 64 + i) * 512 + c8 * 2) = pack8(a, bq); }
        const int c = lane & 15, q = lane >> 4;
#pragma unroll
        for (int f = 0; f < 4; ++f) { const int fi = wave * 4 + f, sl = fi >> 2, mt = fi & 3;
            v2u zo; float zz[4];
#pragma unroll
            for (int r = 0; r < 4; ++r) zz[r] = siluf(bf2f(zraw[f][r]));
            zo.x = cvtpk(zz[0], zz[1]); zo.y = cvtpk(zz[2], zz[3]);
            *(GAS v2u*)(rec + CH_ZG + (size_t)(fi * 64 + lane) * 8) = zo; }
    }
    __syncthreads();
}

__device__ __forceinline__ void dn_solve_item(const unsigned char* lg, const unsigned char* rhs, const DnfMap& dnf, LAS float* Lw, int item, int lane) {
    const int chunk = item >> 2, g = item & 3;
    const unsigned char* lsrc = lg + (size_t)chunk * 8448;
#pragma unroll
    for (int k = 0; k < 9; ++k) { const int t = lane + 64 * k; const int tc = t < 528 ? t : 527; const f32x4 v = *(const GAS f32x4*)(lsrc + (size_t)tc * 16); if (t < 528) *(LAS f32x4*)(Lw + 4 * t) = v; }
    const bf16* rp = (const bf16*)(rhs + (size_t)chunk * 64 * 512) + 64 * g + lane;
    float X[64];
    unsigned short xr[64];
#pragma unroll
    for (int i = 0; i < 64; ++i) xr[i] = rp[i * 256];
    __builtin_amdgcn_sched_barrier(0);
#pragma unroll
    for (int i = 0; i < 64; ++i) X[i] = bf2f(xr[i]);
    asm volatile("s_waitcnt vmcnt(0) lgkmcnt(0)" ::: "memory");
    int vz; asm volatile("v_mov_b32 %0, 0" : "=v"(vz));
    const LAS float* LMv = Lw + vz;
    f32x4 ring[8];
#pragma unroll
    for (int t = 0; t < 8; ++t) ring[t] = *(const LAS f32x4*)(LMv + 4 * t);
    int t = 0;
#pragma unroll
    for (int i = 1; i < 64; ++i) {
        float acc = X[i];
#pragma unroll
        for (int j4 = 0; j4 < (i + 3) / 4; ++j4) { const f32x4 l = ring[t & 7];
            if (t + 8 < 528) ring[t & 7] = *(const LAS f32x4*)(LMv + 4 * (t + 8));
#pragma unroll
            for (int jj = 0; jj < 4; ++jj) { const int j = 4 * j4 + jj; if (j < i) acc -= l[jj] * X[j]; }
            ++t; }
        X[i] = acc; asm volatile("" ::: "memory"); }
    unsigned char* rec = dnf.rec(chunk);
    if (g < 2) {
        const int dv = 64 * g + lane, sl = dv >> 4, c = dv & 15;
        bf16* base = (bf16*)(rec + CH_U) + (size_t)(sl * 4) * 256 + c * 4;
#pragma unroll
        for (int i = 0; i < 64; ++i) base[(i >> 4) * 256 + ((i & 15) >> 2) * 64 + (i & 3)] = (bf16)(cvtpk(X[i], 0.f) & 0xffffu);
    } else {
        const int dk = 64 * (g - 2) + lane, s = dk >> 5, o = dk & 31, qq = (o & 15) >> 2, j = ((o >> 4) << 2) + (o & 3);
        bf16* base = (bf16*)(rec + CH_W) + (size_t)s * 512 + qq * 128 + j;
#pragma unroll
        for (int i = 0; i < 64; ++i) base[(i >> 4) * 2048 + (i & 15) * 8] = (bf16)(cvtpk(-X[i], 0.f) & 0xffffu);
    }
}

constexpr int SC_BUF = 57344, SC_RED = 2 * SC_BUF, SC_RS = SC_RED + 2048;
#define LDS_BAR() do { asm volatile("s_waitcnt lgkmcnt(0)" ::: "memory"); __builtin_amdgcn_s_barrier(); asm volatile("" ::: "memory"); } while (0)
template <int CTRL> __device__ __forceinline__ float dpp_t(float v) { return __builtin_bit_cast(float, __builtin_amdgcn_update_dpp(0, __builtin_bit_cast(int, v), CTRL, 0xf, 0xf, true)); }
#define dpp_f(v, ctrl) dpp_t<ctrl>(v)
__device__ __forceinline__ float row16_sum(float v) { v += dpp_t<0xB1>(v); v += dpp_t<0x4E>(v); v += dpp_t<0x141>(v); v += dpp_t<0x140>(v); return v; }
__device__ __forceinline__ f32x4 row16_sum4(f32x4 v) {
    float a = v[0], b = v[1], c = v[2], d = v[3];
    asm volatile("s_nop 1\n\t"
        "v_add_f32_dpp %0, %0, %0 quad_perm:[1,0,3,2] row_mask:0xf bank_mask:0xf\n\tv_add_f32_dpp %1, %1, %1 quad_perm:[1,0,3,2] row_mask:0xf bank_mask:0xf\n\t"
        "v_add_f32_dpp %2, %2, %2 quad_perm:[1,0,3,2] row_mask:0xf bank_mask:0xf\n\tv_add_f32_dpp %3, %3, %3 quad_perm:[1,0,3,2] row_mask:0xf bank_mask:0xf\n\t"
        "v_add_f32_dpp %0, %0, %0 quad_perm:[2,3,0,1] row_mask:0xf bank_mask:0xf\n\tv_add_f32_dpp %1, %1, %1 quad_perm:[2,3,0,1] row_mask:0xf bank_mask:0xf\n\t"
        "v_add_f32_dpp %2, %2, %2 quad_perm:[2,3,0,1] row_mask:0xf bank_mask:0xf\n\tv_add_f32_dpp %3, %3, %3 quad_perm:[2,3,0,1] row_mask:0xf bank_mask:0xf\n\t"
        "v_add_f32_dpp %0, %0, %0 row_half_mirror row_mask:0xf bank_mask:0xf\n\tv_add_f32_dpp %1, %1, %1 row_half_mirror row_mask:0xf bank_mask:0xf\n\t"
        "v_add_f32_dpp %2, %2, %2 row_half_mirror row_mask:0xf bank_mask:0xf\n\tv_add_f32_dpp %3, %3, %3 row_half_mirror row_mask:0xf bank_mask:0xf\n\t"
        "v_add_f32_dpp %0, %0, %0 row_mirror row_mask:0xf bank_mask:0xf\n\tv_add_f32_dpp %1, %1, %1 row_mirror row_mask:0xf bank_mask:0xf\n\t"
        "v_add_f32_dpp %2, %2, %2 row_mirror row_mask:0xf bank_mask:0xf\n\tv_add_f32_dpp %3, %3, %3 row_mirror row_mask:0xf bank_mask:0xf\n\ts_nop 1"
        : "+v"(a), "+v"(b), "+v"(c), "+v"(d));
    return (f32x4){a, b, c, d};
}
struct ScanIn { DnfMap dnf; const float* gc; const float* onw; bf16* odn; int popt; };
__device__ __forceinline__ void dn_scan(const ScanIn& I, LAS unsigned char* lds, int bh, int tid) {
    const int lane = tid & 63, sl = __builtin_amdgcn_readfirstlane(tid >> 6), c = lane & 15, q = lane >> 4;
    const int b = bh / 6, h = bh % 6;
    const unsigned char* rec0 = I.dnf.rec(bh * 32);
    LAS float* red = (LAS float*)(lds + SC_RED); LAS float* rsv = (LAS float*)(lds + SC_RS);
    const float onw = I.onw[16 * sl + c];
    const float gc_all = I.gc[bh * 32 + (lane & 31)];
    f32x4 S[8];
#pragma unroll
    for (int i = 0; i < 8; ++i) S[i] = (f32x4){0.f, 0.f, 0.f, 0.f};
    v2u Ucur[4], Zcur[4], Unxt[4], Znxt[4];
#pragma unroll
    for (int i = 0; i < 7; ++i) __builtin_amdgcn_global_load_lds((const unsigned*)(rec0 + (size_t)(sl * 7 + i) * 1024 + lane * 16), (LAS unsigned*)(lds + (sl * 7 + i) * 1024), 16, 0, 2);
#pragma unroll
    for (int mt = 0; mt < 4; ++mt) { Unxt[mt] = __builtin_nontemporal_load((const GAS v2u*)(rec0 + CH_U + (size_t)((sl * 4 + mt) * 64 + lane) * 8)); Znxt[mt] = __builtin_nontemporal_load((const GAS v2u*)(rec0 + CH_ZG + (size_t)((sl * 4 + mt) * 64 + lane) * 8)); }
    for (int n = 0; n < 32; ++n) {
        VM_WAIT(); __syncthreads();
#pragma unroll
        for (int mt = 0; mt < 4; ++mt) { Ucur[mt] = Unxt[mt]; Zcur[mt] = Znxt[mt]; }
        const float gcv = __builtin_bit_cast(float, __builtin_amdgcn_readlane(__builtin_bit_cast(int, gc_all), n));
        if (n + 1 < 32) {
            const unsigned char* rec = rec0 + (size_t)(n + 1) * CH_BYTES; LAS unsigned char* dstb = lds + ((n + 1) & 1) * SC_BUF;
#pragma unroll
            for (int i = 0; i < 7; ++i) __builtin_amdgcn_global_load_lds((const unsigned*)(rec + (size_t)(sl * 7 + i) * 1024 + lane * 16), (LAS unsigned*)(dstb + (sl * 7 + i) * 1024), 16, 0, 2);
#pragma unroll
            for (int mt = 0; mt < 4; ++mt) { Unxt[mt] = __builtin_nontemporal_load((const GAS v2u*)(rec + CH_U + (size_t)((sl * 4 + mt) * 64 + lane) * 8)); Znxt[mt] = __builtin_nontemporal_load((const GAS v2u*)(rec + CH_ZG + (size_t)((sl * 4 + mt) * 64 + lane) * 8)); }
        }
        const LAS unsigned char* fb = lds + (n & 1) * SC_BUF + lane * 16;
        bf16x8 Sb[4];
#pragma unroll
        for (int s = 0; s < 4; ++s) Sb[s] = pack8(S[2 * s], S[2 * s + 1]);
        f32x4 d[4], o[4];
#pragma unroll
        for (int mt = 0; mt < 4; ++mt) { d[mt] = (f32x4){bflo(Ucur[mt].x), bfhi(Ucur[mt].x), bflo(Ucur[mt].y), bfhi(Ucur[mt].y)}; o[mt] = (f32x4){0.f, 0.f, 0.f, 0.f}; }
#pragma unroll
        for (int mt = 0; mt < 4; ++mt)
#pragma unroll
            for (int s = 0; s < 4; ++s) {
                d[mt] = __builtin_amdgcn_mfma_f32_16x16x32_bf16(*(const LAS bf16x8*)(fb + CH_W + (mt * 4 + s) * 1024), Sb[s], d[mt], 0, 0, 0);
                o[mt] = __builtin_amdgcn_mfma_f32_16x16x32_bf16(*(const LAS bf16x8*)(fb + CH_QG + (mt * 4 + s) * 1024), Sb[s], o[mt], 0, 0, 0); }
        bf16x8 Db[2];
#pragma unroll
        for (int s = 0; s < 2; ++s) Db[s] = pack8(d[2 * s], d[2 * s + 1]);
#pragma unroll
        for (int mt = 0; mt < 4; ++mt)
#pragma unroll
            for (int s = 0; s < 2; ++s) o[mt] = __builtin_amdgcn_mfma_f32_16x16x32_bf16(*(const LAS bf16x8*)(fb + CH_P + (mt * 2 + s) * 1024), Db[s], o[mt], 0, 0, 0);
#pragma unroll
        for (int mt = 0; mt < 8; ++mt) { S[mt] = S[mt] * gcv;
#pragma unroll
            for (int s = 0; s < 2; ++s) S[mt] = __builtin_amdgcn_mfma_f32_16x16x32_bf16(*(const LAS bf16x8*)(fb + CH_KD + (mt * 2 + s) * 1024), Db[s], S[mt], 0, 0, 0); }
#pragma unroll
        for (int mt = 0; mt < 4; ++mt) { f32x4 ss = o[mt] * o[mt];
            ss = row16_sum4(ss);
            if (c == 0) *(LAS f32x4*)(red + sl * 64 + 16 * mt + 4 * q) = ss; }
        LDS_BAR();
        { const int pos = 8 * sl + (lane >> 3); float v = red[(lane & 7) * 64 + pos]; v += dpp_f(v, 0xB1); v += dpp_f(v, 0x4E); v += dpp_f(v, 0x141);
          if ((lane & 7) == 0) rsv[pos] = 1.0f / sqrtf(v * (1.0f / 128.0f) + EPS); }
        LDS_BAR();
        bf16* orow = I.odn + (size_t)(b * SEQ + 64 * n) * 768 + h * 128 + 16 * sl + c;
#pragma unroll
        for (int mt = 0; mt < 4; ++mt) { const f32x4 r4 = *(const LAS f32x4*)(rsv + 16 * mt + 4 * q);
            const f32x4 z4 = (f32x4){bflo(Zcur[mt].x), bfhi(Zcur[mt].x), bflo(Zcur[mt].y), bfhi(Zcur[mt].y)};
#pragma unroll
            for (int r = 0; r < 4; ++r) { const float v = o[mt][r] * r4[r] * onw * z4[r]; orow[(size_t)(16 * mt + 4 * q + r) * 768] = (bf16)(cvtpk(v, 0.f) & 0xffffu); } }
    }
    VM_WAIT(); __syncthreads();
}

__constant__ unsigned char T5_BUCKET[128] = {0,1,2,3,4,5,6,7,8,9,10,11,12,13,14,15,16,16,16,17,17,18,18,18,19,19,19,20,20,20,20,21,21,21,21,22,22,22,22,22,23,23,23,23,23,23,24,24,24,24,24,24,25,25,25,25,25,25,25,26,26,26,26,26,26,26,26,27,27,27,27,27,27,27,27,27,27,28,28,28,28,28,28,28,28,28,28,29,29,29,29,29,29,29,29,29,29,29,29,30,30,30,30,30,30,30,30,30,30,30,30,30,30,31,31,31,31,31,31,31,31,31,31,31,31,31,31,31};
struct AttnIn { const unsigned char *qf, *kf, *vt, *mqf, *mkf, *mvt; bf16 *oswa, *omem; const float* sinks; };
__device__ __forceinline__ float ex2(float v) { return __builtin_amdgcn_exp2f(v); }

__device__ __forceinline__ void ld8(const unsigned char* p, bf16x8 (&f)[8]) {
#pragma unroll
    for (int s = 0; s < 8; ++s) f[s] = *(const GAS bf16x8*)(p + s * 1024);
}
__device__ __forceinline__ bf16x8 pfrag(const f32x16& S, int s) { return pack8((f32x4){S[8 * s], S[8 * s + 1], S[8 * s + 2], S[8 * s + 3]}, (f32x4){S[8 * s + 4], S[8 * s + 5], S[8 * s + 6], S[8 * s + 7]}); }

__device__ __forceinline__ void swa_item(const AttnIn& I, const LAS float* biasT, int item, int lane) {
    const int qt = item & 63, hq = (item >> 6) % 6, b = item / 384, kvh = hq / 3;
    const int r32 = lane & 31, hh = lane >> 5;
    const unsigned char* kbase = I.kf + ((size_t)((b * 2 + kvh) * 64) * 8) * 1024 + lane * 16;
    const unsigned char* vbase = I.vt + ((size_t)((b * 2 + kvh) * 64) * 8) * 1024 + lane * 16;
#define KT(i) ((qt - 4 + (i)) < 0 ? 0 : (qt - 4 + (i)))
    bf16x8 qfr[8], ka[8], kb[8];
    ld8(I.qf + ((size_t)((b * 6 + hq) * 64 + qt) * 8) * 1024 + lane * 16, qfr);
    ld8(kbase + (size_t)KT(0) * 8192, ka);
    f32x16 S[5];
#pragma unroll
    for (int i = 0; i < 5; ++i) {
#pragma unroll
        for (int r = 0; r < 16; ++r) S[i][r] = 0.f;
        if (i & 1) { if (i + 1 < 5) ld8(kbase + (size_t)KT(i + 1) * 8192, ka); else ld8(vbase + (size_t)KT(0) * 8192, ka);
#pragma unroll
            for (int s = 0; s < 8; ++s) S[i] = __builtin_amdgcn_mfma_f32_32x32x16_bf16(kb[s], qfr[s], S[i], 0, 0, 0);
        } else { if (i + 1 < 5) ld8(kbase + (size_t)KT(i + 1) * 8192, kb); else ld8(vbase + (size_t)KT(0) * 8192, kb);
#pragma unroll
            for (int s = 0; s < 8; ++s) S[i] = __builtin_amdgcn_mfma_f32_32x32x16_bf16(ka[s], qfr[s], S[i], 0, 0, 0);
        }
    }
    const float sink2 = I.sinks[hq] * LOG2E; const LAS float* bt = biasT + hq * 128;
    float m = sink2;
#pragma unroll
    for (int i = 0; i < 5; ++i) {
#pragma unroll
        for (int r = 0; r < 16; ++r) { const int koff = (r & 3) + 8 * (r >> 2) + 4 * hh; const int dist = 32 * (4 - i) + r32 - koff;
            const bool valid = (qt - 4 + i >= 0) && (dist >= 0) && (dist < 128);
            const float v = valid ? S[i][r] + bt[dist & 127] : -INFINITY; S[i][r] = v; m = fmaxf(m, v); } }
    m = fmaxf(m, __shfl_xor(m, 32));
    float l = 0.f;
#pragma unroll
    for (int i = 0; i < 5; ++i)
#pragma unroll
        for (int r = 0; r < 16; ++r) { const float p = ex2(S[i][r] - m); S[i][r] = p; l += p; }
    l += __shfl_xor(l, 32); l += ex2(sink2 - m);
    f32x16 O[4];
#pragma unroll
    for (int dt = 0; dt < 4; ++dt)
#pragma unroll
        for (int r = 0; r < 16; ++r) O[dt][r] = 0.f;
#pragma unroll
    for (int i = 0; i < 5; ++i) {
        if (i + 1 < 5) { if (i & 1) ld8(vbase + (size_t)KT(i + 1) * 8192, kb); else ld8(vbase + (size_t)KT(i + 1) * 8192, ka); }
#pragma unroll
        for (int s = 0; s < 2; ++s) { const bf16x8 pf = pfrag(S[i], s);
#pragma unroll
            for (int dt = 0; dt < 4; ++dt) O[dt] = __builtin_amdgcn_mfma_f32_32x32x16_bf16((i & 1) ? ka[s * 4 + dt] : kb[s * 4 + dt], pf, O[dt], 0, 0, 0); }
    }
#undef KT
    const float inv = 1.0f / l;
    bf16* orow = I.oswa + (size_t)(b * SEQ + 32 * qt + r32) * 768 + hq * 128 + 4 * hh;
#pragma unroll
    for (int dt = 0; dt < 4; ++dt)
#pragma unroll
        for (int g = 0; g < 4; ++g) { v2u w; w.x = cvtpk(O[dt][4 * g] * inv, O[dt][4 * g + 1] * inv); w.y = cvtpk(O[dt][4 * g + 2] * inv, O[dt][4 * g + 3] * inv);
            *(GAS v2u*)(orow + 32 * dt + 8 * g) = w; }
}

__device__ __forceinline__ void mem_item(const AttnIn& I, int item, int lane) {
    const int qt = item & 63, h = (item >> 6) & 3, b = item >> 8;
    const int r32 = lane & 31, hh = lane >> 5;
    const unsigned char* kbase = I.mkf + ((size_t)((b * 4 + h) * 8) * 8) * 1024 + lane * 16;
    const unsigned char* vbase = I.mvt + ((size_t)((b * 4 + h) * 8) * 8) * 1024 + lane * 16;
    bf16x8 qfr[8], ka[8], kb[8];
    ld8(I.mqf + ((size_t)((b * 4 + h) * 64 + qt) * 8) * 1024 + lane * 16, qfr);
    ld8(kbase, ka);
    f32x16 O[4];
#pragma unroll
    for (int dt = 0; dt < 4; ++dt)
#pragma unroll
        for (int r = 0; r < 16; ++r) O[dt][r] = 0.f;
    float m = -INFINITY, l = 0.f;
#pragma unroll 1
    for (int half = 0; half < 2; ++half) {
        f32x16 S[4];
#pragma unroll
        for (int i = 0; i < 4; ++i) { const int kt = half * 4 + i;
#pragma unroll
            for (int r = 0; r < 16; ++r) S[i][r] = 0.f;
            const unsigned char* nxt = (i < 3) ? kbase + (size_t)(kt + 1) * 8192 : vbase + (size_t)(half * 4) * 8192;
            if (i & 1) { ld8(nxt, ka);
#pragma unroll
                for (int s = 0; s < 8; ++s) S[i] = __builtin_amdgcn_mfma_f32_32x32x16_bf16(kb[s], qfr[s], S[i], 0, 0, 0);
            } else { ld8(nxt, kb);
#pragma unroll
                for (int s = 0; s < 8; ++s) S[i] = __builtin_amdgcn_mfma_f32_32x32x16_bf16(ka[s], qfr[s], S[i], 0, 0, 0);
            } }
        float mh = m;
#pragma unroll
        for (int i = 0; i < 4; ++i)
#pragma unroll
            for (int r = 0; r < 16; ++r) mh = fmaxf(mh, S[i][r]);
        mh = fmaxf(mh, __shfl_xor(mh, 32));
        const float alpha = ex2(m - mh); m = mh;
        float ls = 0.f;
#pragma unroll
        for (int i = 0; i < 4; ++i)
#pragma unroll
            for (int r = 0; r < 16; ++r) { const float p = ex2(S[i][r] - m); S[i][r] = p; ls += p; }
        ls += __shfl_xor(ls, 32); l = l * alpha + ls;
#pragma unroll
        for (int dt = 0; dt < 4; ++dt) O[dt] = O[dt] * alpha;
#pragma unroll
        for (int i = 0; i < 4; ++i) { const int kt = half * 4 + i;
            const unsigned char* nxt = (i < 3) ? vbase + (size_t)(kt + 1) * 8192 : kbase + (size_t)(half == 0 ? 4 : 0) * 8192;
            if (i & 1) { ld8(nxt, ka); } else { ld8(nxt, kb); }
#pragma unroll
            for (int s = 0; s < 2; ++s) { const bf16x8 pf = pfrag(S[i], s);
#pragma unroll
                for (int dt = 0; dt < 4; ++dt) O[dt] = __builtin_amdgcn_mfma_f32_32x32x16_bf16((i & 1) ? kb[s * 4 + dt] : ka[s * 4 + dt], pf, O[dt], 0, 0, 0); } }
    }
    const float inv = 1.0f / l;
    bf16* orow = I.omem + (size_t)(b * SEQ + 32 * qt + r32) * 768 + h * 128 + 4 * hh;
#pragma unroll
    for (int dt = 0; dt < 4; ++dt)
#pragma unroll
        for (int g = 0; g < 4; ++g) { v2u w; w.x = cvtpk(O[dt][4 * g] * inv, O[dt][4 * g + 1] * inv); w.y = cvtpk(O[dt][4 * g + 2] * inv, O[dt][4 * g + 3] * inv);
            *(GAS v2u*)(orow + 32 * dt + 8 * g) = w; }
}

#ifndef PH_MASK
#define PH_MASK 0x1ff
#endif
#ifndef WGM_UP
#define WGM_UP 4
#endif
#ifndef WGM_DN
#define WGM_DN 4
#endif
#ifndef SP2_UP
#define SP2_UP true
#endif
#ifndef DUP_PHASE
#define DUP_PHASE -1
#endif
struct Args { const float* in[23]; float* out; unsigned char* ws; int ph_lo, ph_hi, opt, pad; };
__global__ void __launch_bounds__(NWAVES * 64, 2) hyb_fwd(Args args) {
    extern __shared__ __attribute__((aligned(16))) unsigned char lds_raw[];
    LAS unsigned char* lds = (LAS unsigned char*)lds_raw;
    volatile LAS unsigned* MISC = (volatile LAS unsigned*)(lds + MISC_OFF);
    const int tid = threadIdx.x, lane = tid & 63, wave = __builtin_amdgcn_readfirstlane(tid >> 6);
    const int G = gridDim.x, bx = blockIdx.x;
    unsigned char* ws = args.ws;
    const float* x = args.in[0]; const float* mem = args.in[1]; const float* attn_norm_w = args.in[2]; const float* w_in = args.in[3];
    const float* dn_conv_w = args.in[4]; const float* dn_A_log = args.in[5]; const float* dn_dt_bias = args.in[6]; const float* dn_out_norm_w = args.in[7];
    const float* swa_q_norm_w = args.in[8]; const float* swa_k_norm_w = args.in[9]; const float* swa_sinks = args.in[10]; const float* rel_bias = args.in[11];
    const float* mem_norm_w = args.in[12]; const float* w_mem_kv = args.in[13]; const float* xq_norm_w = args.in[14]; const float* xk_norm_w = args.in[15];
    const float* p_dn = args.in[16]; const float* p_swa = args.in[17]; const float* p_mem = args.in[18]; const float* w_out = args.in[19];
    const float* mlp_norm_w = args.in[20]; const float* w_up = args.in[21]; const float* w_down = args.in[22];
    float* out = args.out;
    bf16* WoutT = (bf16*)(ws + WS_WOUT); bf16* PdnT = (bf16*)(ws + WS_PDN); bf16* PswaT = (bf16*)(ws + WS_PSWA); bf16* PmemT = (bf16*)(ws + WS_PMEM);
    bf16* WinT = (bf16*)((unsigned char*)out + DO_WIN); bf16* WmkvT = (bf16*)((unsigned char*)out + DO_WMKV); bf16* memn = (bf16*)((unsigned char*)out + DO_MEMN);
    const DnfMap dnfm{(unsigned char*)out, ws + WS_DNF2};
    bf16* WupT = (bf16*)(ws + WS_WUP); bf16* WdnT = (bf16*)(ws + WS_WDN);
    bf16* xn = (bf16*)(ws + WS_XN); bf16* proj = (bf16*)(ws + WS_PROJ); bf16* gates = (bf16*)(ws + WS_GATES);
    bf16* odn = (bf16*)(ws + WS_ODN); bf16* oswa = (bf16*)(ws + WS_OSWA); bf16* omem = (bf16*)(ws + WS_OMEM); bf16* merged = (bf16*)(ws + WS_MERGED);
    bf16* memk = (bf16*)(ws + WS_MEMK); bf16* Hb = (bf16*)(ws + WS_H);
    float* ssq = (float*)(ws + WS_SSQ); float* gcarr = (float*)(ws + WS_GC);

    for (int u = tid; u < (LDS_BYTES - LDSCTL_OFF) / 4; u += NWAVES * 64) ((LAS unsigned*)(lds + LDSCTL_OFF))[u] = 0u;
    __syncthreads();
    XcdBarrier bar = xcd_barrier_post((unsigned*)(ws + WS_CTL) + CW_BAR, MISC + 8);
    const int lo = args.ph_lo, hi = args.ph_hi;
#define IN(k) (lo <= (k) && (k) < hi && ((PH_MASK >> (k)) & 1))
#ifdef DOUBLE_SEAM
#define SEAM(k) do { if ((k) + 1 < hi) { xcd_barrier(bar); xcd_barrier(bar); } } while (0)
#else
#define SEAM(k) do { if ((k) + 1 < hi) xcd_barrier(bar); } while (0)
#endif
    const int gw = bx * NWAVES + wave, NGW = G * NWAVES;

    if (lo <= 0 && 0 < hi) {
        for (int rep = 0; rep < ((DUP_PHASE == 0) ? 2 : 1); ++rep) if (IN(0)) { if (rep) xcd_barrier(bar);
        transpose_matrix<1>(w_in, DM, NIN, nullptr, WinT, DM, NWIN, gw, NGW, lane);
        transpose_matrix<2>(w_in, DM, NIN, nullptr, (bf16*)(ws + WS_WTAIL), DM, 1280, gw, NGW, lane);
        transpose_matrix<0>(w_mem_kv, DM, 1024, nullptr, WmkvT, DM, 1024, gw, NGW, lane);
        for (int m = gw; m < MT + MMEM; m += 2 * NGW) {
            f32x4 va[8], vb[8]; const int m2 = m + NGW; const bool two = m2 < MT + MMEM;
            rms_load(m < MT ? x + (size_t)m * DM : mem + (size_t)(m - MT) * DM, lane, va);
            if (two) rms_load(m2 < MT ? x + (size_t)m2 * DM : mem + (size_t)(m2 - MT) * DM, lane, vb);
            if (m < MT) rms_finish(attn_norm_w, xn + (size_t)m * DM, lane, va); else rms_finish(mem_norm_w, memn + (size_t)(m - MT) * DM, lane, va);
            if (two) { if (m2 < MT) rms_finish(attn_norm_w, xn + (size_t)m2 * DM, lane, vb); else rms_finish(mem_norm_w, memn + (size_t)(m2 - MT) * DM, lane, vb); }
        }
        }
        SEAM(0);
    }
    if (lo <= 1 && 1 < hi) {
        for (int rep = 0; rep < ((DUP_PHASE == 1) ? 2 : 1); ++rep) if (IN(1)) { if (rep) xcd_barrier(bar);
        { pg8::Gemm g{xn, WinT, MT, NMAIN, DM}; pg8::StaticOrder S; S.init(MT, NMAIN, G, bx); S.cap = P1_CAP; S.wgm = 4;
          pg8::EpiProj E{proj, gates, LDP, LDG};
          pg8::gemm_phase<pg8::EpiProj, pg8::StaticOrder, true, true>(lds + RING_OFF, g, S, E); }
        { pg8::Gemm g{WinT + (size_t)NMAIN * DM, xn, 256, MT, DM}; pg8::StaticOrder S; S.init(256, MT, G, (bx - 208 + G) % G);
          pg8::EpiVt<2, SEQ> E{ws + WS_VT};
          pg8::gemm_phase<pg8::EpiVt<2, SEQ>, pg8::StaticOrder, true, true>(lds + RING_OFF, g, S, E); }
        { pg8::Gemm g{memn, WmkvT, MMEM, 512, DM}; pg8::StaticOrder S; S.init(MMEM, 512, G, (bx - 240 + G) % G);
          pg8::EpiPlain E{memk, 512};
          pg8::gemm_phase<pg8::EpiPlain, pg8::StaticOrder, true, true>(lds + RING_OFF, g, S, E); }
        { pg8::Gemm g{WmkvT + (size_t)512 * DM, memn, 512, MMEM, DM}; pg8::StaticOrder S; S.init(512, MMEM, G, (bx - 248 + G) % G);
          pg8::EpiVt<4, MEML> E{ws + WS_MVT};
          pg8::gemm_phase<pg8::EpiVt<4, MEML>, pg8::StaticOrder, true, true>(lds + RING_OFF, g, S, E); }
        }
        SEAM(1);
    }
    if (lo <= 2 && 2 < hi) {
        for (int rep = 0; rep < ((DUP_PHASE == 2) ? 2 : 1); ++rep) if (IN(2)) { if (rep) xcd_barrier(bar);
        DnIn DI{proj, dn_conv_w, dn_A_log, dn_dt_bias, dnfm, gcarr, ws + WS_LG, ws + WS_RHS};
        { unsigned uraw[35];
          if (bx < NCHUNK) dn_conv_issue(DI, bx, tid, uraw);
          for (int chunk = bx; chunk < NCHUNK; chunk += G) dn_prep_chunk(DI, (LAS float*)(lds + RING_OFF), chunk, chunk + G, tid, uraw); }
        asm volatile("s_waitcnt vmcnt(0)" ::: "memory"); __syncthreads();
        { const int nmine = (NCHUNK - 1 - bx) / G + 1;
          for (int si = wave; si < 4 * nmine; si += NWAVES) dn_solve_item(ws + WS_LG, ws + WS_RHS, dnfm, (LAS float*)(lds + RING_OFF + wave * 8448), (bx + (si >> 2) * G) * 4 + (si & 3), lane); }
        { const int lw = (NWAVES - 1 - wave) * G + bx, nlight = NGW;
          for (int it = lw; it < 3200; it += nlight) {
            if (it < 1536) { const int grp = it >> 6, tile = it & 63, b = grp / 6, hq = grp % 6;
                normfrag_item(proj, LDP, b * SEQ + 32 * tile, PC_SQ + hq * 128, swa_q_norm_w, QSCALE, ws + WS_QF + (size_t)it * 8192, lane); }
            else if (it < 2048) { const int i2 = it - 1536, grp = i2 >> 6, tile = i2 & 63, b = grp >> 1, kvh = grp & 1;
                normfrag_item(proj, LDP, b * SEQ + 32 * tile, PC_SK + kvh * 128, swa_k_norm_w, 1.0f, ws + WS_KF + (size_t)i2 * 8192, lane); }
            else if (it < 3072) { const int i3 = it - 2048, grp = i3 >> 6, tile = i3 & 63, b = grp >> 2, h = grp & 3;
                normfrag_item(proj, LDP, b * SEQ + 32 * tile, PC_MQ + h * 128, xq_norm_w, QSCALE, ws + WS_MQF + (size_t)i3 * 8192, lane); }
            else { const int i4 = it - 3072, grp = i4 >> 3, tile = i4 & 7, b = grp >> 2, h = grp & 3;
                normfrag_item(memk, 512, b * MEML + 32 * tile, h * 128, xk_norm_w, 1.0f, ws + WS_MKF + (size_t)i4 * 8192, lane); }
          }
        }
        }
        SEAM(2);
    }
    if (lo <= 4 && 4 < hi) {
        for (int rep = 0; rep < ((DUP_PHASE == 4) ? 2 : 1); ++rep) if (IN(4)) { if (rep) xcd_barrier(bar);
        if (bx < 24) {
#ifndef NO_SCAN
            if (!(args.opt & 1)) { int tid_s = tid; asm volatile("" : "+v"(tid_s)); ScanIn SI{dnfm, gcarr, dn_out_norm_w, odn, args.opt}; dn_scan(SI, lds + RING_OFF, bx, tid_s); }
#endif
        }
        else if (!(args.opt & 2)) {
            LAS float* biasT = (LAS float*)(lds + RING_OFF);
            for (int e = tid; e < 768; e += NWAVES * 64) { const int hq = e >> 7, dist = e & 127; biasT[e] = rel_bias[T5_BUCKET[dist] * 6 + hq] * LOG2E; }
            __syncthreads();
            int lane_a = lane; asm volatile("" : "+v"(lane_a));
            AttnIn AI{ws + WS_QF, ws + WS_KF, ws + WS_VT, ws + WS_MQF, ws + WS_MKF, ws + WS_MVT, oswa, omem, swa_sinks};
            const int aw = (bx - 24) * NWAVES + wave, NAW = (G - 24) * NWAVES;
#ifndef NO_MEM
            for (int it = aw; it < 1024; it += NAW) mem_item(AI, it, lane_a);
#endif
#ifndef NO_SWA
            for (int it = (aw + NAW - (1024 % NAW)) % NAW; it < 1536; it += NAW) swa_item(AI, biasT, it, lane_a);
#endif
            const int ab = bx - 24, nab = G - 24, ntail = NTAIL < nab ? NTAIL : nab;
            __syncthreads();
            if (!(args.opt & 16)) { pg8::StaticOrder S; S.init(MT, NMAIN, 1 << 20, P1_CAP + ab); S.wgm = 4;
              if (ntail < NTAIL) S.cap = 0;
              const bf16* wt = (const bf16*)(ws + WS_WTAIL) - (size_t)38 * 256 * DM;
              pg8::Gemm g{xn, wt, MT, NMAIN, DM};
              pg8::EpiProj E{proj, gates, LDP, LDG};
              pg8::gemm_phase<pg8::EpiProj, pg8::StaticOrder, false, true>(lds + RING_OFF, g, S, E); }
            if (!(args.opt & 8)) {
            int lane2 = lane; asm volatile("" : "+v"(lane2));
            const int share = ab < ntail ? 1 : 3, Wt = NWAVES * (ntail + 3 * (nab - ntail));
            const int vb = ab < ntail ? (ab * NWAVES + wave) : (ntail * NWAVES + ((ab - ntail) * NWAVES + wave) * 3);
            for (int k = 0; k < share; ++k) {
                transpose_matrix<0>(w_up, DM, DFF, mlp_norm_w, WupT, DM, DFF, vb + k, Wt, lane2);
                transpose_matrix<0>(w_down, DFF, DM, nullptr, WdnT, DFF, DM, vb + k, Wt, lane2);
                transpose_matrix<0>(p_dn, 768, DM, nullptr, PdnT, 768, DM, vb + k, Wt, lane2);
                transpose_matrix<0>(p_swa, 768, DM, nullptr, PswaT, 768, DM, vb + k, Wt, lane2);
                transpose_matrix<0>(p_mem, 512, DM, nullptr, PmemT, 768, DM, vb + k, Wt, lane2);
                transpose_matrix<0>(w_out, DM, DM, nullptr, WoutT, DM, DM, vb + k, Wt, lane2); } }
        }
        }
        SEAM(4);
    }
    if (lo <= 5 && 5 < hi) {
        for (int rep = 0; rep < ((DUP_PHASE == 5) ? 2 : 1); ++rep) if (IN(5)) { if (rep) xcd_barrier(bar);
        if (!(args.opt & 16))
        { pg8::Gemm g{odn, PdnT, 3 * MT, 3 * DM, 768}; pg8::MergeOrder S; S.init(MT, DM, G, bx); S.so.wgm = 4;
          pg8::EpiMergeAll E{gates, merged, LDG, DM};
          pg8::gemm_phase<pg8::EpiMergeAll, pg8::MergeOrder, true, true>(lds + RING_OFF, g, S, E); }
        }
        SEAM(5);
    }
    if (lo <= 6 && 6 < hi) {
        for (int rep = 0; rep < ((DUP_PHASE == 6) ? 2 : 1); ++rep) if (IN(6)) { if (rep) xcd_barrier(bar);
        pg8::Gemm g{merged, WoutT, MT, DM, DM}; pg8::StaticOrder S; S.init(MT, DM, G, bx); S.wgm = 4;
        pg8::EpiOut E{x, (args.opt & 4) ? (float*)(ws + 225 * MiB) : out, xn, ssq, DM, rep ? 0.f : 1.f};
        pg8::gemm_phase<pg8::EpiOut, pg8::StaticOrder, false, true>(lds + RING_OFF, g, S, E);
        }
        SEAM(6);
    }
    if (lo <= 7 && 7 < hi) {
        for (int rep = 0; rep < ((DUP_PHASE == 7) ? 2 : 1); ++rep) if (IN(7)) { if (rep) xcd_barrier(bar);
        pg8::Gemm g{xn, WupT, MT, DFF, DM}; pg8::StaticOrder S; S.init(MT, DFF, G, bx); S.wgm = WGM_UP;
        pg8::EpiUp E{ssq, Hb, DFF, 1.0f / DM, EPS};
        pg8::gemm_phase<pg8::EpiUp, pg8::StaticOrder, true, SP2_UP>(lds + RING_OFF, g, S, E);
        }
        SEAM(7);
    }
    if (lo <= 8 && 8 < hi) {
        for (int rep = 0; rep < ((DUP_PHASE == 8) ? 2 : 1); ++rep) if (IN(8)) { if (rep) xcd_barrier(bar);
        pg8::Gemm g{Hb, WdnT, MT, DM, DFF}; pg8::StaticOrder S; S.init(MT, DM, G, bx); S.wgm = WGM_DN;
        pg8::EpiDown E{xn, out, DM, (rep || (args.opt & 4)) ? 0.f : 1.f};
        pg8::gemm_phase<pg8::EpiDown, pg8::StaticOrder, false, true>(lds + RING_OFF, g, S, E);
        }
    }
#undef IN
#undef SEAM
}

#ifndef N_LAUNCHES
#define N_LAUNCHES 1
#endif
extern "C" void kernel_launch(void* const* d_in, const int* in_sizes, int n_in, void* d_out, int out_size, void* d_ws, size_t ws_size, hipStream_t stream) {
    static int grid = 0;
    if (grid == 0) {
        if (n_in != 23 || out_size != MT * DM || ws_size < WS_END) { fprintf(stderr, "kernel_launch: unexpected shapes (n_in %d, out %d, ws %zu)\n", n_in, out_size, ws_size); grid = -1; return; }
        int dev = 0, cus = 0, per_cu = 0;
        if (hipGetDevice(&dev) != hipSuccess || hipDeviceGetAttribute(&cus, hipDeviceAttributeMultiprocessorCount, dev) != hipSuccess) { grid = -1; return; }
        if (hipFuncSetAttribute((const void*)hyb_fwd, hipFuncAttributeMaxDynamicSharedMemorySize, LDS_BYTES) != hipSuccess) { fprintf(stderr, "kernel_launch: hipFuncSetAttribute failed\n"); grid = -1; return; }
        if (hipOccupancyMaxActiveBlocksPerMultiprocessor(&per_cu, (const void*)hyb_fwd, NWAVES * 64, LDS_BYTES) != hipSuccess || per_cu < 1) { fprintf(stderr, "kernel_launch: occupancy query says %d\n", per_cu); per_cu = 1; }
        (void)hipGetLastError();
        grid = cus;
        if (grid > 256) grid = 256;
    }
    if (grid < 0) return;
    (void)hipMemsetAsync((char*)d_ws + WS_CTL, 0, CTL_ZERO_BYTES, stream);
#ifdef EXTRA_MEMSET
    (void)hipMemsetAsync((char*)d_ws + WS_END, 0, 64, stream);
#endif
    Args a{};
    for (int i = 0; i < 23; ++i) a.in[i] = (const float*)d_in[i];
    a.out = (float*)d_out; a.ws = (unsigned char*)d_ws;
#if N_LAUNCHES == 1
    a.ph_lo = 0; a.ph_hi = 9;
    hipLaunchKernelGGL(hyb_fwd, dim3(grid), dim3(NWAVES * 64), LDS_BYTES, stream, a);
#else
    for (int p = 0; p < 9; ++p) { a.ph_lo = p; a.ph_hi = p + 1; hipLaunchKernelGGL(hyb_fwd, dim3(grid), dim3(NWAVES * 64), LDS_BYTES, stream, a); }
#endif
#ifdef RERUN_PHASE
    a.ph_lo = RERUN_PHASE; a.ph_hi = RERUN_PHASE + 1; a.opt = RERUN_OPT;
    hipLaunchKernelGGL(hyb_fwd, dim3(grid), dim3(NWAVES * 64), LDS_BYTES, stream, a);
#endif
}
```
